# Optimizing an MI355X kernel written in HIP

```python
import math
import jax, jax.numpy as jnp
from jax import lax
import numpy as np

D_MODEL = 2048
BATCH = 4
SEQ = 2048
DEPTH = 2

N_META = 16
N_A_LAYERS = DEPTH // 2
N_B_LAYERS = DEPTH - N_A_LAYERS
N_DENSE_LAYERS = (DEPTH + 1) // 2
N_MOE_LAYERS = DEPTH // 2
D_RNN = D_MODEL
RNN_BLOCK = 128
N_RNN_BLOCKS = D_RNN // RNN_BLOCK
CONV_WIDTH = 4
RGLRU_C = 8.0
HEAD_DIM = 128
N_HEADS = D_MODEL // (2 * HEAD_DIM)
V_HEAD_DIM = 2 * HEAD_DIM
Q_BLOCK = 128
D_FF = ((8 * D_MODEL // 3 + 127) // 128) * 128
N_EXPERTS = 8
TOP_K = 2
EPS = 1e-6

kernel_name = "yoco_rglru_diffattn_moe_trunk"


def rms_norm(x, g):
    xf = x.astype(jnp.float32)
    y = xf * lax.rsqrt(jnp.mean(xf * xf, axis=-1, keepdims=True) + EPS)
    return (y * g.astype(jnp.float32)).astype(x.dtype)


def swiglu(u, w_gate, w_up, w_down):
    return (jax.nn.silu(u @ w_gate) * (u @ w_up)) @ w_down


def alibi_slopes():
    return jnp.asarray(2.0 ** (-8.0 * np.arange(1, N_HEADS + 1) / N_HEADS), dtype=jnp.float32)


def causal_depthwise_conv(x, w, b):
    seq = x.shape[1]
    xp = jnp.pad(x, ((0, 0), (CONV_WIDTH - 1, 0), (0, 0)))
    y = b
    for k in range(CONV_WIDTH):
        y = y + xp[:, k:k + seq] * w[k]
    return y


def rglru_block(h, norm_g, w_in, conv_w, conv_b, w_rg, b_rg, w_ig, b_ig, lam, w_out):
    bsz, seq, _ = h.shape
    u = rms_norm(h, norm_g)
    x_br, g_br = jnp.split(u @ w_in, 2, axis=-1)
    xc = causal_depthwise_conv(x_br, conv_w, conv_b)
    xg = xc.reshape(bsz, seq, N_RNN_BLOCKS, RNN_BLOCK)
    r = jax.nn.sigmoid(jnp.einsum("blgi,gij->blgj", xg, w_rg).reshape(bsz, seq, D_RNN) + b_rg).astype(jnp.float32)
    i = jax.nn.sigmoid(jnp.einsum("blgi,gij->blgj", xg, w_ig).reshape(bsz, seq, D_RNN) + b_ig).astype(jnp.float32)
    log_a = -RGLRU_C * r * jax.nn.softplus(-lam.astype(jnp.float32))
    a = jnp.exp(log_a)
    b = jnp.sqrt(-jnp.expm1(2.0 * log_a)) * (i * xc.astype(jnp.float32))

    def combine(left, right):
        a_l, b_l = left
        a_r, b_r = right
        return a_l * a_r, a_r * b_l + b_r

    _, hs = lax.associative_scan(combine, (a, b), axis=1)
    y = hs.astype(h.dtype) * jax.nn.gelu(g_br)
    return y @ w_out


def diff_attention_block(h, norm_g, w_q, lq1, lk1, lq2, lk2, subln_g, w_out, k1, k2, v, lambda_init):
    bsz, seq, _ = h.shape
    n_blocks = seq // Q_BLOCK
    u = rms_norm(h, norm_g)
    q = (u @ w_q).reshape(bsz, seq, 2, N_HEADS, HEAD_DIM) * (HEAD_DIM ** -0.5)

    def to_blocks(t):
        return t.reshape(bsz, n_blocks, Q_BLOCK, N_HEADS, HEAD_DIM).transpose(1, 0, 3, 2, 4)

    q1b = to_blocks(q[:, :, 0])
    q2b = to_blocks(q[:, :, 1])
    q_pos = (N_META + jnp.arange(seq, dtype=jnp.int32)).reshape(n_blocks, Q_BLOCK)
    k_pos = jnp.arange(k1.shape[2], dtype=jnp.int32)
    slopes = alibi_slopes()
    lam = (jnp.exp(jnp.sum(lq1.astype(jnp.float32) * lk1.astype(jnp.float32)))
           - jnp.exp(jnp.sum(lq2.astype(jnp.float32) * lk2.astype(jnp.float32))) + lambda_init)
    v32 = v.astype(jnp.float32)

    def attend(args):
        q1_blk, q2_blk, qp = args
        dist = qp[:, None] - k_pos[None, :]
        bias = -slopes[:, None, None] * dist.astype(jnp.float32)
        visible = dist >= 0

        def probs(qb, kb):
            s = jnp.einsum("bhqd,bhkd->bhqk", qb, kb).astype(jnp.float32) + bias
            return jax.nn.softmax(jnp.where(visible, s, -jnp.inf), axis=-1)

        p = probs(q1_blk, k1) - lam * probs(q2_blk, k2)
        return jnp.einsum("bhqk,bhkd->bhqd", p, v32)

    o = lax.map(attend, (q1b, q2b, q_pos))
    o = o.transpose(1, 0, 3, 2, 4).reshape(bsz, seq, N_HEADS, V_HEAD_DIM)
    o = rms_norm(o, subln_g) * (1.0 - lambda_init)
    return o.reshape(bsz, seq, N_HEADS * V_HEAD_DIM).astype(h.dtype) @ w_out


def moe_swiglu(h, norm_g, router, w_gate, w_up, w_down):
    bsz, seq, d = h.shape
    u = rms_norm(h, norm_g).reshape(bsz * seq, d)
    logits = (u @ router).astype(jnp.float32)
    top_vals, top_idx = lax.top_k(logits, TOP_K)
    top_w = jax.nn.softmax(top_vals, axis=-1)
    gates = jnp.sum(jax.nn.one_hot(top_idx, N_EXPERTS, dtype=jnp.float32) * top_w[..., None], axis=1).astype(u.dtype)
    y = jnp.zeros_like(u)
    for e in range(N_EXPERTS):
        y = y + gates[:, e:e + 1] * swiglu(u, w_gate[e], w_up[e], w_down[e])
    return y.reshape(bsz, seq, d)


def setup_inputs(seed: int = 0) -> dict:
    key = jax.random.key(seed)
    ks = iter(jax.random.split(key, 40))

    def normal(shape, scale):
        return jax.random.normal(next(ks), shape, jnp.float32) * scale

    def gain(shape):
        return 1.0 + normal(shape, 0.02)

    d, f = D_MODEL, D_FF
    qk_width = 2 * N_HEADS * HEAD_DIM
    v_width = N_HEADS * V_HEAD_DIM
    x = normal((BATCH, SEQ, d), 1.0)
    meta_tokens = normal((N_META, d), 1.0)
    a_norm = gain((N_A_LAYERS, d))
    a_w_in = normal((N_A_LAYERS, d, 2 * D_RNN), d ** -0.5)
    a_conv_w = normal((N_A_LAYERS, CONV_WIDTH, D_RNN), CONV_WIDTH ** -0.5)
    a_conv_b = normal((N_A_LAYERS, D_RNN), 0.01)
    a_w_rgate = normal((N_A_LAYERS, N_RNN_BLOCKS, RNN_BLOCK, RNN_BLOCK), RNN_BLOCK ** -0.5)
    a_b_rgate = normal((N_A_LAYERS, D_RNN), 0.01)
    a_w_igate = normal((N_A_LAYERS, N_RNN_BLOCKS, RNN_BLOCK, RNN_BLOCK), RNN_BLOCK ** -0.5)
    a_b_igate = normal((N_A_LAYERS, D_RNN), 0.01)
    u = jax.random.uniform(next(ks), (N_A_LAYERS, D_RNN), jnp.float32, 0.9, 0.999)
    a0 = u ** (1.0 / RGLRU_C)
    a_lambda = jnp.log(a0) - jnp.log1p(-a0)
    a_w_out = normal((N_A_LAYERS, D_RNN, d), D_RNN ** -0.5)
    kv_norm = gain((d,))
    w_kv = normal((d, qk_width + v_width), d ** -0.5)
    b_norm = gain((N_B_LAYERS, d))
    b_w_q = normal((N_B_LAYERS, d, qk_width), d ** -0.5)
    b_lambda_q1 = normal((N_B_LAYERS, HEAD_DIM), 0.1)
    b_lambda_k1 = normal((N_B_LAYERS, HEAD_DIM), 0.1)
    b_lambda_q2 = normal((N_B_LAYERS, HEAD_DIM), 0.1)
    b_lambda_k2 = normal((N_B_LAYERS, HEAD_DIM), 0.1)
    b_subln = gain((N_B_LAYERS, V_HEAD_DIM))
    b_w_out = normal((N_B_LAYERS, v_width, d), v_width ** -0.5)
    ffn_norm = gain((DEPTH, d))
    ffn_w_gate = normal((N_DENSE_LAYERS, d, f), d ** -0.5)
    ffn_w_up = normal((N_DENSE_LAYERS, d, f), d ** -0.5)
    ffn_w_down = normal((N_DENSE_LAYERS, f, d), f ** -0.5)
    moe_router = normal((N_MOE_LAYERS, d, N_EXPERTS), d ** -0.5)
    moe_w_gate = normal((N_MOE_LAYERS, N_EXPERTS, d, f), d ** -0.5)
    moe_w_up = normal((N_MOE_LAYERS, N_EXPERTS, d, f), d ** -0.5)
    moe_w_down = normal((N_MOE_LAYERS, N_EXPERTS, f, d), f ** -0.5)
    final_norm = gain((d,))
    return {
        "x": x, "meta_tokens": meta_tokens,
        "a_norm": a_norm, "a_w_in": a_w_in, "a_conv_w": a_conv_w, "a_conv_b": a_conv_b,
        "a_w_rgate": a_w_rgate, "a_b_rgate": a_b_rgate, "a_w_igate": a_w_igate, "a_b_igate": a_b_igate,
        "a_lambda": a_lambda, "a_w_out": a_w_out,
        "kv_norm": kv_norm, "w_kv": w_kv,
        "b_norm": b_norm, "b_w_q": b_w_q, "b_lambda_q1": b_lambda_q1, "b_lambda_k1": b_lambda_k1,
        "b_lambda_q2": b_lambda_q2, "b_lambda_k2": b_lambda_k2, "b_subln": b_subln, "b_w_out": b_w_out,
        "ffn_norm": ffn_norm, "ffn_w_gate": ffn_w_gate, "ffn_w_up": ffn_w_up, "ffn_w_down": ffn_w_down,
        "moe_router": moe_router, "moe_w_gate": moe_w_gate, "moe_w_up": moe_w_up, "moe_w_down": moe_w_down,
        "final_norm": final_norm,
    }


def reference(x, meta_tokens, a_norm, a_w_in, a_conv_w, a_conv_b, a_w_rgate, a_b_rgate, a_w_igate, a_b_igate,
              a_lambda, a_w_out, kv_norm, w_kv, b_norm, b_w_q, b_lambda_q1, b_lambda_k1, b_lambda_q2, b_lambda_k2,
              b_subln, b_w_out, ffn_norm, ffn_w_gate, ffn_w_up, ffn_w_down, moe_router, moe_w_gate, moe_w_up,
              moe_w_down, final_norm):
    bsz = x.shape[0]
    h = jnp.concatenate([jnp.broadcast_to(meta_tokens.astype(x.dtype)[None], (bsz, N_META, D_MODEL)), x], axis=1)
    qk_width = 2 * N_HEADS * HEAD_DIM
    for layer in range(DEPTH):
        if layer < N_A_LAYERS:
            j = layer
            h = h + rglru_block(h, a_norm[j], a_w_in[j], a_conv_w[j], a_conv_b[j], a_w_rgate[j], a_b_rgate[j],
                                a_w_igate[j], a_b_igate[j], a_lambda[j], a_w_out[j])
        else:
            j = layer - N_A_LAYERS
            lambda_init = 0.8 - 0.6 * math.exp(-0.3 * layer)
            h = h + diff_attention_block(h, b_norm[j], b_w_q[j], b_lambda_q1[j], b_lambda_k1[j], b_lambda_q2[j],
                                         b_lambda_k2[j], b_subln[j], b_w_out[j], k1, k2, v, lambda_init)
        if layer % 2 == 0:
            m = layer // 2
            h = h + swiglu(rms_norm(h, ffn_norm[layer]), ffn_w_gate[m], ffn_w_up[m], ffn_w_down[m])
        else:
            m = layer // 2
            h = h + moe_swiglu(h, ffn_norm[layer], moe_router[m], moe_w_gate[m], moe_w_up[m], moe_w_down[m])
        if layer == N_A_LAYERS - 1:
            kv = rms_norm(h, kv_norm) @ w_kv
            seq_full = kv.shape[1]
            k = kv[..., :qk_width].reshape(bsz, seq_full, 2, N_HEADS, HEAD_DIM)
            k1 = k[:, :, 0].transpose(0, 2, 1, 3)
            k2 = k[:, :, 1].transpose(0, 2, 1, 3)
            v = kv[..., qk_width:].reshape(bsz, seq_full, N_HEADS, V_HEAD_DIM).transpose(0, 2, 1, 3)
            h = h[:, N_META:]
    return rms_norm(h, final_norm)
```

```cpp
#include <hip/hip_runtime.h>
#include <cstdio>
#include <cstdint>

namespace nv {
constexpr int B_ = 4, S_ = 2048, D_ = 2048, NM = 16, L_ = S_ + NM, F_ = 5504, H_ = 8, HD = 128, VD = 256, E_ = 8;
constexpr int ML = B_ * L_;
constexpr int MS = B_ * S_;
constexpr float EPS = 1e-6f;

__global__ void k_concat(const float* __restrict__ x, const float* __restrict__ meta, float* __restrict__ h) {
    const int row = blockIdx.x, b = row / L_, t = row % L_;
    const float* src = t < NM ? meta + (size_t)t * D_ : x + ((size_t)b * S_ + (t - NM)) * D_;
    for (int c = threadIdx.x; c < D_; c += blockDim.x) h[(size_t)row * D_ + c] = src[c];
}

__device__ __forceinline__ float block_sum(float v, float* red) {
    for (int o = 32; o >= 1; o >>= 1) v += __shfl_xor(v, o);
    const int w = threadIdx.x >> 6, nw = blockDim.x >> 6;
    __syncthreads();
    if ((threadIdx.x & 63) == 0) red[w] = v;
    __syncthreads();
    float s = 0.f;
    for (int i = 0; i < nw; ++i) s += red[i];
    return s;
}

__global__ void k_rmsnorm(const float* __restrict__ in, size_t in_stride, const float* __restrict__ g, float* __restrict__ out, size_t out_stride, int n, float post) {
    __shared__ float red[8];
    const float* x = in + (size_t)blockIdx.x * in_stride;
    float* o = out + (size_t)blockIdx.x * out_stride;
    float s = 0.f;
    for (int c = threadIdx.x; c < n; c += blockDim.x) { const float v = x[c]; s += v * v; }
    s = block_sum(s, red);
    const float rs = rsqrtf(s / (float)n + EPS) * post;
    for (int c = threadIdx.x; c < n; c += blockDim.x) o[c] = x[c] * rs * g[c];
}

__global__ __launch_bounds__(256) void k_gemm(const float* __restrict__ A, int lda, const float* __restrict__ Bm, int ldb, float* C, int ldc,
                                              int M, int N, int K, const float* R, int ldr) {
    __shared__ float As[16][65];
    __shared__ float Bs[16][64];
    const int tx = threadIdx.x & 15, ty = threadIdx.x >> 4;
    const int m0 = blockIdx.y * 64, n0 = blockIdx.x * 64;
    float acc[4][4];
#pragma unroll
    for (int i = 0; i < 4; ++i)
#pragma unroll
        for (int j = 0; j < 4; ++j) acc[i][j] = 0.f;
    for (int k0 = 0; k0 < K; k0 += 16) {
#pragma unroll
        for (int q = 0; q < 4; ++q) { const int i = threadIdx.x + q * 256; const int m = i >> 4, k = i & 15; const int gm = m0 + m;
            As[k][m] = (gm < M && k0 + k < K) ? A[(size_t)gm * lda + k0 + k] : 0.f; }
#pragma unroll
        for (int q = 0; q < 4; ++q) { const int i = threadIdx.x + q * 256; const int k = i >> 6, n = i & 63; const int gn = n0 + n;
            Bs[k][n] = (gn < N && k0 + k < K) ? Bm[(size_t)(k0 + k) * ldb + gn] : 0.f; }
        __syncthreads();
#pragma unroll
        for (int k = 0; k < 16; ++k) {
            float a[4], b[4];
#pragma unroll
            for (int i = 0; i < 4; ++i) a[i] = As[k][ty * 4 + i];
#pragma unroll
            for (int j = 0; j < 4; ++j) b[j] = Bs[k][tx * 4 + j];
#pragma unroll
            for (int i = 0; i < 4; ++i)
#pragma unroll
                for (int j = 0; j < 4; ++j) acc[i][j] += a[i] * b[j];
        }
        __syncthreads();
    }
#pragma unroll
    for (int i = 0; i < 4; ++i) { const int gm = m0 + ty * 4 + i; if (gm >= M) continue;
#pragma unroll
        for (int j = 0; j < 4; ++j) { const int gn = n0 + tx * 4 + j; if (gn >= N) continue;
            float v = acc[i][j]; if (R) v += R[(size_t)gm * ldr + gn]; C[(size_t)gm * ldc + gn] = v; } }
}

__global__ void k_conv(const float* __restrict__ xw, const float* __restrict__ w, const float* __restrict__ bias, float* __restrict__ xc) {
    const int row = blockIdx.x, t = row % L_;
    for (int c = threadIdx.x; c < D_; c += blockDim.x) {
        float y = bias[c];
#pragma unroll
        for (int k = 0; k < 4; ++k) { const int tt = t - 3 + k; if (tt >= 0) y += w[k * D_ + c] * xw[(size_t)(row - 3 + k) * (2 * D_) + c]; }
        xc[(size_t)row * D_ + c] = y;
    }
}
__device__ __forceinline__ float sigmoidf_(float x) { return 1.f / (1.f + expf(-x)); }
__global__ void k_ab(float* __restrict__ rp, float* __restrict__ ip, const float* __restrict__ xc, const float* __restrict__ brg, const float* __restrict__ big, const float* __restrict__ lam) {
    const size_t row = blockIdx.x;
    for (int c = threadIdx.x; c < D_; c += blockDim.x) {
        const size_t i = row * D_ + c;
        const float r = sigmoidf_(rp[i] + brg[c]), ig = sigmoidf_(ip[i] + big[c]);
        const float nl = -lam[c];
        const float sp = nl > 20.f ? nl : log1pf(expf(nl));
        const float log_a = -8.0f * r * sp;
        const float a = expf(log_a);
        const float bb = sqrtf(-expm1f(2.f * log_a)) * (ig * xc[i]);
        rp[i] = a; ip[i] = bb;
    }
}
__global__ void k_scan(const float* __restrict__ a, const float* __restrict__ b, const float* __restrict__ xw, float* __restrict__ y) {
    const int idx = blockIdx.x * blockDim.x + threadIdx.x;
    const int bb = idx / D_, c = idx % D_;
    float h = 0.f;
    for (int t = 0; t < L_; ++t) {
        const size_t row = (size_t)bb * L_ + t;
        h = a[row * D_ + c] * h + b[row * D_ + c];
        const float g = xw[row * (2 * D_) + D_ + c];
        const float gl = 0.5f * g * (1.f + tanhf(0.7978845608028654f * (g + 0.044715f * g * g * g)));
        y[row * D_ + c] = h * gl;
    }
}
__global__ void k_swiglu(const float* __restrict__ G, const float* __restrict__ U, float* __restrict__ A, size_t n) {
    for (size_t i = (size_t)blockIdx.x * blockDim.x + threadIdx.x; i < n; i += (size_t)gridDim.x * blockDim.x) { const float g = G[i]; A[i] = g * sigmoidf_(g) * U[i]; }
}
__global__ void k_lambda(const float* q1, const float* k1, const float* q2, const float* k2, float lambda_init, float* out) {
    __shared__ float red[8];
    float s1 = q1[threadIdx.x] * k1[threadIdx.x], s2 = q2[threadIdx.x] * k2[threadIdx.x];
    s1 = block_sum(s1, red); s2 = block_sum(s2, red);
    if (threadIdx.x == 0) out[0] = expf(s1) - expf(s2) + lambda_init;
}
__global__ __launch_bounds__(256) void k_attn(const float* __restrict__ q, const float* __restrict__ kv, const float* __restrict__ lamp, float* __restrict__ o) {
    __shared__ float q1[HD], q2[HD], s1[L_], s2[L_], red[8];
    const int s = blockIdx.x, h = blockIdx.y, b = blockIdx.z, tid = threadIdx.x;
    const float* qrow = q + ((size_t)b * S_ + s) * D_;
    const float sc = 0.08838834764831845f;
    if (tid < HD) { q1[tid] = qrow[h * HD + tid] * sc; q2[tid] = qrow[1024 + h * HD + tid] * sc; }
    __syncthreads();
    const int qp = NM + s, nk = qp + 1;
    const float slope = exp2f(-(float)(h + 1));
    float m1 = -INFINITY, m2 = -INFINITY;
    for (int k = tid; k < nk; k += 256) {
        const float* kr = kv + ((size_t)b * L_ + k) * 4096;
        float d1 = 0.f, d2 = 0.f;
        for (int d = 0; d < HD; ++d) { d1 += q1[d] * kr[h * HD + d]; d2 += q2[d] * kr[1024 + h * HD + d]; }
        const float bias = -slope * (float)(qp - k);
        d1 += bias; d2 += bias; s1[k] = d1; s2[k] = d2; m1 = fmaxf(m1, d1); m2 = fmaxf(m2, d2);
    }
    for (int o2 = 32; o2 >= 1; o2 >>= 1) { m1 = fmaxf(m1, __shfl_xor(m1, o2)); m2 = fmaxf(m2, __shfl_xor(m2, o2)); }
    __syncthreads();
    if ((tid & 63) == 0) { red[tid >> 6] = m1; red[4 + (tid >> 6)] = m2; }
    __syncthreads();
    m1 = fmaxf(fmaxf(red[0], red[1]), fmaxf(red[2], red[3])); m2 = fmaxf(fmaxf(red[4], red[5]), fmaxf(red[6], red[7]));
    float l1 = 0.f, l2 = 0.f;
    for (int k = tid; k < nk; k += 256) { const float e1 = expf(s1[k] - m1), e2 = expf(s2[k] - m2); s1[k] = e1; s2[k] = e2; l1 += e1; l2 += e2; }
    l1 = block_sum(l1, red); l2 = block_sum(l2, red);
    const float lam = lamp[0], i1 = 1.f / l1, i2 = lam / l2;
    __syncthreads();
    float acc = 0.f;
    for (int k = 0; k < nk; ++k) { const float p = s1[k] * i1 - s2[k] * i2; acc += p * kv[((size_t)b * L_ + k) * 4096 + 2048 + h * VD + tid]; }
    o[((size_t)b * S_ + s) * D_ + h * VD + tid] = acc;
}
__global__ __launch_bounds__(256) void k_router(const float* __restrict__ u, const float* __restrict__ router, float* __restrict__ gates) {
    __shared__ float red[8]; __shared__ float lg[E_];
    const float* ur = u + (size_t)blockIdx.x * D_;
    float p[E_];
#pragma unroll
    for (int e = 0; e < E_; ++e) p[e] = 0.f;
    for (int c = threadIdx.x; c < D_; c += 256) { const float v = ur[c];
#pragma unroll
        for (int e = 0; e < E_; ++e) p[e] += v * router[c * E_ + e]; }
#pragma unroll
    for (int e = 0; e < E_; ++e) { const float s = block_sum(p[e], red); if (threadIdx.x == 0) lg[e] = s; }
    __syncthreads();
    if (threadIdx.x == 0) {
        int i1 = 0; float v1 = lg[0];
        for (int e = 1; e < E_; ++e) if (lg[e] > v1) { v1 = lg[e]; i1 = e; }
        int i2 = -1; float v2 = -INFINITY;
        for (int e = 0; e < E_; ++e) if (e != i1 && lg[e] > v2) { v2 = lg[e]; i2 = e; }
        const float e2 = expf(v2 - v1), w1 = 1.f / (1.f + e2), w2 = e2 / (1.f + e2);
        for (int e = 0; e < E_; ++e) gates[(size_t)blockIdx.x * E_ + e] = (e == i1) ? w1 : (e == i2 ? w2 : 0.f);
    }
}
__global__ void k_moe_acc(float* __restrict__ yacc, const float* __restrict__ Y, const float* __restrict__ gates, int e, int first) {
    const size_t row = blockIdx.x; const float g = gates[row * E_ + e];
    for (int c = threadIdx.x; c < D_; c += blockDim.x) { const size_t i = row * D_ + c; yacc[i] = (first ? 0.f : yacc[i]) + g * Y[i]; }
}
__global__ void k_add(float* __restrict__ a, const float* __restrict__ b, size_t n) {
    for (size_t i = (size_t)blockIdx.x * blockDim.x + threadIdx.x; i < n; i += (size_t)gridDim.x * blockDim.x) a[i] += b[i];
}

static void gemm(hipStream_t st, const float* A, int lda, const float* Bm, int ldb, float* C, int ldc, int M, int N, int K, const float* R, int ldr) {
    dim3 grid((N + 63) / 64, (M + 63) / 64);
    hipLaunchKernelGGL(k_gemm, grid, dim3(256), 0, st, A, lda, Bm, ldb, C, ldc, M, N, K, R, ldr);
}
}

extern "C" void kernel_launch(void* const* d_in, const int* in_sizes, int n_in, void* d_out, int out_size, void* d_ws, size_t ws_size, hipStream_t stream) {
    using namespace nv;
    const float* x = (const float*)d_in[0]; const float* meta = (const float*)d_in[1];
    const float* a_norm = (const float*)d_in[2]; const float* a_w_in = (const float*)d_in[3]; const float* a_conv_w = (const float*)d_in[4]; const float* a_conv_b = (const float*)d_in[5];
    const float* a_w_rg = (const float*)d_in[6]; const float* a_b_rg = (const float*)d_in[7]; const float* a_w_ig = (const float*)d_in[8]; const float* a_b_ig = (const float*)d_in[9];
    const float* a_lambda = (const float*)d_in[10]; const float* a_w_out = (const float*)d_in[11]; const float* kv_norm = (const float*)d_in[12]; const float* w_kv = (const float*)d_in[13];
    const float* b_norm = (const float*)d_in[14]; const float* b_w_q = (const float*)d_in[15]; const float* lq1 = (const float*)d_in[16]; const float* lk1 = (const float*)d_in[17];
    const float* lq2 = (const float*)d_in[18]; const float* lk2 = (const float*)d_in[19]; const float* b_subln = (const float*)d_in[20]; const float* b_w_out = (const float*)d_in[21];
    const float* ffn_norm = (const float*)d_in[22]; const float* ffn_wg = (const float*)d_in[23]; const float* ffn_wu = (const float*)d_in[24]; const float* ffn_wd = (const float*)d_in[25];
    const float* moe_router = (const float*)d_in[26]; const float* moe_wg = (const float*)d_in[27]; const float* moe_wu = (const float*)d_in[28]; const float* moe_wd = (const float*)d_in[29];
    const float* final_norm = (const float*)d_in[30];
    float* out = (float*)d_out;
    char* ws = (char*)d_ws; size_t off = 0;
    auto alloc = [&](size_t bytes) { char* p = ws + off; off += (bytes + 255) & ~(size_t)255; return (float*)p; };
    float* h = alloc((size_t)ML * D_ * 4);
    float* u = alloc((size_t)ML * D_ * 4);
    float* R1 = alloc((size_t)2 * ML * F_ * 4);
    float* kv = alloc((size_t)ML * 4096 * 4);
    float* q = alloc((size_t)MS * D_ * 4);
    float* o = alloc((size_t)MS * D_ * 4);
    float* h2 = alloc((size_t)MS * D_ * 4);
    float* Y = alloc((size_t)MS * D_ * 4);
    float* yacc = alloc((size_t)MS * D_ * 4);
    float* gates = alloc((size_t)MS * E_ * 4);
    float* lamp = alloc(256);
    if (off > ws_size) { fprintf(stderr, "ws too small: need %zu have %zu\n", off, ws_size); return; }
    float* xw = R1; float* xc = xw + (size_t)ML * 4096; float* rp = xc + (size_t)ML * D_; float* ip = rp + (size_t)ML * D_;
    float* G = R1; float* U = R1 + (size_t)ML * F_;

    hipLaunchKernelGGL(k_concat, dim3(ML), dim3(256), 0, stream, x, meta, h);
    hipLaunchKernelGGL(k_rmsnorm, dim3(ML), dim3(256), 0, stream, h, (size_t)D_, a_norm, u, (size_t)D_, D_, 1.f);
    gemm(stream, u, D_, a_w_in, 4096, xw, 4096, ML, 4096, D_, nullptr, 0);
    hipLaunchKernelGGL(k_conv, dim3(ML), dim3(256), 0, stream, xw, a_conv_w, a_conv_b, xc);
    for (int g = 0; g < 16; ++g) {
        gemm(stream, xc + g * 128, D_, a_w_rg + (size_t)g * 128 * 128, 128, rp + g * 128, D_, ML, 128, 128, nullptr, 0);
        gemm(stream, xc + g * 128, D_, a_w_ig + (size_t)g * 128 * 128, 128, ip + g * 128, D_, ML, 128, 128, nullptr, 0);
    }
    hipLaunchKernelGGL(k_ab, dim3(ML), dim3(256), 0, stream, rp, ip, xc, a_b_rg, a_b_ig, a_lambda);
    hipLaunchKernelGGL(k_scan, dim3(B_ * D_ / 256), dim3(256), 0, stream, rp, ip, xw, u);
    gemm(stream, u, D_, a_w_out, D_, h, D_, ML, D_, D_, h, D_);
    hipLaunchKernelGGL(k_rmsnorm, dim3(ML), dim3(256), 0, stream, h, (size_t)D_, ffn_norm, u, (size_t)D_, D_, 1.f);
    gemm(stream, u, D_, ffn_wg, F_, G, F_, ML, F_, D_, nullptr, 0);
    gemm(stream, u, D_, ffn_wu, F_, U, F_, ML, F_, D_, nullptr, 0);
    hipLaunchKernelGGL(k_swiglu, dim3(4096), dim3(256), 0, stream, G, U, G, (size_t)ML * F_);
    gemm(stream, G, F_, ffn_wd, D_, h, D_, ML, D_, F_, h, D_);
    hipLaunchKernelGGL(k_rmsnorm, dim3(ML), dim3(256), 0, stream, h, (size_t)D_, kv_norm, u, (size_t)D_, D_, 1.f);
    gemm(stream, u, D_, w_kv, 4096, kv, 4096, ML, 4096, D_, nullptr, 0);
    for (int b = 0; b < B_; ++b) hipMemcpyAsync(h2 + (size_t)b * S_ * D_, h + ((size_t)b * L_ + NM) * D_, (size_t)S_ * D_ * 4, hipMemcpyDeviceToDevice, stream);
    const float lambda_init = 0.8f - 0.6f * expf(-0.3f * 1.0f);
    hipLaunchKernelGGL(k_lambda, dim3(1), dim3(128), 0, stream, lq1, lk1, lq2, lk2, lambda_init, lamp);
    hipLaunchKernelGGL(k_rmsnorm, dim3(MS), dim3(256), 0, stream, h2, (size_t)D_, b_norm, u, (size_t)D_, D_, 1.f);
    gemm(stream, u, D_, b_w_q, D_, q, D_, MS, D_, D_, nullptr, 0);
    hipLaunchKernelGGL(k_attn, dim3(S_, H_, B_), dim3(256), 0, stream, q, kv, lamp, o);
    hipLaunchKernelGGL(k_rmsnorm, dim3(MS * H_), dim3(64), 0, stream, o, (size_t)VD, b_subln, u, (size_t)VD, VD, 1.f - lambda_init);
    gemm(stream, u, D_, b_w_out, D_, h2, D_, MS, D_, D_, h2, D_);
    hipLaunchKernelGGL(k_rmsnorm, dim3(MS), dim3(256), 0, stream, h2, (size_t)D_, ffn_norm + D_, u, (size_t)D_, D_, 1.f);
    hipLaunchKernelGGL(k_router, dim3(MS), dim3(256), 0, stream, u, moe_router, gates);
    for (int e = 0; e < E_; ++e) {
        gemm(stream, u, D_, moe_wg + (size_t)e * D_ * F_, F_, G, F_, MS, F_, D_, nullptr, 0);
        gemm(stream, u, D_, moe_wu + (size_t)e * D_ * F_, F_, U, F_, MS, F_, D_, nullptr, 0);
        hipLaunchKernelGGL(k_swiglu, dim3(4096), dim3(256), 0, stream, G, U, G, (size_t)MS * F_);
        gemm(stream, G, F_, moe_wd + (size_t)e * F_ * D_, D_, Y, D_, MS, D_, F_, nullptr, 0);
        hipLaunchKernelGGL(k_moe_acc, dim3(MS), dim3(256), 0, stream, yacc, Y, gates, e, e == 0 ? 1 : 0);
    }
    hipLaunchKernelGGL(k_add, dim3(4096), dim3(256), 0, stream, h2, yacc, (size_t)MS * D_);
    hipLaunchKernelGGL(k_rmsnorm, dim3(MS), dim3(256), 0, stream, h2, (size_t)D_, final_norm, out, (size_t)D_, D_, 1.f);
}
```

```cpp
#include <hip/hip_runtime.h>
#include <cstdio>
#include <cstdint>

namespace pg8 {
#define PG8_LAS __attribute__((address_space(3)))
typedef unsigned short bf16_t;
typedef short bf16x8 __attribute__((ext_vector_type(8)));
typedef float f32x4 __attribute__((ext_vector_type(4)));
typedef unsigned u32x4 __attribute__((ext_vector_type(4)));
constexpr int BM = 256, BK = 64, HALF = 128, HTB = HALF * BK * 2  , STAGE_BYTES = 8 * HTB, NXCD = 8, WGM = 8;

__host__ __device__ __forceinline__ int lds_byte(int r, int c) { const int st = (r >> 4) * 2 + (c >> 5), rr = r & 15, cc = c & 31, ob = rr * 64 + cc * 2; return st * 1024 + (ob ^ (((ob >> 9) & 1) << 5)); }
__host__ __device__ __forceinline__ void stage_rc(int b, int& R, int& C) { const int st = b / 1024, sb = b % 1024, swz = sb ^ (((sb >> 9) & 1) << 5); R = (st >> 1) * 16 + swz / 64; C = (st & 1) * 32 + (swz % 64) / 2; }
__host__ __device__ __forceinline__ int perm32(int rho) { const int n = rho >> 4, i = rho & 15; return 8 * (i >> 2) + 4 * n + (i & 3); }

struct Unit { int pm, pn, e; };
struct Gemm { const bf16_t* A; const bf16_t* Bt; int K; size_t estride; };

struct StaticOrder {
    int nM, nN, nwg, G, c;
    __host__ __device__ void init(int M, int N, int G_, int c_) { nM = M / BM; nN = N / BM; nwg = nM * nN; G = G_; c = c_; }
    __host__ __device__ bool next(int i, Unit& u) const {
        const long L = (long)i * G + c; if (L >= nwg) return false;
        int wgid = (int)L; { const int q = nwg / NXCD, r = nwg % NXCD, xcd = wgid % NXCD, off = wgid / NXCD; wgid = (xcd < r ? xcd * (q + 1) : r * (q + 1) + (xcd - r) * q) + off; }
        const int nig = WGM * nN, gid = wgid / nig, fm = gid * WGM, gsz = (nM - fm) < WGM ? (nM - fm) : WGM;
        u.pm = fm + ((wgid % nig) % gsz); u.pn = (wgid % nig) / gsz; u.e = 0; return true;
    }
    __device__ __forceinline__ void a_ready(const Unit&) const {}
    __device__ __forceinline__ void done(const Unit&) const {}
};
struct GroupedOrder {
    int nM, nN, nwg, G, c; const int* pe;
    __device__ __forceinline__ bool next(int i, Unit& u) const {
        const long L = (long)i * G + c; if (L >= nwg) return false;
        int wgid = (int)L; { const int q = nwg / NXCD, r = nwg % NXCD, xcd = wgid % NXCD, off = wgid / NXCD; wgid = (xcd < r ? xcd * (q + 1) : r * (q + 1) + (xcd - r) * q) + off; }
        const int nig = WGM * nN, gid = wgid / nig, fm = gid * WGM, gsz = (nM - fm) < WGM ? (nM - fm) : WGM;
        u.pm = fm + ((wgid % nig) % gsz); u.pn = (wgid % nig) / gsz; u.e = __builtin_amdgcn_readfirstlane(pe[u.pm]); return true;
    }
    __device__ __forceinline__ void a_ready(const Unit&) const {}
    __device__ __forceinline__ void done(const Unit&) const {}
};

__device__ __forceinline__ unsigned cvt_pk_bf16(float lo, float hi) { unsigned r; asm volatile("v_cvt_pk_bf16_f32 %0, %1, %2" : "=v"(r) : "v"(lo), "v"(hi)); return r; }
typedef float f32x2 __attribute__((ext_vector_type(2)));

struct EpiBf16 {
    static constexpr bool PERM = true, AFTER_DRAIN = false;
    bf16_t* O; int ldc;
    __device__ __forceinline__ void operator()(const f32x4 (&acc)[2][2][4][2], const Unit& u, int wr, int wc, int fr, int fq) const {
        const int row0 = u.pm * BM + wr * 64 + fr; const int col0 = u.pn * BM + wc * 32 + 8 * fq;
#pragma unroll
        for (int ai = 0; ai < 2; ++ai)
#pragma unroll
            for (int m = 0; m < 4; ++m) { bf16_t* rowp = O + (size_t)(row0 + ai * HALF + m * 16) * ldc + col0;
#pragma unroll
                for (int bj = 0; bj < 2; ++bj) { const f32x4 v0 = acc[ai][bj][m][0], v1 = acc[ai][bj][m][1];
                    u32x4 w; w.x = cvt_pk_bf16(v0[0], v0[1]); w.y = cvt_pk_bf16(v0[2], v0[3]); w.z = cvt_pk_bf16(v1[0], v1[1]); w.w = cvt_pk_bf16(v1[2], v1[3]);
                    *(u32x4*)(rowp + bj * HALF) = w; } }
    }
};
struct EpiSwiglu {
    static constexpr bool PERM = true, AFTER_DRAIN = false;
    bf16_t* O; int ldc;
    __device__ __forceinline__ void operator()(const f32x4 (&acc)[2][2][4][2], const Unit& u, int wr, int wc, int fr, int fq) const {
        const int row0 = u.pm * BM + wr * 64 + fr; const int col0 = u.pn * HALF + wc * 32 + 8 * fq;
#pragma unroll
        for (int ai = 0; ai < 2; ++ai)
#pragma unroll
            for (int m = 0; m < 4; ++m) { bf16_t* rowp = O + (size_t)(row0 + ai * HALF + m * 16) * ldc + col0;
                float r[8];
#pragma unroll
                for (int n = 0; n < 2; ++n)
#pragma unroll
                    for (int j = 0; j < 4; ++j) { const float g = acc[ai][0][m][n][j], up = acc[ai][1][m][n][j];
                        r[n * 4 + j] = g * __builtin_amdgcn_rcpf(1.0f + __builtin_amdgcn_exp2f(-1.4426950408889634f * g)) * up; }
                u32x4 w; w.x = cvt_pk_bf16(r[0], r[1]); w.y = cvt_pk_bf16(r[2], r[3]); w.z = cvt_pk_bf16(r[4], r[5]); w.w = cvt_pk_bf16(r[6], r[7]);
                *(u32x4*)rowp = w; }
    }
};
template <int MAP> struct EpiResF32 {
    static constexpr bool PERM = false, AFTER_DRAIN = false;
    const float* base; float* out; int ldc;
    __device__ __forceinline__ void operator()(const f32x4 (&acc)[2][2][4][2], const Unit& u, int wr, int wc, int fr, int fq) const {
        const int row0 = u.pm * BM + wr * 64 + fr, col0 = u.pn * BM + wc * 32 + 4 * fq;
#pragma unroll
        for (int ai = 0; ai < 2; ++ai)
#pragma unroll
            for (int m = 0; m < 4; ++m) { const int r = row0 + ai * HALF + m * 16; const int br = MAP == 1 ? r + 16 * ((r >> 11) + 1) : r;
                const float* bp = base + (size_t)br * ldc + col0; float* op = out + (size_t)r * ldc + col0;
#pragma unroll
                for (int bj = 0; bj < 2; ++bj)
#pragma unroll
                    for (int n = 0; n < 2; ++n) { const f32x4 b = *(const f32x4*)(bp + bj * HALF + n * 16); *(f32x4*)(op + bj * HALF + n * 16) = b + acc[ai][bj][m][n]; } }
    }
};

template <class Epi, class Sched, bool ALIGN_EPI = false, bool SP2 = false>
__device__ __forceinline__ void gemm_phase(PG8_LAS unsigned char* lds, const Gemm g, const Sched& S, const Epi& E) {
    const int tid = threadIdx.x, wid = __builtin_amdgcn_readfirstlane(tid >> 6), lane = tid & 63, wr = wid >> 2, wc = wid & 3, fr = lane & 15, fq = lane >> 4;
    const int K = g.K, nt = K / BK;
    unsigned voffA[2], voffB[2];
#pragma unroll
    for (int i = 0; i < 2; ++i) { int R, C; stage_rc(tid * 16 + i * 8192, R, C); const int Rb = Epi::PERM ? ((R & ~31) + perm32(R & 31)) : R;
        voffA[i] = (unsigned)(R * K + C) * 2u; voffB[i] = (unsigned)(Rb * K + C) * 2u; }
    const size_t kstep = (size_t)(BK * 2);
    const size_t hstep = (size_t)HALF * K * 2;
    const size_t tstep = 2 * hstep;
    const unsigned ldsw = (unsigned)wid * 1024u;
    const int aoff = lds_byte(wr * 64 + fr, fq * 8), boff = lds_byte(wc * 32 + fr, fq * 8);
#define PG8_SA(b, h) (((b) * 2 + (h)) * HTB)
#define PG8_SB(b, h) ((4 + (b) * 2 + (h)) * HTB)
#define PG8_STAGE(bufoff, gbase, voff) do { _Pragma("unroll") for (int _i = 0; _i < 2; ++_i) \
        __builtin_amdgcn_global_load_lds((const unsigned*)((const char*)(gbase) + (voff)[_i]), (PG8_LAS unsigned*)(lds + (bufoff) + ldsw + _i * 8192), 16, 0, 0); } while (0)
#define PG8_LDA(dst, b, h) do { _Pragma("unroll") for (int m = 0; m < 4; ++m) _Pragma("unroll") for (int k = 0; k < 2; ++k) dst[m][k] = *(const PG8_LAS bf16x8*)(lds + PG8_SA(b, h) + aoff + m * 2048 + k * 1024); } while (0)
#define PG8_LDB(dst, b, h) do { _Pragma("unroll") for (int n = 0; n < 2; ++n) _Pragma("unroll") for (int k = 0; k < 2; ++k) dst[n][k] = *(const PG8_LAS bf16x8*)(lds + PG8_SB(b, h) + boff + n * 2048 + k * 1024); } while (0)
#define PG8_MMA(ai, bj, At, Bt) do { __builtin_amdgcn_s_setprio(1); _Pragma("unroll") for (int m = 0; m < 4; ++m) _Pragma("unroll") for (int n = 0; n < 2; ++n) _Pragma("unroll") for (int k = 0; k < 2; ++k) \
        acc[ai][bj][m][n] = __builtin_amdgcn_mfma_f32_16x16x32_bf16(Bt[n][k], At[m][k], acc[ai][bj][m][n], 0, 0, 0); __builtin_amdgcn_s_setprio(0); } while (0)
#define PG8_WAIT_V(n) asm volatile("s_waitcnt vmcnt(" #n ")" ::: "memory")
#define PG8_WAIT_L(n) asm volatile("s_waitcnt lgkmcnt(" #n ")" ::: "memory")
#define PG8_BAR __builtin_amdgcn_s_barrier()
#define PG8_SCHED __builtin_amdgcn_sched_barrier(0)
    Unit cur, nxt; int ui = 0;
    if (!S.next(0, cur)) return;
    f32x4 acc[2][2][4][2];
#pragma unroll
    for (int a = 0; a < 2; ++a)
#pragma unroll
        for (int b = 0; b < 2; ++b)
#pragma unroll
            for (int m = 0; m < 4; ++m)
#pragma unroll
                for (int n = 0; n < 2; ++n) acc[a][b][m][n] = (f32x4){0.f, 0.f, 0.f, 0.f};
    bf16x8 At[4][2], B0[2][2], B1[2][2];
    const char* cA = (const char*)g.A + (size_t)cur.pm * tstep; const char* cB = (const char*)g.Bt + (size_t)cur.e * g.estride + (size_t)cur.pn * tstep;
    S.a_ready(cur);
    if constexpr (SP2) {
        PG8_STAGE(PG8_SB(0, 0), cB, voffB); PG8_STAGE(PG8_SB(0, 1), cB + hstep, voffB); PG8_STAGE(PG8_SA(0, 0), cA, voffA); PG8_STAGE(PG8_SA(0, 1), cA + hstep, voffA);
        if (wr == 1) PG8_BAR;
        PG8_WAIT_V(2); PG8_BAR;
        PG8_STAGE(PG8_SB(1, 0), cB + kstep, voffB); PG8_STAGE(PG8_SA(1, 0), cA + kstep, voffA); PG8_STAGE(PG8_SB(1, 1), cB + hstep + kstep, voffB);
        PG8_WAIT_V(6); PG8_BAR;
    } else {
        PG8_STAGE(PG8_SB(0, 0), cB, voffB); PG8_STAGE(PG8_SA(0, 0), cA, voffA); PG8_STAGE(PG8_SB(0, 1), cB + hstep, voffB); PG8_STAGE(PG8_SA(0, 1), cA + hstep, voffA);
        if (wr == 1) PG8_BAR;
        PG8_WAIT_V(4); PG8_BAR;
        PG8_STAGE(PG8_SB(1, 0), cB + kstep, voffB); PG8_STAGE(PG8_SA(1, 0), cA + kstep, voffA); PG8_STAGE(PG8_SB(1, 1), cB + hstep + kstep, voffB);
        PG8_WAIT_V(6); PG8_BAR;
    }
    for (;;) {
        const bool has_next = S.next(ui + 1, nxt);
        const char* nA = has_next ? (const char*)g.A + (size_t)nxt.pm * tstep : cA; const char* nB = has_next ? (const char*)g.Bt + (size_t)nxt.e * g.estride + (size_t)nxt.pn * tstep : cB;
        for (int t = 0; t < nt; t += 2) {
            const bool last = (t == nt - 2);
            const char* a1 = cA + (size_t)(t + 1) * kstep;
            const char* a2 = last ? nA : cA + (size_t)(t + 2) * kstep; const char* b2 = last ? nB : cB + (size_t)(t + 2) * kstep;
            const char* a3 = a2 + kstep; const char* b3 = b2 + kstep;
            if (last && has_next) S.a_ready(nxt);
            if constexpr (SP2) {
            PG8_LDB(B0, 0, 0); PG8_LDB(B1, 0, 1); PG8_SCHED; PG8_LDA(At, 0, 0); PG8_STAGE(PG8_SA(1, 1), a1 + hstep, voffA);
            PG8_WAIT_V(8); PG8_WAIT_L(0); PG8_BAR; PG8_MMA(0, 0, At, B0); PG8_MMA(0, 1, At, B1); PG8_BAR; PG8_SCHED;
            PG8_LDA(At, 0, 1); PG8_STAGE(PG8_SB(0, 0), b2, voffB); PG8_STAGE(PG8_SB(0, 1), b2 + hstep, voffB); PG8_STAGE(PG8_SA(0, 0), a2, voffA);
            PG8_WAIT_V(8); PG8_WAIT_L(0); PG8_BAR; PG8_MMA(1, 0, At, B0); PG8_MMA(1, 1, At, B1); PG8_BAR; PG8_SCHED;
            PG8_LDB(B0, 1, 0); PG8_LDB(B1, 1, 1); PG8_SCHED; PG8_LDA(At, 1, 0); PG8_STAGE(PG8_SA(0, 1), a2 + hstep, voffA);
            PG8_WAIT_V(8); PG8_WAIT_L(0); PG8_BAR; PG8_MMA(0, 0, At, B0); PG8_MMA(0, 1, At, B1); PG8_BAR; PG8_SCHED;
            PG8_LDA(At, 1, 1); PG8_STAGE(PG8_SB(1, 0), b3, voffB); PG8_STAGE(PG8_SB(1, 1), b3 + hstep, voffB); PG8_STAGE(PG8_SA(1, 0), a3, voffA);
            PG8_WAIT_V(8); PG8_WAIT_L(0); PG8_BAR; PG8_MMA(1, 0, At, B0); PG8_MMA(1, 1, At, B1); PG8_BAR; PG8_SCHED;
            } else {
            PG8_LDB(B0, 0, 0); PG8_SCHED; PG8_LDA(At, 0, 0); PG8_STAGE(PG8_SA(1, 1), a1 + hstep, voffA);
            PG8_WAIT_L(8); PG8_BAR; PG8_WAIT_L(0); PG8_MMA(0, 0, At, B0); PG8_BAR; PG8_SCHED;
            PG8_LDB(B1, 0, 1); PG8_STAGE(PG8_SB(0, 0), b2, voffB);
            PG8_BAR; PG8_WAIT_L(0); PG8_MMA(0, 1, At, B1); PG8_BAR;
            PG8_LDA(At, 0, 1); PG8_STAGE(PG8_SA(0, 0), a2, voffA);
            PG8_BAR; PG8_WAIT_L(0); PG8_MMA(1, 0, At, B0); PG8_BAR; PG8_SCHED;
            PG8_STAGE(PG8_SB(0, 1), b2 + hstep, voffB);
            PG8_WAIT_V(6); PG8_BAR; PG8_MMA(1, 1, At, B1); PG8_BAR;
            PG8_LDB(B0, 1, 0); PG8_SCHED; PG8_LDA(At, 1, 0); PG8_STAGE(PG8_SA(0, 1), a2 + hstep, voffA);
            PG8_WAIT_L(8); PG8_BAR; PG8_WAIT_L(0); PG8_MMA(0, 0, At, B0); PG8_BAR; PG8_SCHED;
            PG8_LDB(B1, 1, 1); PG8_STAGE(PG8_SB(1, 0), b3, voffB);
            PG8_BAR; PG8_WAIT_L(0); PG8_MMA(0, 1, At, B1); PG8_BAR;
            PG8_LDA(At, 1, 1); PG8_STAGE(PG8_SA(1, 0), a3, voffA);
            PG8_BAR; PG8_WAIT_L(0); PG8_MMA(1, 0, At, B0); PG8_BAR; PG8_SCHED;
            PG8_STAGE(PG8_SB(1, 1), b3 + hstep, voffB);
            PG8_WAIT_V(6); PG8_BAR; PG8_MMA(1, 1, At, B1); PG8_BAR;
            }
        }
        if constexpr (ALIGN_EPI) { if (wr == 0) PG8_BAR; }
        if constexpr (!Epi::AFTER_DRAIN) { E(acc, cur, wr, wc, fr, fq); S.done(cur); }
        if (!has_next) break;
#pragma unroll
        for (int a = 0; a < 2; ++a)
#pragma unroll
            for (int b = 0; b < 2; ++b)
#pragma unroll
                for (int m = 0; m < 4; ++m)
#pragma unroll
                    for (int n = 0; n < 2; ++n) acc[a][b][m][n] = (f32x4){0.f, 0.f, 0.f, 0.f};
        cur = nxt; cA = nA; cB = nB; ++ui;
        if constexpr (ALIGN_EPI) { if (wr == 1) PG8_BAR; }
    }
    PG8_WAIT_V(0);
    if constexpr (!ALIGN_EPI) { if (wr == 0) PG8_BAR; }
    PG8_BAR;
    if constexpr (Epi::AFTER_DRAIN) { E.fused(acc, cur, wr, wc, fr, fq, lds, wid, lane); S.done(cur); }
#undef PG8_SA
#undef PG8_SB
#undef PG8_STAGE
#undef PG8_LDA
#undef PG8_LDB
#undef PG8_MMA
#undef PG8_WAIT_V
#undef PG8_WAIT_L
#undef PG8_BAR
#undef PG8_SCHED
}
}
#define GAS __attribute__((address_space(1)))
#define LAS __attribute__((address_space(3)))
typedef unsigned short bf16;
typedef unsigned v4u __attribute__((ext_vector_type(4)));
typedef float f32x4 __attribute__((ext_vector_type(4)));
typedef short bf16x8 __attribute__((ext_vector_type(8)));
typedef GAS unsigned gu32;
typedef GAS unsigned long long gu64;
#define RLX_AGENT __ATOMIC_RELAXED, __HIP_MEMORY_SCOPE_AGENT
#define LDS_WAIT() asm volatile("s_waitcnt lgkmcnt(0)" ::: "memory")
#define VM_WAIT() asm volatile("s_waitcnt vmcnt(0)" ::: "memory")
__device__ __forceinline__ unsigned long long rt() { return __builtin_amdgcn_s_memrealtime(); }
__device__ __forceinline__ unsigned f2bf(float f) { unsigned u = __builtin_bit_cast(unsigned, f); return (u + 0x7fffu + ((u >> 16) & 1u)) >> 16; }
__device__ __forceinline__ unsigned pk2(float lo, float hi) { return f2bf(lo) | (f2bf(hi) << 16); }

#define XB_TMO      128
#define XB_XCNT(j)  (256  + 64 * (j))
#define XB_XSUB(j)  (1280 + 64 * (j))
#define XB_XGEN(j)  (2304 + 64 * (j))
#define XB_TOP      3328
#define XB_TOPGEN   3392
#define XCD_BAR_WORDS 3456
#define XB_SPIN_CAP (1u << 22)

__device__ __forceinline__ unsigned xb_ld(unsigned* p)              { return __hip_atomic_load(p, __ATOMIC_RELAXED, __HIP_MEMORY_SCOPE_AGENT); }
__device__ __forceinline__ unsigned xb_add(unsigned* p, unsigned v) { return __hip_atomic_fetch_add(p, v, __ATOMIC_RELAXED, __HIP_MEMORY_SCOPE_AGENT); }
__device__ __forceinline__ unsigned xb_xcc_id() { return (unsigned)__builtin_amdgcn_s_getreg((3 << 11) | 20) & 0xFu; }
#define XB_SPIN(cond, bar) do { unsigned _sp = 0; while (cond) { __builtin_amdgcn_s_sleep(1); \
    if ((++_sp & 255u) == 0u) { if (xb_ld(&(bar)[XB_TMO])) break; if (_sp > XB_SPIN_CAP) { atomicAdd(&(bar)[XB_TMO], 1u); break; } } } } while (0)

struct XcdBarrier {
    unsigned* bar; unsigned x;
    volatile LAS unsigned* st;
};

__device__ __forceinline__ XcdBarrier xcd_barrier_post(unsigned* bar, volatile LAS unsigned* st) {
    XcdBarrier b; b.bar = bar; b.x = xb_xcc_id(); b.st = st;
    if (threadIdx.x == 0) (void)xb_add(&bar[XB_XCNT(b.x)], 1u);
    return b;
}
__device__ __forceinline__ void xcd_barrier_complete(unsigned* bar, unsigned x, unsigned& nloc, unsigned& nx) {
    const unsigned G = gridDim.x * gridDim.y * gridDim.z;
    unsigned sum, cnt, mine, sp = 0u;
    for (;;) {
        sum = 0u; cnt = 0u; mine = 0u;
#pragma unroll
        for (unsigned j = 0; j < 16; ++j) { const unsigned c = xb_ld(&bar[XB_XCNT(j)]); sum += c; cnt += (c > 0u) ? 1u : 0u; mine = (j == x) ? c : mine; }
        if (sum == G) break;
        __builtin_amdgcn_s_sleep(1);
        if ((++sp & 255u) == 0u) { if (xb_ld(&bar[XB_TMO])) break; if (sp > XB_SPIN_CAP) { atomicAdd(&bar[XB_TMO], 1u); break; } }
    }
    nloc = mine > 0u ? mine : 1u; nx = cnt > 0u ? cnt : 1u;
}

__device__ __forceinline__ void xcd_barrier(const XcdBarrier& b) {
    asm volatile("s_waitcnt vmcnt(0)" ::: "memory");
    __syncthreads();
    if (threadIdx.x == 0) {
        unsigned* bar = b.bar;
        __builtin_amdgcn_s_waitcnt(0);
        unsigned nloc = b.st[0], nx = b.st[1];
        if (nloc == 0u) { xcd_barrier_complete(bar, b.x, nloc, nx); b.st[0] = nloc; b.st[1] = nx; }
        const unsigned old = xb_add(&bar[XB_XSUB(b.x)], 1u);
        const unsigned gen = old / nloc;
        if (old + 1u == (gen + 1u) * nloc) {
            __builtin_amdgcn_fence(__ATOMIC_RELEASE, "agent");
            asm volatile("s_waitcnt vmcnt(0)" ::: "memory");
            const unsigned og = xb_add(&bar[XB_TOP], 1u);
            const unsigned tg = og / nx;
            if (og + 1u == (tg + 1u) * nx) xb_add(&bar[XB_TOPGEN], 1u);
            else XB_SPIN(xb_ld(&bar[XB_TOPGEN]) == tg, bar);
            __builtin_amdgcn_fence(__ATOMIC_ACQUIRE, "agent");
            xb_add(&bar[XB_XGEN(b.x)], 1u);
            asm volatile("s_waitcnt vmcnt(0)" ::: "memory");
        } else {
            XB_SPIN(xb_ld(&bar[XB_XGEN(b.x)]) == gen, bar);
            __builtin_amdgcn_fence(__ATOMIC_ACQUIRE, "agent");
            asm volatile("s_waitcnt vmcnt(0)" ::: "memory");
        }
    }
    __syncthreads();
}


constexpr int NB = 4, SEQ = 2048, DM = 2048, NMETA = 16, LSEQ = SEQ + NMETA, DFF = 5504, NH = 8, HDIM = 128, VDIM = 256, NEXP = 8;
constexpr int ML = NB * LSEQ;
constexpr int MLP = 8448;
constexpr int MS = NB * SEQ;
constexpr int NGU = 2 * DFF;
constexpr int MPERM = 18432;
constexpr float RMS_EPS = 1e-6f;
constexpr int NWAVES = 8;

constexpr size_t MiB = 1u << 20;
constexpr size_t WS_CTL = 0, CTL_ZERO_BYTES = 1 * MiB;
constexpr size_t WS_WKV = 1 * MiB;
constexpr size_t WS_WQ = WS_WKV + 16 * MiB;
constexpr size_t WS_WO2 = WS_WQ + 8 * MiB;
constexpr size_t WS_MGU = WS_WO2 + 8 * MiB;
constexpr size_t SZ_GU = (size_t)NGU * DM * 2;
constexpr size_t WS_MD = WS_MGU + 8 * SZ_GU;
constexpr size_t SZ_D = (size_t)DM * DFF * 2;
constexpr size_t WS_HBUF = WS_MD + 8 * SZ_D;
constexpr size_t WS_KVB = WS_HBUF + (size_t)MLP * DM * 4;
constexpr size_t WS_UQ = WS_KVB + (size_t)MLP * 4096 * 2;
constexpr size_t WS_QB = WS_UQ + (size_t)MS * DM * 2;
constexpr size_t WS_OB = WS_QB + (size_t)MS * DM * 2;
constexpr size_t WS_ON = WS_UQ;
constexpr size_t WS_H3 = WS_OB + (size_t)2 * MS * DM * 4;
constexpr size_t WS_UM = WS_QB;
constexpr size_t WS_MISC = WS_H3 + (size_t)MS * DM * 4;
constexpr size_t WS_R0 = WS_MISC + 4 * MiB;
constexpr size_t WS_WIN = WS_R0;
constexpr size_t WS_WG = WS_WIN + 16 * MiB;
constexpr size_t WS_WOUT = WS_WG + 1 * MiB;
constexpr size_t WS_WGU = WS_WOUT + 8 * MiB;
constexpr size_t WS_WD = WS_WGU + SZ_GU;
constexpr size_t WS_U = WS_WD + SZ_D;
constexpr size_t WS_XG = WS_U + (size_t)MLP * DM * 2;
constexpr size_t WS_HSL = WS_XG + (size_t)MLP * 4096 * 2;
constexpr size_t WS_PC = WS_HSL + (size_t)MLP * DM * 2;
constexpr size_t WS_CSUM = WS_PC + (size_t)MLP * DM * 2;
constexpr size_t WS_Y = WS_CSUM + 3 * MiB;
constexpr size_t WS_ACT = WS_Y + (size_t)MLP * DM * 2;
constexpr size_t WS_R0_L0END = WS_ACT + (size_t)MLP * DFF * 2;
constexpr size_t WS_XPERM = WS_R0;
constexpr size_t WS_ACTP = WS_XPERM + (size_t)MPERM * DM * 2;
constexpr size_t WS_YP = WS_ACTP + (size_t)MPERM * DFF * 2;
constexpr size_t WS_R0_MOEEND = WS_YP + (size_t)MPERM * DM * 2;
constexpr size_t WS_END = WS_R0_L0END > WS_R0_MOEEND ? WS_R0_L0END : WS_R0_MOEEND;
static_assert(WS_END <= (size_t)1442840576, "d_ws map exceeds the guaranteed workspace");
constexpr int CW_BAR = 4096;
constexpr int CW_CNT = 16384;
constexpr int CW_CUR = 16384 + 1024;

constexpr int SCR_BYTES = 133120;
constexpr int LDSCTL_OFF = SCR_BYTES, MISC_OFF = LDSCTL_OFF + 320;
constexpr int LDS_BYTES = 147456;
static_assert(MISC_OFF + 128 <= LDS_BYTES, "LDS map");

constexpr int NPHASE = 18;
struct Args { const float* in[31]; float* out; unsigned char* ws; int ph_lo, ph_hi; };
static_assert(sizeof(Args) == 33 * 8 + 8, "Args has no padding");
struct Ctx { LAS unsigned char* lds; int tid, lane, wave, G, gw, NGW; };

__device__ __forceinline__ float wave_sum(float v) {
#pragma unroll
    for (int o = 1; o < 64; o <<= 1) v += __shfl_xor(v, o);
    return v;
}
typedef unsigned long long u64;

template <int MODE>
__device__ __forceinline__ void transpose_item(const float* __restrict__ W, int K, int N, bf16* __restrict__ WT, LAS float* scr, int item, int lane) {
    const int nblk = N / 64, kb = item / nblk, nb = item % nblk, k0 = 64 * kb, n0 = 64 * nb;
    const float* src = W + (size_t)k0 * N + n0 + lane;
#pragma unroll 16
    for (int i = 0; i < 64; ++i) scr[i * 65 + lane] = src[(size_t)i * N];
    LDS_WAIT(); asm volatile("" ::: "memory");
    const int c = lane & 7, nl = lane >> 3;
    const int drow0 = MODE == 0 ? n0 : ((n0 >> 7) * 256 + (n0 & 127) + (MODE == 2 ? 128 : 0));
#pragma unroll
    for (int j = 0; j < 8; ++j) { const int n = nl + 8 * j; const LAS float* s = scr + (8 * c) * 65 + n;
        v4u o; o.x = pk2(s[0 * 65], s[1 * 65]); o.y = pk2(s[2 * 65], s[3 * 65]); o.z = pk2(s[4 * 65], s[5 * 65]); o.w = pk2(s[6 * 65], s[7 * 65]);
        *(GAS v4u*)(WT + (size_t)(drow0 + n) * K + k0 + 8 * c) = o; }
    LDS_WAIT(); asm volatile("" ::: "memory");
}
__device__ __forceinline__ void rms_row(const float* xrow, const float* __restrict__ g, bf16* orow, float* hcopy, int lane) {
    const GAS f32x4* xr = (const GAS f32x4*)xrow + lane; const GAS f32x4* gr = (const GAS f32x4*)g + lane;
    f32x4 v[8]; float s = 0.f;
#pragma unroll
    for (int j = 0; j < 8; ++j) { v[j] = xr[64 * j]; s += (v[j].x * v[j].x + v[j].y * v[j].y) + (v[j].z * v[j].z + v[j].w * v[j].w); }
    if (hcopy) { GAS f32x4* hc = (GAS f32x4*)hcopy + lane;
#pragma unroll
        for (int j = 0; j < 8; ++j) hc[64 * j] = v[j]; }
    const float rstd = 1.f / sqrtf(wave_sum(s) * (1.f / DM) + RMS_EPS);
    GAS u64* o8 = (GAS u64*)orow + lane;
#pragma unroll
    for (int j = 0; j < 8; ++j) { const f32x4 gg = gr[64 * j]; const f32x4 y = v[j] * rstd * gg;
        o8[64 * j] = (u64)pk2(y.x, y.y) | ((u64)pk2(y.z, y.w) << 32); }
}

__device__ __forceinline__ void rms_row2(const float* xrow, const float* __restrict__ g1, bf16* o1, const float* __restrict__ g2, bf16* o2, int lane) {
    const GAS f32x4* xr = (const GAS f32x4*)xrow + lane;
    f32x4 v[8]; float s = 0.f;
#pragma unroll
    for (int j = 0; j < 8; ++j) { v[j] = xr[64 * j]; s += (v[j].x * v[j].x + v[j].y * v[j].y) + (v[j].z * v[j].z + v[j].w * v[j].w); }
    const float rstd = 1.f / sqrtf(wave_sum(s) * (1.f / DM) + RMS_EPS);
    { const GAS f32x4* gr = (const GAS f32x4*)g1 + lane; GAS u64* o8 = (GAS u64*)o1 + lane;
#pragma unroll
      for (int j = 0; j < 8; ++j) { const f32x4 y = v[j] * rstd * gr[64 * j]; o8[64 * j] = (u64)pk2(y.x, y.y) | ((u64)pk2(y.z, y.w) << 32); } }
    if (o2) { const GAS f32x4* gr = (const GAS f32x4*)g2 + lane; GAS u64* o8 = (GAS u64*)o2 + lane;
#pragma unroll
      for (int j = 0; j < 8; ++j) { const f32x4 y = v[j] * rstd * gr[64 * j]; o8[64 * j] = (u64)pk2(y.x, y.y) | ((u64)pk2(y.z, y.w) << 32); } }
}

constexpr int P2_T = 48, P2_NCH = LSEQ / P2_T  , P2_UNITS = 16 * NB * P2_NCH  ;
constexpr int P2_XS = 0, P2_XCF = P2_XS + 51 * 128 * 4, P2_XCB = P2_XCF + 48 * 128 * 4, P2_AS = P2_XCB + 48 * 272, P2_BS = P2_AS + 48 * 128 * 4, P2_END = P2_BS + 48 * 128 * 4;
static_assert(P2_END <= SCR_BYTES, "P2 LDS");
__device__ __forceinline__ float sigmoid_fast(float x) { return __builtin_amdgcn_rcpf(1.0f + __builtin_amdgcn_exp2f(-1.4426950408889634f * x)); }
__device__ __forceinline__ void phase2(const Args& a, const Ctx& C) {
    unsigned char* ws = a.ws;
    const bf16* XG = (const bf16*)(ws + WS_XG); const bf16* WG = (const bf16*)(ws + WS_WG);
    bf16* HSL = (bf16*)(ws + WS_HSL); bf16* PCb = (bf16*)(ws + WS_PC); float* CS = (float*)(ws + WS_CSUM);
    LAS float* XS = (LAS float*)(C.lds + P2_XS); LAS float* XCF = (LAS float*)(C.lds + P2_XCF); LAS unsigned char* XCB = C.lds + P2_XCB;
    LAS float* AS = (LAS float*)(C.lds + P2_AS); LAS float* BS = (LAS float*)(C.lds + P2_BS);
    const int tid = C.tid, lane = C.lane, w = C.wave, fr = lane & 15, fq = lane >> 4;
    const int per = (P2_UNITS + C.G - 1) / C.G;
    for (int k = 0; k < per; ++k) {
        const int u = (int)blockIdx.x * per + k; if (u >= P2_UNITS) break;
        const int g = u / (NB * P2_NCH), rem = u - g * (NB * P2_NCH), b = rem / P2_NCH, c = rem - b * P2_NCH;
        const int t0 = c * P2_T; const size_t Rb = (size_t)b * LSEQ;
        bf16x8 wr_[4], wi_[4];
        { const bf16* wrow = WG + ((size_t)g * 256 + 16 * w + fr) * 128 + 8 * fq;
#pragma unroll
          for (int ks = 0; ks < 4; ++ks) { wr_[ks] = *(const GAS bf16x8*)(wrow + 32 * ks); wi_[ks] = *(const GAS bf16x8*)(wrow + 128 * 128 + 32 * ks); } }
#pragma unroll
        for (int p = 0; p < 2; ++p) { const int q = tid + 512 * p; if (q < 51 * 16) { const int j = q >> 4, c8 = q & 15; const int t = t0 - 3 + j;
            f32x4 lo = {0.f, 0.f, 0.f, 0.f}, hi = {0.f, 0.f, 0.f, 0.f};
            if (t >= 0) { const v4u raw = *(const GAS v4u*)(XG + (Rb + t) * 4096 + 128 * g + 8 * c8);
                lo = (f32x4){__uint_as_float(raw.x << 16), __uint_as_float(raw.x & 0xffff0000u), __uint_as_float(raw.y << 16), __uint_as_float(raw.y & 0xffff0000u)};
                hi = (f32x4){__uint_as_float(raw.z << 16), __uint_as_float(raw.z & 0xffff0000u), __uint_as_float(raw.w << 16), __uint_as_float(raw.w & 0xffff0000u)}; }
            *(LAS f32x4*)(XS + j * 128 + 8 * c8) = lo; *(LAS f32x4*)(XS + j * 128 + 8 * c8 + 4) = hi; } }
        __syncthreads();
        { const int ch4 = tid & 31, rsub = tid >> 5; const int gc = 128 * g + 4 * ch4;
          const f32x4 cb = *(const GAS f32x4*)(a.in[5] + gc);
          f32x4 cw[4];
#pragma unroll
          for (int kk = 0; kk < 4; ++kk) cw[kk] = *(const GAS f32x4*)(a.in[4] + kk * DM + gc);
#pragma unroll
          for (int rr = 0; rr < 3; ++rr) { const int row = rsub + 16 * rr; f32x4 y = cb;
#pragma unroll
              for (int kk = 0; kk < 4; ++kk) y += cw[kk] * *(const LAS f32x4*)(XS + (row + kk) * 128 + 4 * ch4);
              *(LAS f32x4*)(XCF + row * 128 + 4 * ch4) = y;
              typedef unsigned u32x2 __attribute__((ext_vector_type(2)));
              u32x2 pk; pk.x = pk2(y.x, y.y); pk.y = pk2(y.z, y.w);
              *(LAS u32x2*)(XCB + row * 272 + 8 * ch4) = pk; } }
        __syncthreads();
        f32x4 accR[3], accI[3];
#pragma unroll
        for (int mt = 0; mt < 3; ++mt) { accR[mt] = (f32x4){0.f, 0.f, 0.f, 0.f}; accI[mt] = (f32x4){0.f, 0.f, 0.f, 0.f}; }
#pragma unroll
        for (int ks = 0; ks < 4; ++ks)
#pragma unroll
            for (int mt = 0; mt < 3; ++mt) { const bf16x8 af = *(const LAS bf16x8*)(XCB + (16 * mt + fr) * 272 + 64 * ks + 16 * fq);
                accR[mt] = __builtin_amdgcn_mfma_f32_16x16x32_bf16(wr_[ks], af, accR[mt], 0, 0, 0);
                accI[mt] = __builtin_amdgcn_mfma_f32_16x16x32_bf16(wi_[ks], af, accI[mt], 0, 0, 0); }
        { const int ch0 = 16 * w + 4 * fq, gc = 128 * g + ch0;
          const f32x4 brg = *(const GAS f32x4*)(a.in[7] + gc), big = *(const GAS f32x4*)(a.in[9] + gc), lam = *(const GAS f32x4*)(a.in[10] + gc);
          f32x4 sp8;
#pragma unroll
          for (int j = 0; j < 4; ++j) sp8[j] = -8.0f * log1pf(__expf(-lam[j]));
#pragma unroll
          for (int mt = 0; mt < 3; ++mt) { const int row = 16 * mt + fr; const f32x4 xc = *(const LAS f32x4*)(XCF + row * 128 + ch0);
              f32x4 av, bv;
#pragma unroll
              for (int j = 0; j < 4; ++j) { const float r = sigmoid_fast(accR[mt][j] + brg[j]), ig = sigmoid_fast(accI[mt][j] + big[j]);
                  const float la = r * sp8[j]; av[j] = __expf(la); bv[j] = sqrtf(-expm1f(2.0f * la)) * (ig * xc[j]); }
              *(LAS f32x4*)(AS + row * 128 + ch0) = av; *(LAS f32x4*)(BS + row * 128 + ch0) = bv; } }
        __syncthreads();
        if (tid < 128) { float h = 0.f, P = 1.f; const size_t o0 = (Rb + t0) * DM + 128 * g + tid;
#pragma unroll 8
            for (int row = 0; row < P2_T; ++row) { const float av = AS[row * 128 + tid], bv = BS[row * 128 + tid]; h = av * h + bv; P *= av;
                HSL[o0 + (size_t)row * DM] = (bf16)f2bf(h); PCb[o0 + (size_t)row * DM] = (bf16)f2bf(P); }
            const size_t cs = ((size_t)b * P2_NCH + c) * DM + 128 * g + tid; CS[cs] = P; CS[(size_t)NB * P2_NCH * DM + cs] = h; }
        __syncthreads();
    }
}
__device__ __forceinline__ void phase3(const Args& a, const Ctx& C) {
    unsigned char* ws = a.ws;
    const bf16* XG = (const bf16*)(ws + WS_XG); const bf16* HSL = (const bf16*)(ws + WS_HSL); const bf16* PCb = (const bf16*)(ws + WS_PC); const float* CS = (const float*)(ws + WS_CSUM);
    bf16* Y = (bf16*)(ws + WS_Y);
    typedef unsigned u32x2 __attribute__((ext_vector_type(2)));
    for (int wu = C.gw; wu < NB * P2_NCH * 8; wu += C.NGW) {
        const int cb = wu & 7, bc = wu >> 3, b = bc / P2_NCH, c = bc - b * P2_NCH; const int ch = 256 * cb + 4 * C.lane;
        f32x4 carry = {0.f, 0.f, 0.f, 0.f};
        for (int cc = 0; cc < c; ++cc) { const size_t cs = ((size_t)b * P2_NCH + cc) * DM + ch;
            const f32x4 A = *(const GAS f32x4*)(CS + cs), H = *(const GAS f32x4*)(CS + (size_t)NB * P2_NCH * DM + cs); carry = A * carry + H; }
        const size_t r0 = (size_t)b * LSEQ + (size_t)c * P2_T;
#pragma unroll 4
        for (int row = 0; row < P2_T; ++row) { const size_t o = (r0 + row) * DM + ch;
            const u32x2 hs = *(const GAS u32x2*)(HSL + o), pc = *(const GAS u32x2*)(PCb + o), gg = *(const GAS u32x2*)(XG + (r0 + row) * 4096 + DM + ch);
            const f32x4 hv = {__uint_as_float(hs.x << 16), __uint_as_float(hs.x & 0xffff0000u), __uint_as_float(hs.y << 16), __uint_as_float(hs.y & 0xffff0000u)};
            const f32x4 pv = {__uint_as_float(pc.x << 16), __uint_as_float(pc.x & 0xffff0000u), __uint_as_float(pc.y << 16), __uint_as_float(pc.y & 0xffff0000u)};
            const f32x4 gv = {__uint_as_float(gg.x << 16), __uint_as_float(gg.x & 0xffff0000u), __uint_as_float(gg.y << 16), __uint_as_float(gg.y & 0xffff0000u)};
            f32x4 y;
#pragma unroll
            for (int j = 0; j < 4; ++j) { const float gx = gv[j]; const float z2 = 1.5957691216057308f * (gx + 0.044715f * gx * gx * gx);
                const float gl = gx * __builtin_amdgcn_rcpf(1.0f + __builtin_amdgcn_exp2f(-1.4426950408889634f * z2)); y[j] = (hv[j] + pv[j] * carry[j]) * gl; }
            u32x2 pk; pk.x = pk2(y.x, y.y); pk.y = pk2(y.z, y.w); *(GAS u32x2*)(Y + o) = pk; }
    }
}

namespace attn {
constexpr int D = 128;
constexpr float THR = 8.f;
constexpr bool WSKIP = false;
constexpr int QP = 2048, KVP = 4096, OP = 2048;
constexpr float SCALE = 0.08838834764831845f;
constexpr int NW = 8, QBLK = 32, KVBLK = 64, QB = NW * QBLK;
constexpr int SHM_V = KVBLK * D * 2, SHM_K = KVBLK * D * 2;
constexpr int LDS_BYTES = 2 * SHM_V + 2 * SHM_K + NW * 64 * 4;
typedef unsigned short bf16;
typedef short bf16x8 __attribute__((ext_vector_type(8)));
typedef short s16x4 __attribute__((ext_vector_type(4)));
typedef float f32x16 __attribute__((ext_vector_type(16)));
typedef float f32x4 __attribute__((ext_vector_type(4)));
typedef unsigned u32x4 __attribute__((ext_vector_type(4)));
template <class A, class Bt> struct same_t { static constexpr bool v = false; };
template <class A> struct same_t<A, A> { static constexpr bool v = true; };
#define KSWZ(row, colB) ((row) * 256 + ((colB) ^ (((row) & 7) << 4)))
#define SBAR() __builtin_amdgcn_sched_barrier(0)
__device__ __forceinline__ int v_st(int k, int c) { const int kk = (k & ~0xC) | ((k & 4) << 1) | ((k & 8) >> 1); return ((kk >> 3) * 4 + (c >> 5)) * 512 + ((kk & 7) * 32 + (c & 31)) * 2; }
__device__ __forceinline__ int v_rd_base(int lane) { return ((lane & 3) << 3) | (((lane >> 2) & 3) << 6) | (((lane >> 4) & 1) << 5) | (((lane >> 5) & 1) << 8); }
constexpr int v_rd_off(int d0, int ks, int half) { return d0 * 512 + ks * 4096 + half * 2048; }
__device__ __forceinline__ int crow(int r, int hi) { return (r & 3) + 8 * (r >> 2) + 4 * hi; }
__device__ __forceinline__ unsigned cvtpk(float lo, float hi) {
    unsigned r; asm volatile("v_cvt_pk_bf16_f32 %0, %1, %2" : "=v"(r) : "v"(lo), "v"(hi)); return r;
}
__device__ __forceinline__ bf16x8 pack8(f32x4 a, f32x4 b) {
    u32x4 w = {cvtpk(a[0], a[1]), cvtpk(a[2], a[3]), cvtpk(b[0], b[1]), cvtpk(b[2], b[3])};
    return *reinterpret_cast<bf16x8*>(&w);
}
template <class T> __device__ __forceinline__ bf16x8 load8(const T* p) {
    if constexpr (same_t<T, float>::v) { return pack8(*(const f32x4*)p, *(const f32x4*)(p + 4)); }
    else { return *reinterpret_cast<const bf16x8*>(p); }
}
__device__ __forceinline__ void bias_tile(f32x16& p0, f32x16& p1, float cb, float b0) {
    const float b1 = fmaf(cb, 32.f, b0);
#pragma unroll
    for (int r = 0; r < 16; ++r) { const float c = (float)((r & 3) + 8 * (r >> 2)); p0[r] += fmaf(cb, c, b0); p1[r] += fmaf(cb, c, b1); }
}
__device__ __forceinline__ void mask_tile(f32x16& p0, f32x16& p1, int dq, unsigned W) {
    const float NEG = -__builtin_inff();
#pragma unroll
    for (int r = 0; r < 16; ++r) {
        const int c = (r & 3) + 8 * (r >> 2);
        if ((unsigned)(dq - c) >= W) p0[r] = NEG;
        if ((unsigned)(dq - c - 32) >= W) p1[r] = NEG;
    }
}
__device__ __forceinline__ void partialSM(f32x16& p0, f32x16& p1, float& m_reg, float& mn, float& alpha) {
    float pmax = p0[0]; for (int r = 1; r < 16; ++r) pmax = fmaxf(pmax, p0[r]); for (int r = 0; r < 16; ++r) pmax = fmaxf(pmax, p1[r]);
    { auto rr = __builtin_amdgcn_permlane32_swap(__float_as_uint(pmax), __float_as_uint(pmax), false, false);
      pmax = fmaxf(__uint_as_float(rr[0]), __uint_as_float(rr[1])); }
    constexpr float C2 = 1.4426950408889634f * SCALE;
    if (__builtin_expect(__all((pmax - m_reg) * SCALE <= THR), 1)) { mn = m_reg; alpha = 1.f; }
    else { mn = fmaxf(m_reg, pmax); alpha = __builtin_amdgcn_exp2f((m_reg - mn) * C2); m_reg = mn; }
    const float mnL = -mn * C2;
    for (int r = 0; r < 16; ++r) p0[r] = fmaf(p0[r], C2, mnL); for (int r = 0; r < 16; ++r) p1[r] = fmaf(p1[r], C2, mnL);
    for (int r = 0; r < 16; ++r) p0[r] = __builtin_amdgcn_exp2f(p0[r]);
}
__device__ __forceinline__ void finishSM(f32x16& p0, f32x16& p1, float alpha, float& l_reg, bf16x8& pa0, bf16x8& pa1, bf16x8& pa2, bf16x8& pa3) {
    for (int r = 0; r < 16; ++r) p1[r] = __builtin_amdgcn_exp2f(p1[r]);
    float ps = 0; for (int r = 0; r < 16; ++r) ps += p0[r]; for (int r = 0; r < 16; ++r) ps += p1[r];
    { auto rr = __builtin_amdgcn_permlane32_swap(__float_as_uint(ps), __float_as_uint(ps), false, false);
      ps = __uint_as_float(rr[0]) + __uint_as_float(rr[1]); }
    l_reg = l_reg * alpha + ps;
#define PK4(P, B_, OUT) do { unsigned a0 = cvtpk(P[B_+0], P[B_+1]), a1 = cvtpk(P[B_+2], P[B_+3]);                          \
        unsigned b0 = cvtpk(P[B_+4], P[B_+5]), b1 = cvtpk(P[B_+6], P[B_+7]);                                             \
        auto r0 = __builtin_amdgcn_permlane32_swap(a0, b0, false, false); auto r1 = __builtin_amdgcn_permlane32_swap(a1, b1, false, false); \
        u32x4 w = {r0[0], r1[0], r0[1], r1[1]}; OUT = *reinterpret_cast<bf16x8*>(&w); } while (0)
    PK4(p0, 0, pa0); PK4(p0, 8, pa1); PK4(p1, 0, pa2); PK4(p1, 8, pa3);
#undef PK4
}
template <int KB, bool SK>
__device__ __forceinline__ void qkt(f32x16& p0, f32x16& p1, const char* K_lds, int r32, int hi, const bf16x8* qr, bool act) {
    if (SK && !act) { const float NEG = -__builtin_inff();
#pragma unroll
        for (int r = 0; r < 16; ++r) { p0[r] = NEG; p1[r] = NEG; } return; }
    p0 = f32x16{}; p1 = f32x16{};
    const char* kb[4];
#pragma unroll
    for (int dd = 0; dd < 4; ++dd) kb[dd] = K_lds + KB * SHM_K + KSWZ(r32, (dd * 16 + hi * 8) * 2);
#pragma unroll
    for (int d0 = 0; d0 < 8; ++d0) { const char* a = kb[d0 & 3] + (d0 >> 2) * 128;
        bf16x8 b0 = *reinterpret_cast<const bf16x8*>(a);
        bf16x8 b1 = *reinterpret_cast<const bf16x8*>(a + 32 * 256);
        p0 = __builtin_amdgcn_mfma_f32_32x32x16_bf16(b0, qr[d0], p0, 0, 0, 0);
        p1 = __builtin_amdgcn_mfma_f32_32x32x16_bf16(b1, qr[d0], p1, 0, 0, 0); }
}
template <int VB, bool SK>
__device__ __forceinline__ void pv_tile(f32x16* o, int vb0, bf16x8 pa0, bf16x8 pa1, bf16x8 pa2, bf16x8 pa3, bool act) {
    if (SK && !act) return;
#define TRRD(dst, off) asm volatile("ds_read_b64_tr_b16 %0, %1 offset:%2" : "=&v"(dst) : "v"(vb0), "i"(off) : "memory")
#define PV_D0(d0) do { s16x4 l0, l1, l2, l3, h0, h1, h2, h3; constexpr int b_ = VB * SHM_V + v_rd_off(d0, 0, 0);     \
        TRRD(l0, b_); TRRD(h0, b_ + 2048); TRRD(l1, b_ + 4096); TRRD(h1, b_ + 6144); TRRD(l2, b_ + 8192); TRRD(h2, b_ + 10240); TRRD(l3, b_ + 12288); TRRD(h3, b_ + 14336); \
        asm volatile("s_waitcnt lgkmcnt(0)" ::: "memory"); SBAR();                 \
        o[d0] = __builtin_amdgcn_mfma_f32_32x32x16_bf16(pa0, (bf16x8){l0[0], l0[1], l0[2], l0[3], h0[0], h0[1], h0[2], h0[3]}, o[d0], 0, 0, 0);   \
        o[d0] = __builtin_amdgcn_mfma_f32_32x32x16_bf16(pa1, (bf16x8){l1[0], l1[1], l1[2], l1[3], h1[0], h1[1], h1[2], h1[3]}, o[d0], 0, 0, 0);   \
        o[d0] = __builtin_amdgcn_mfma_f32_32x32x16_bf16(pa2, (bf16x8){l2[0], l2[1], l2[2], l2[3], h2[0], h2[1], h2[2], h2[3]}, o[d0], 0, 0, 0);   \
        o[d0] = __builtin_amdgcn_mfma_f32_32x32x16_bf16(pa3, (bf16x8){l3[0], l3[1], l3[2], l3[3], h3[0], h3[1], h3[2], h3[3]}, o[d0], 0, 0, 0); } while (0)
    PV_D0(0); PV_D0(1); PV_D0(2); PV_D0(3);
#undef PV_D0
#undef TRRD
}

template <class TIn, class TOut> struct BlockRef { const TIn* Q; const TIn* K; const TIn* V; TOut* O; int P0; float cb; };
template <class TIn> struct Seam {
    bf16x8 qr[8];
    bf16x8 st_v0, st_v1, st_k0, st_k1; f32x4 sf0, sf1, sf2, sf3;
    f32x4 tq[16];
};
__device__ __forceinline__ int swa_jlo(int P0, int W) { const int lowk = P0 - W + 1; return lowk > 0 ? lowk / KVBLK : 0; }
#define ROW(p, k0, rr) ((p) + (size_t)((k0) + (rr) - sr) * KVP + (unsigned)(sr * KVP + sc))
#define VMW() asm volatile("s_waitcnt vmcnt(0)" ::: "memory")
#define VMWN(n) asm volatile("s_waitcnt vmcnt(%0)" :: "i"(n) : "memory")
#define SLOAD_H(Kp, Vp, k0) do { S.st_v0 = load8<TIn>(ROW(Vp, k0, sr)); S.st_v1 = load8<TIn>(ROW(Vp, k0, 32 + sr));              \
                         S.st_k0 = load8<TIn>(ROW(Kp, k0, sr)); S.st_k1 = load8<TIn>(ROW(Kp, k0, 32 + sr)); } while (0)
#define SWRITE_HK(bf) do { *(bf16x8*)(K_lds + (bf) * SHM_K + kws) = S.st_k0; *(bf16x8*)(K_lds + (bf) * SHM_K + kws + 32 * 256) = S.st_k1; } while (0)
#define SWRITE_HV(bf) do { *(bf16x8*)(V_lds + (bf) * SHM_V + vst0) = S.st_v0; *(bf16x8*)(V_lds + (bf) * SHM_V + vst1) = S.st_v1; } while (0)
#define SWRITE_H(bf) do { SWRITE_HV(bf); SWRITE_HK(bf); } while (0)
#define SLOAD_F(p, k0) do { S.sf0 = *(const f32x4*)ROW(p, k0, sr); S.sf1 = *(const f32x4*)(ROW(p, k0, sr) + 4);                \
                            S.sf2 = *(const f32x4*)ROW(p, k0, 32 + sr); S.sf3 = *(const f32x4*)(ROW(p, k0, 32 + sr) + 4); } while (0)
#define SWRITE_KF(bf) do { *(bf16x8*)(K_lds + (bf) * SHM_K + kws) = pack8(S.sf0, S.sf1); *(bf16x8*)(K_lds + (bf) * SHM_K + kws + 32 * 256) = pack8(S.sf2, S.sf3); } while (0)
#define SWRITE_VF(bf) do { *(bf16x8*)(V_lds + (bf) * SHM_V + vst0) = pack8(S.sf0, S.sf1); *(bf16x8*)(V_lds + (bf) * SHM_V + vst1) = pack8(S.sf2, S.sf3); } while (0)
template <class TIn, class TOut>
__device__ __forceinline__ void causal_swa_prime(const BlockRef<TIn, TOut>& cur, int W, char* lds, Seam<TIn>& S) {
    constexpr bool F32 = same_t<TIn, float>::v;
    const int tid = threadIdx.x, wid = __builtin_amdgcn_readfirstlane(tid >> 6), lane = tid & 63, r32 = lane & 31, hi = lane >> 5;
    const int sr = tid >> 4, sc = (tid & 15) * 8, kws = KSWZ(sr, sc * 2); char* K_lds = lds + 2 * SHM_V;
    const int kb0 = swa_jlo(cur.P0, W) * KVBLK;
    for (int d0 = 0; d0 < 8; ++d0) S.qr[d0] = load8<TIn>(cur.Q + (size_t)(wid * QBLK) * QP + (unsigned)(r32 * QP + hi * 8) + d0 * 16);
    if constexpr (F32) { SLOAD_F((const float*)cur.K, kb0); VMW(); SWRITE_KF(0); SBAR(); SLOAD_F((const float*)cur.V, kb0); }
    else { SLOAD_H(cur.K, cur.V, kb0); VMW(); SWRITE_HK(0); }
    __syncthreads();
}
template <class TIn, class TOut>
__device__ __forceinline__ void causal_swa_block(const BlockRef<TIn, TOut>& cur, const BlockRef<TIn, TOut>& nxt, int skv, int W, char* lds, Seam<TIn>& S) {
    constexpr bool F32 = same_t<TIn, float>::v;
    const int tid = threadIdx.x, wid = __builtin_amdgcn_readfirstlane(tid >> 6), lane = tid & 63, r32 = lane & 31, hi = lane >> 5;
    const int j_lo = swa_jlo(cur.P0, W);
    int j_hi = (cur.P0 + QB - 1) / KVBLK + 1; if (j_hi > skv / KVBLK) j_hi = skv / KVBLK;
    const int NT = j_hi - j_lo;
    const int kbn = swa_jlo(nxt.P0, W) * KVBLK;
    const int qlo = cur.P0 + wid * QBLK, qm = qlo + r32 - 4 * hi;
    char* V_lds = lds; char* K_lds = lds + 2 * SHM_V;
    float* ws = (float*)(lds + 2 * SHM_V + 2 * SHM_K) + wid * 64; float* li_l = ws, * al_l = ws + 32;
    float m_reg = -1e30f, l_reg = 0; f32x16 o[4] = {};
    const int sr = tid >> 4, sc = (tid & 15) * 8, vst0 = v_st(sr, sc), vst1 = v_st(32 + sr, sc), kws = KSWZ(sr, sc * 2);
    const int vb0 = (int)(uintptr_t)V_lds + v_rd_base(lane);
    const TIn* Kh = cur.K; const TIn* Vh = cur.V;
#define RESC(a) do { if (__any((a) < 1.f)) { if (hi == 0) al_l[r32] = (a); asm volatile("s_waitcnt lgkmcnt(0)" ::: "memory");              \
                     for (int d_ = 0; d_ < 4; ++d_) for (int r = 0; r < 16; ++r) o[d_][r] *= al_l[crow(r, hi)]; } } while (0)
#define KBASE(t) ((j_lo + (t)) * KVBLK)
#define ACT(t) (KBASE(t) <= qlo + QBLK - 1 && KBASE(t) + KVBLK - 1 >= qlo - W + 1)
#define MASKT(P0_, P1_, t) do { const int kb_ = KBASE(t); bias_tile(P0_, P1_, cur.cb, cur.cb * (float)(kb_ + 4 * hi)); if ((!SK || ACT(t)) && (kb_ + KVBLK - 1 > qlo || kb_ <= qlo + QBLK - 1 - W)) mask_tile(P0_, P1_, qm - kb_, (unsigned)W); } while (0)
    constexpr int NQL = F32 ? 16 : 8;
    constexpr bool SK = WSKIP && !F32;
#define SEAM_K0() do { VMWN(NQL); if constexpr (F32) { SWRITE_KF(0); SBAR(); SLOAD_F((const float*)nxt.V, kbn); } else { SWRITE_HK(0); } SBAR(); } while (0)
    f32x16 pA0, pA1, pB0, pB1; float mnA, mnB, alA, alB; bf16x8 pa0, pa1, pa2, pa3;
    if constexpr (F32) { VMW(); SWRITE_VF(0); SBAR(); } else { SWRITE_HV(0); SBAR(); }
    if (NT > 1) { if constexpr (F32) SLOAD_F((const float*)Kh, KBASE(1)); else SLOAD_H(Kh, Vh, KBASE(1)); }
    SBAR(); qkt<0, SK>(pA0, pA1, K_lds, r32, hi, S.qr, ACT(0));
    if constexpr (F32) { if (NT > 1) { VMW(); SWRITE_KF(1); SBAR(); SLOAD_F((const float*)Vh, KBASE(1)); } }
    MASKT(pA0, pA1, 0); partialSM(pA0, pA1, m_reg, mnA, alA);
    if (NT > 1) { VMW(); if constexpr (F32) { SWRITE_VF(1); SBAR(); if (NT > 2) SLOAD_F((const float*)Kh, KBASE(2)); } else SWRITE_H(1); }
    __syncthreads();
#define HALF_STEP(PX0, PX1, mnX, alX, PY0, PY1, alY, t, KB, VB, SB) do {                                                      \
        SBAR(); qkt<KB, SK>(PX0, PX1, K_lds, r32, hi, S.qr, ACT(t));                                             \
        finishSM(PY0, PY1, alY, l_reg, pa0, pa1, pa2, pa3); SBAR();                                                           \
        if ((t) + 1 < NT) { if constexpr (F32) { VMW(); SWRITE_KF(SB); SBAR(); SLOAD_F((const float*)Vh, KBASE((t) + 1)); }  \
                            else { SLOAD_H(Kh, Vh, KBASE((t) + 1)); } SBAR(); }                                               \
        pv_tile<VB, SK>(o, vb0, pa0, pa1, pa2, pa3, ACT((t) - 1)); MASKT(PX0, PX1, (t)); partialSM(PX0, PX1, m_reg, mnX, alX);                                        \
        __syncthreads();                                                                                                      \
        if ((t) + 1 < NT) { VMW(); if constexpr (F32) { SWRITE_VF(SB); SBAR(); if ((t) + 2 < NT) SLOAD_F((const float*)Kh, KBASE((t) + 2)); } \
                            else { SWRITE_H(SB); } }                                                                          \
        RESC(alX); __syncthreads(); } while (0)
    for (int t = 1; t + 1 < NT; t += 2) {
        HALF_STEP(pB0, pB1, mnB, alB, pA0, pA1, alA, t, 1, 0, 0);
        HALF_STEP(pA0, pA1, mnA, alA, pB0, pB1, alB, t + 1, 0, 1, 1);
    }
    const bool even = (NT & 1) == 0;
    if (even) { SBAR(); qkt<1, SK>(pB0, pB1, K_lds, r32, hi, S.qr, ACT(NT - 1)); SBAR(); }
#define QROW(e) (nxt.Q + (size_t)(wid * QBLK + r32) * QP + ((e) >> 1) * 16 + hi * 8 + ((e) & 1) * 4)
    if constexpr (F32) { SLOAD_F((const float*)nxt.K, kbn); SBAR();
#pragma unroll
        for (int e = 0; e < 8; ++e) S.tq[e] = *(const f32x4*)QROW(e); }
    else { SLOAD_H(nxt.K, nxt.V, kbn); SBAR();
#pragma unroll
        for (int d0 = 0; d0 < 8; ++d0) S.qr[d0] = load8<TIn>(nxt.Q + (size_t)(wid * QBLK) * QP + (unsigned)(r32 * QP + hi * 8) + d0 * 16); }
    SBAR();
    finishSM(pA0, pA1, alA, l_reg, pa0, pa1, pa2, pa3); SBAR();
    if constexpr (F32) {
#pragma unroll
        for (int e = 8; e < 16; ++e) S.tq[e] = *(const f32x4*)QROW(e); SBAR(); }
#undef QROW
    pv_tile<0, SK>(o, vb0, pa0, pa1, pa2, pa3, ACT(even ? NT - 2 : NT - 1));
    if (even) { MASKT(pB0, pB1, NT - 1); partialSM(pB0, pB1, m_reg, mnB, alB); __syncthreads(); RESC(alB);
        finishSM(pB0, pB1, alB, l_reg, pa0, pa1, pa2, pa3); SBAR(); pv_tile<1, SK>(o, vb0, pa0, pa1, pa2, pa3, ACT(NT - 1)); }
    SBAR(); SEAM_K0();
    if (hi == 0) li_l[r32] = l_reg; asm volatile("s_waitcnt lgkmcnt(0)" ::: "memory");
    float rli[16];
#pragma unroll
    for (int r = 0; r < 16; ++r) rli[r] = __builtin_amdgcn_rcpf(li_l[crow(r, hi)]);
    TOut* Ow = cur.O + (size_t)(wid * QBLK) * OP;
#pragma unroll
    for (int r = 0; r < 16; ++r) { const int orow = crow(r, hi);
#pragma unroll
        for (int d0 = 0; d0 < 4; ++d0) { const float v = o[d0][r] * rli[r];
            if constexpr (same_t<TOut, float>::v) { Ow[(size_t)orow * OP + d0 * 32 + r32] = v; }
            else { const float vn = __shfl_xor(v, 1);
                   if ((r32 & 1) == 0) *(unsigned*)(Ow + (size_t)orow * OP + d0 * 32 + r32) = cvtpk(v, vn); } } }
    if constexpr (F32) {
#pragma unroll
        for (int d0 = 0; d0 < 8; ++d0) S.qr[d0] = pack8(S.tq[2 * d0], S.tq[2 * d0 + 1]); }
    __syncthreads();
#undef RESC
#undef KBASE
#undef ACT
#undef MASKT
#undef SEAM_K0
#undef HALF_STEP
}
#undef ROW
#undef VMW
#undef VMWN
#undef SLOAD_H
#undef SWRITE_HK
#undef SWRITE_HV
#undef SWRITE_H
#undef SLOAD_F
#undef SWRITE_KF
#undef SWRITE_VF
}

constexpr float LAMBDA_INIT = 0.35550906759096924f;
__device__ __forceinline__ attn::BlockRef<attn::bf16, float> attn_ref(unsigned char* ws, int bh, int qb) {
    const int b = bh >> 5, h = (bh >> 2) & 7, map = (bh >> 1) & 1, vh = bh & 1;
    attn::BlockRef<attn::bf16, float> r;
    r.Q = (const attn::bf16*)(ws + WS_QB) + ((size_t)b * SEQ + (size_t)qb * 256) * DM + map * 1024 + h * 128;
    r.K = (const attn::bf16*)(ws + WS_KVB) + (size_t)b * LSEQ * 4096 + map * 1024 + h * 128;
    r.V = (const attn::bf16*)(ws + WS_KVB) + (size_t)b * LSEQ * 4096 + 2048 + h * 256 + vh * 128;
    r.O = (float*)(ws + WS_OB) + (size_t)map * MS * DM + ((size_t)b * SEQ + (size_t)qb * 256) * DM + h * 256 + vh * 128;
    r.P0 = NMETA + qb * 256;
    r.cb = __builtin_amdgcn_exp2f(-(float)(h + 1)) * 11.313708498984761f;
    return r;
}
__device__ __forceinline__ void phase10(const Args& a, const Ctx& C, char* lds) {
    using namespace attn;
    constexpr int total = 4 * 128;
    constexpr int SKV = 2112, W = 0x40000000;
    int L = blockIdx.x; const int stride = C.G;
    if (L < total) {
        int bh = L >> 2, x = L & 3, pass = 0;
        BlockRef<bf16, float> cur = attn_ref(a.ws, bh, x);
        Seam<bf16> S;
        causal_swa_prime<bf16, float>(cur, W, lds, S);
        for (;;) {
            const bool more_pass = pass == 0, more_item = L + stride < total, last = !more_pass && !more_item;
            int bhn = bh, xn = x, passn = pass + 1, Ln = L;
            if (!more_pass) { passn = 0; Ln = more_item ? L + stride : L; bhn = Ln >> 2; xn = Ln & 3; }
            const BlockRef<bf16, float> nxt = last ? cur : attn_ref(a.ws, bhn, passn ? 7 - xn : xn);
            causal_swa_block<bf16, float>(cur, nxt, SKV, W, lds, S);
            if (last) break;
            cur = nxt; bh = bhn; x = xn; pass = passn; L = Ln;
        }
    }
}
__device__ __forceinline__ void phase11(const Args& a, const Ctx& C) {
    unsigned char* ws = a.ws;
    const float* O1 = (const float*)(ws + WS_OB); const float* O2 = O1 + (size_t)MS * DM; bf16* ON = (bf16*)(ws + WS_ON);
    const int lane = C.lane;
    float lam;
    { const float s1 = wave_sum(a.in[16][lane] * a.in[17][lane] + a.in[16][lane + 64] * a.in[17][lane + 64]);
      const float s2 = wave_sum(a.in[18][lane] * a.in[19][lane] + a.in[18][lane + 64] * a.in[19][lane + 64]);
      lam = __expf(s1) - __expf(s2) + LAMBDA_INIT; }
    const f32x4 gs = *((const GAS f32x4*)a.in[20] + lane) * (1.0f - LAMBDA_INIT);
    for (int row = C.gw; row < MS; row += C.NGW) {
        const GAS f32x4* p1 = (const GAS f32x4*)(O1 + (size_t)row * DM) + lane; const GAS f32x4* p2 = (const GAS f32x4*)(O2 + (size_t)row * DM) + lane;
        GAS u64* o8 = (GAS u64*)(ON + (size_t)row * DM) + lane;
        f32x4 v[8];
#pragma unroll
        for (int j = 0; j < 8; ++j) v[j] = p1[64 * j] - lam * p2[64 * j];
#pragma unroll
        for (int j = 0; j < 8; ++j) { const float s = wave_sum((v[j].x * v[j].x + v[j].y * v[j].y) + (v[j].z * v[j].z + v[j].w * v[j].w));
            const float rstd = 1.f / sqrtf(s * (1.f / VDIM) + RMS_EPS); const f32x4 y = v[j] * rstd * gs;
            o8[64 * j] = (u64)pk2(y.x, y.y) | ((u64)pk2(y.z, y.w) << 32); }
    }
}

constexpr size_t MISC_TOKE = 0, MISC_TOKW = 64 * 1024, MISC_TOKS = 128 * 1024, MISC_PE = 192 * 1024;
__device__ __forceinline__ void phase13(const Args& a, const Ctx& C) {
    unsigned char* ws = a.ws; const int lane = C.lane;
    const float* H3 = (const float*)(ws + WS_H3); bf16* UM = (bf16*)(ws + WS_UM);
    int* TOKE = (int*)(ws + WS_MISC + MISC_TOKE); float* TOKW = (float*)(ws + WS_MISC + MISC_TOKW);
    LAS float* RL = (LAS float*)C.lds;
    LAS unsigned* hist = (LAS unsigned*)(C.lds + MISC_OFF) + 16;
    for (int i = C.tid; i < DM * NEXP / 4; i += NWAVES * 64) *((LAS f32x4*)RL + i) = *((const GAS f32x4*)a.in[26] + i);
    __syncthreads();
    const float* gain = a.in[22] + DM;
    for (int row = C.gw; row < MS; row += C.NGW) {
        const GAS f32x4* xr = (const GAS f32x4*)(H3 + (size_t)row * DM) + lane; const GAS f32x4* gr = (const GAS f32x4*)gain + lane;
        f32x4 v[8]; float s = 0.f;
#pragma unroll
        for (int j = 0; j < 8; ++j) { v[j] = xr[64 * j]; s += (v[j].x * v[j].x + v[j].y * v[j].y) + (v[j].z * v[j].z + v[j].w * v[j].w); }
        const float rstd = 1.f / sqrtf(wave_sum(s) * (1.f / DM) + RMS_EPS);
        GAS u64* o8 = (GAS u64*)(UM + (size_t)row * DM) + lane;
        float p[8];
#pragma unroll
        for (int e = 0; e < 8; ++e) p[e] = 0.f;
#pragma unroll
        for (int j = 0; j < 8; ++j) { const f32x4 y = v[j] * rstd * gr[64 * j];
            o8[64 * j] = (u64)pk2(y.x, y.y) | ((u64)pk2(y.z, y.w) << 32);
#pragma unroll
            for (int i = 0; i < 4; ++i) { const LAS f32x4* rr = (const LAS f32x4*)(RL + (256 * j + 4 * lane + i) * 8); const f32x4 r0 = rr[0], r1 = rr[1];
                p[0] += y[i] * r0.x; p[1] += y[i] * r0.y; p[2] += y[i] * r0.z; p[3] += y[i] * r0.w; p[4] += y[i] * r1.x; p[5] += y[i] * r1.y; p[6] += y[i] * r1.z; p[7] += y[i] * r1.w; } }
#pragma unroll
        for (int e = 0; e < 8; ++e) p[e] = wave_sum(p[e]);
        int i1 = 0; float v1 = p[0];
#pragma unroll
        for (int e = 1; e < 8; ++e) if (p[e] > v1) { v1 = p[e]; i1 = e; }
        int i2 = -1; float v2 = -__builtin_inff();
#pragma unroll
        for (int e = 0; e < 8; ++e) if (e != i1 && p[e] > v2) { v2 = p[e]; i2 = e; }
        const float e2 = __expf(v2 - v1), w1 = 1.f / (1.f + e2), w2 = e2 * w1;
        if (lane == 0) { TOKE[2 * row] = i1; TOKE[2 * row + 1] = i2; TOKW[2 * row] = w1; TOKW[2 * row + 1] = w2;
            __hip_atomic_fetch_add(hist + i1, 1u, __ATOMIC_RELAXED, __HIP_MEMORY_SCOPE_WORKGROUP); __hip_atomic_fetch_add(hist + i2, 1u, __ATOMIC_RELAXED, __HIP_MEMORY_SCOPE_WORKGROUP); }
    }
    __syncthreads();
    if (C.tid < 8) { const unsigned hcount = hist[C.tid]; if (hcount) __hip_atomic_fetch_add((unsigned*)((gu32*)(ws + WS_CTL) + CW_CNT + 64 * C.tid), hcount, RLX_AGENT); }
}
struct ExpTab { int cnt[8], np[8], pb[8]; int npanels; };
__device__ __forceinline__ void load_exptab(unsigned char* ws, ExpTab& T) {
    int acc = 0;
#pragma unroll
    for (int e = 0; e < 8; ++e) { const int c = __builtin_amdgcn_readfirstlane((int)__hip_atomic_load((unsigned*)((gu32*)(ws + WS_CTL) + CW_CNT + 64 * e), RLX_AGENT));
        T.cnt[e] = c; T.np[e] = (c + 255) >> 8; T.pb[e] = acc; acc += T.np[e]; }
    T.npanels = acc;
}
__device__ __forceinline__ void phase14(const Args& a, const Ctx& C) {
    unsigned char* ws = a.ws; const int lane = C.lane;
    const bf16* UM = (const bf16*)(ws + WS_UM); bf16* XP = (bf16*)(ws + WS_XPERM);
    const int* TOKE = (const int*)(ws + WS_MISC + MISC_TOKE); int* TOKS = (int*)(ws + WS_MISC + MISC_TOKS);
    ExpTab T; load_exptab(ws, T);
    for (int row = C.gw; row < MS; row += C.NGW) {
        int s1 = 0, s2 = 0;
        if (lane == 0) { const int e1 = TOKE[2 * row], e2 = TOKE[2 * row + 1]; int b1 = 0, b2 = 0;
#pragma unroll
            for (int e = 0; e < 8; ++e) { if (e == e1) b1 = T.pb[e]; if (e == e2) b2 = T.pb[e]; }
            s1 = b1 * 256 + (int)__hip_atomic_fetch_add((unsigned*)((gu32*)(ws + WS_CTL) + CW_CUR + 64 * e1), 1u, RLX_AGENT);
            s2 = b2 * 256 + (int)__hip_atomic_fetch_add((unsigned*)((gu32*)(ws + WS_CTL) + CW_CUR + 64 * e2), 1u, RLX_AGENT);
            TOKS[2 * row] = s1; TOKS[2 * row + 1] = s2; }
        s1 = __builtin_amdgcn_readfirstlane(s1); s2 = __builtin_amdgcn_readfirstlane(s2);
        const GAS v4u* src = (const GAS v4u*)(UM + (size_t)row * DM) + lane; GAS v4u* d1 = (GAS v4u*)(XP + (size_t)s1 * DM) + lane; GAS v4u* d2 = (GAS v4u*)(XP + (size_t)s2 * DM) + lane;
#pragma unroll
        for (int j = 0; j < 4; ++j) { const v4u x = src[64 * j]; d1[64 * j] = x; d2[64 * j] = x; }
    }
    if (blockIdx.x == 0 && C.tid < 128 && C.tid < T.npanels) { int e = 0;
#pragma unroll
        for (int q = 1; q < 8; ++q) e += (C.tid >= T.pb[q]) ? 1 : 0;
        ((int*)(ws + WS_MISC + MISC_PE))[C.tid] = e; }
    for (int pr = C.gw; pr < 8 * 256; pr += C.NGW) { const int e = pr >> 8, r = pr & 255; int cnt = 0, pb = 0, np = 0;
#pragma unroll
        for (int q = 0; q < 8; ++q) if (q == e) { cnt = T.cnt[q]; pb = T.pb[q]; np = T.np[q]; }
        const int row = pb * 256 + cnt + r;
        if (row < (pb + np) * 256) { GAS v4u* d = (GAS v4u*)(XP + (size_t)row * DM) + lane; const v4u z = {0u, 0u, 0u, 0u};
#pragma unroll
            for (int j = 0; j < 4; ++j) d[64 * j] = z; } }
}
__device__ __forceinline__ void make_grouped(unsigned char* ws, pg8::GroupedOrder& S, int nN, int G, int c) {
    int npanels = 0;
#pragma unroll
    for (int e = 0; e < 8; ++e) { const int cn = __builtin_amdgcn_readfirstlane((int)__hip_atomic_load((unsigned*)((gu32*)(ws + WS_CTL) + CW_CNT + 64 * e), RLX_AGENT)); npanels += (cn + 255) >> 8; }
    S.nM = npanels; S.nN = nN; S.nwg = npanels * nN; S.G = G; S.c = c; S.pe = (const int*)(ws + WS_MISC + MISC_PE);
}
__device__ __forceinline__ void phase17(const Args& a, const Ctx& C) {
    unsigned char* ws = a.ws; const int lane = C.lane;
    const float* H3 = (const float*)(ws + WS_H3); const bf16* YP = (const bf16*)(ws + WS_YP);
    const int* TOKS = (const int*)(ws + WS_MISC + MISC_TOKS); const float* TOKW = (const float*)(ws + WS_MISC + MISC_TOKW);
    typedef unsigned u32x2 __attribute__((ext_vector_type(2)));
    for (int row = C.gw; row < MS; row += C.NGW) {
        const int s1 = TOKS[2 * row], s2 = TOKS[2 * row + 1]; const float w1 = TOKW[2 * row], w2 = TOKW[2 * row + 1];
        const GAS f32x4* xr = (const GAS f32x4*)(H3 + (size_t)row * DM) + lane; const GAS f32x4* gr = (const GAS f32x4*)a.in[30] + lane;
        const GAS u32x2* y1 = (const GAS u32x2*)(YP + (size_t)s1 * DM) + lane; const GAS u32x2* y2 = (const GAS u32x2*)(YP + (size_t)s2 * DM) + lane;
        f32x4 v[8]; float s = 0.f;
#pragma unroll
        for (int j = 0; j < 8; ++j) { const u32x2 q1 = y1[64 * j], q2 = y2[64 * j];
            const f32x4 f1 = {__uint_as_float(q1.x << 16), __uint_as_float(q1.x & 0xffff0000u), __uint_as_float(q1.y << 16), __uint_as_float(q1.y & 0xffff0000u)};
            const f32x4 f2 = {__uint_as_float(q2.x << 16), __uint_as_float(q2.x & 0xffff0000u), __uint_as_float(q2.y << 16), __uint_as_float(q2.y & 0xffff0000u)};
            v[j] = xr[64 * j] + w1 * f1 + w2 * f2; s += (v[j].x * v[j].x + v[j].y * v[j].y) + (v[j].z * v[j].z + v[j].w * v[j].w); }
        const float rstd = 1.f / sqrtf(wave_sum(s) * (1.f / DM) + RMS_EPS);
        GAS f32x4* op = (GAS f32x4*)(a.out + (size_t)row * DM) + lane;
#pragma unroll
        for (int j = 0; j < 8; ++j) op[64 * j] = v[j] * rstd * gr[64 * j];
    }
}


__device__ __forceinline__ void phase0(const Args& a, const Ctx& C) {
    unsigned char* ws = a.ws;
    LAS float* scr = (LAS float*)(C.lds + C.wave * 16640);
    constexpr int I_SQ = 32 * 32, I_IN = 32 * 64, I_GU = 32 * 86, I_DN = 86 * 32, I_E = 2 * I_GU + I_DN;
    constexpr int NITEMS = 8 * I_E + I_IN + 2 * I_SQ + (2 * I_GU + I_DN) + I_SQ + I_IN;
    for (int it = C.gw; it < NITEMS; it += C.NGW) {
        int r = it;
        if (r < 8 * I_E) { const int e = r / I_E; int q = r - e * I_E;
            if (q < I_GU) { transpose_item<1>(a.in[27] + (size_t)e * DM * DFF, DM, DFF, (bf16*)(ws + WS_MGU + e * SZ_GU), scr, q, C.lane); continue; } q -= I_GU;
            if (q < I_GU) { transpose_item<2>(a.in[28] + (size_t)e * DM * DFF, DM, DFF, (bf16*)(ws + WS_MGU + e * SZ_GU), scr, q, C.lane); continue; } q -= I_GU;
            transpose_item<0>(a.in[29] + (size_t)e * DFF * DM, DFF, DM, (bf16*)(ws + WS_MD + e * SZ_D), scr, q, C.lane); continue; }
        r -= 8 * I_E;
        if (r < I_IN) { transpose_item<0>(a.in[13], DM, 4096, (bf16*)(ws + WS_WKV), scr, r, C.lane); continue; } r -= I_IN;
        if (r < I_SQ) { transpose_item<0>(a.in[15], DM, DM, (bf16*)(ws + WS_WQ), scr, r, C.lane); continue; } r -= I_SQ;
        if (r < I_SQ) { transpose_item<0>(a.in[21], DM, DM, (bf16*)(ws + WS_WO2), scr, r, C.lane); continue; } r -= I_SQ;
        if (r < I_GU) { transpose_item<1>(a.in[23], DM, DFF, (bf16*)(ws + WS_WGU), scr, r, C.lane); continue; } r -= I_GU;
        if (r < I_GU) { transpose_item<2>(a.in[24], DM, DFF, (bf16*)(ws + WS_WGU), scr, r, C.lane); continue; } r -= I_GU;
        if (r < I_DN) { transpose_item<0>(a.in[25], DFF, DM, (bf16*)(ws + WS_WD), scr, r, C.lane); continue; } r -= I_DN;
        if (r < I_SQ) { transpose_item<0>(a.in[11], DM, DM, (bf16*)(ws + WS_WOUT), scr, r, C.lane); continue; } r -= I_SQ;
        transpose_item<0>(a.in[3], DM, 4096, (bf16*)(ws + WS_WIN), scr, r, C.lane);
    }
    { bf16* wg = (bf16*)(ws + WS_WG); const float* rg = a.in[6]; const float* ig = a.in[8];
      for (int idx = C.gw * 64 + C.lane; idx < 16 * 256 * 128; idx += C.NGW * 64) { const int g = idx >> 15, jj = (idx >> 7) & 255, i = idx & 127;
          const float v = (jj < 128 ? rg : ig)[(size_t)g * 16384 + i * 128 + (jj & 127)]; wg[idx] = (bf16)f2bf(v); } }
    { float* hb = (float*)(ws + WS_HBUF); bf16* U = (bf16*)(ws + WS_U);
      for (int row = C.gw; row < ML; row += C.NGW) { const int b = row / LSEQ, t = row - b * LSEQ;
          const float* src = t < NMETA ? a.in[1] + (size_t)t * DM : a.in[0] + ((size_t)b * SEQ + (t - NMETA)) * DM;
          rms_row(src, a.in[2], U + (size_t)row * DM, hb + (size_t)row * DM, C.lane); } }
}

__global__ void __launch_bounds__(NWAVES * 64, 2) mk_fwd(Args args) {
    extern __shared__ __attribute__((aligned(16))) unsigned char lds_raw[];
    Ctx C;
    C.lds = (LAS unsigned char*)lds_raw;
    C.tid = threadIdx.x; C.lane = C.tid & 63; C.wave = __builtin_amdgcn_readfirstlane(C.tid >> 6);
    C.G = gridDim.x; C.gw = blockIdx.x * NWAVES + C.wave; C.NGW = C.G * NWAVES;
    volatile LAS unsigned* MISC = (volatile LAS unsigned*)(C.lds + MISC_OFF);
    unsigned char* ws = args.ws;
    gu32* ctl = (gu32*)(ws + WS_CTL);
    for (int u = C.tid; u < (LDS_BYTES - LDSCTL_OFF) / 4; u += NWAVES * 64) ((LAS unsigned*)(C.lds + LDSCTL_OFF))[u] = 0u;
    __syncthreads();
    const int lo = args.ph_lo, hi = args.ph_hi;
    XcdBarrier bar; bar.bar = (unsigned*)(ctl + CW_BAR); bar.x = 0; bar.st = nullptr;
    if (hi - lo > 1) bar = xcd_barrier_post((unsigned*)(ctl + CW_BAR), MISC + 8);
#define IN(k) (lo <= (k) && (k) < hi)
#define SEAM(k) do { if (IN(k) && IN((k) + 1)) xcd_barrier(bar); } while (0)

    if (IN(0)) { phase0(args, C); }
    SEAM(0);
    if (IN(1)) {
        pg8::Gemm g{(const pg8::bf16_t*)(ws + WS_U), (const pg8::bf16_t*)(ws + WS_WIN), DM, 0}; pg8::StaticOrder S; S.init(MLP, 4096, C.G, (int)blockIdx.x);
        pg8::EpiBf16 E{(pg8::bf16_t*)(ws + WS_XG), 4096};
        pg8::gemm_phase<pg8::EpiBf16, pg8::StaticOrder, true, true>(C.lds, g, S, E);
    }
    SEAM(1);
    if (IN(2)) { phase2(args, C); }
    SEAM(2);
    if (IN(3)) { phase3(args, C); }
    SEAM(3);
    if (IN(4)) {
        pg8::Gemm g{(const pg8::bf16_t*)(ws + WS_Y), (const pg8::bf16_t*)(ws + WS_WOUT), DM, 0}; pg8::StaticOrder S; S.init(MLP, DM, C.G, (int)blockIdx.x);
        pg8::EpiResF32<0> E{(const float*)(ws + WS_HBUF), (float*)(ws + WS_HBUF), DM};
        pg8::gemm_phase<pg8::EpiResF32<0>, pg8::StaticOrder, true, true>(C.lds, g, S, E);
    }
    SEAM(4);
    if (IN(5)) {
        const float* hb = (const float*)(ws + WS_HBUF); bf16* U = (bf16*)(ws + WS_U);
        for (int row = C.gw; row < ML; row += C.NGW) rms_row(hb + (size_t)row * DM, args.in[22], U + (size_t)row * DM, nullptr, C.lane);
    }
    SEAM(5);
    if (IN(6)) {
        pg8::Gemm g{(const pg8::bf16_t*)(ws + WS_U), (const pg8::bf16_t*)(ws + WS_WGU), DM, 0}; pg8::StaticOrder S; S.init(MLP, NGU, C.G, (int)blockIdx.x);
        pg8::EpiSwiglu E{(pg8::bf16_t*)(ws + WS_ACT), DFF};
        pg8::gemm_phase<pg8::EpiSwiglu, pg8::StaticOrder, true, true>(C.lds, g, S, E);
    }
    SEAM(6);
    if (IN(7)) {
        pg8::Gemm g{(const pg8::bf16_t*)(ws + WS_ACT), (const pg8::bf16_t*)(ws + WS_WD), DFF, 0}; pg8::StaticOrder S; S.init(MLP, DM, C.G, (int)blockIdx.x);
        pg8::EpiResF32<0> E{(const float*)(ws + WS_HBUF), (float*)(ws + WS_HBUF), DM};
        pg8::gemm_phase<pg8::EpiResF32<0>, pg8::StaticOrder, true, true>(C.lds, g, S, E);
    }
    SEAM(7);
    if (IN(8)) {
        const float* hb = (const float*)(ws + WS_HBUF); bf16* U = (bf16*)(ws + WS_U); bf16* UQ = (bf16*)(ws + WS_UQ);
        for (int row = C.gw; row < ML; row += C.NGW) { const int b = row / LSEQ, t = row - b * LSEQ;
            rms_row2(hb + (size_t)row * DM, args.in[12], U + (size_t)row * DM, args.in[14], t >= NMETA ? UQ + ((size_t)b * SEQ + (t - NMETA)) * DM : nullptr, C.lane); }
    }
    SEAM(8);
    if (IN(9)) {
        { pg8::Gemm g{(const pg8::bf16_t*)(ws + WS_U), (const pg8::bf16_t*)(ws + WS_WKV), DM, 0}; pg8::StaticOrder S; S.init(MLP, 4096, C.G, (int)blockIdx.x);
          pg8::EpiBf16 E{(pg8::bf16_t*)(ws + WS_KVB), 4096};
          pg8::gemm_phase<pg8::EpiBf16, pg8::StaticOrder, true, true>(C.lds, g, S, E); }
        { pg8::Gemm g{(const pg8::bf16_t*)(ws + WS_UQ), (const pg8::bf16_t*)(ws + WS_WQ), DM, 0}; pg8::StaticOrder S; S.init(MS, DM, C.G, (int)blockIdx.x);
          pg8::EpiBf16 E{(pg8::bf16_t*)(ws + WS_QB), DM};
          pg8::gemm_phase<pg8::EpiBf16, pg8::StaticOrder, true, true>(C.lds, g, S, E); }
    }
    SEAM(9);
    if (IN(10)) { phase10(args, C, (char*)lds_raw); }
    SEAM(10);
    if (IN(11)) { phase11(args, C); }
    SEAM(11);
    if (IN(12)) {
        pg8::Gemm g{(const pg8::bf16_t*)(ws + WS_ON), (const pg8::bf16_t*)(ws + WS_WO2), DM, 0}; pg8::StaticOrder S; S.init(MS, DM, C.G, (int)blockIdx.x);
        pg8::EpiResF32<1> E{(const float*)(ws + WS_HBUF), (float*)(ws + WS_H3), DM};
        pg8::gemm_phase<pg8::EpiResF32<1>, pg8::StaticOrder, true, true>(C.lds, g, S, E);
    }
    SEAM(12);
    if (IN(13)) { phase13(args, C); }
    SEAM(13);
    if (IN(14)) { phase14(args, C); }
    SEAM(14);
    if (IN(15)) {
        pg8::Gemm g{(const pg8::bf16_t*)(ws + WS_XPERM), (const pg8::bf16_t*)(ws + WS_MGU), DM, SZ_GU}; pg8::GroupedOrder S; make_grouped(ws, S, NGU / 256, C.G, (int)blockIdx.x);
        pg8::EpiSwiglu E{(pg8::bf16_t*)(ws + WS_ACTP), DFF};
        pg8::gemm_phase<pg8::EpiSwiglu, pg8::GroupedOrder, true, true>(C.lds, g, S, E);
    }
    SEAM(15);
    if (IN(16)) {
        pg8::Gemm g{(const pg8::bf16_t*)(ws + WS_ACTP), (const pg8::bf16_t*)(ws + WS_MD), DFF, SZ_D}; pg8::GroupedOrder S; make_grouped(ws, S, DM / 256, C.G, (int)blockIdx.x);
        pg8::EpiBf16 E{(pg8::bf16_t*)(ws + WS_YP), DM};
        pg8::gemm_phase<pg8::EpiBf16, pg8::GroupedOrder, true, true>(C.lds, g, S, E);
    }
    SEAM(16);
    if (IN(17)) { phase17(args, C); }
#undef IN
#undef SEAM
}

#ifndef MK_PER_PHASE
#define MK_PER_PHASE 0
#endif
extern "C" void kernel_launch(void* const* d_in, const int* in_sizes, int n_in, void* d_out, int out_size, void* d_ws, size_t ws_size, hipStream_t stream) {
    static int grid = 0;
    if (grid == 0) {
        if (n_in != 31 || ws_size < WS_END || out_size != MS * DM) { fprintf(stderr, "kernel_launch: unexpected n_in %d / out %d / ws %zu (need %zu)\n", n_in, out_size, ws_size, (size_t)WS_END); grid = -1; return; }
        int dev = 0, cus = 0, per_cu = 0;
        if (hipGetDevice(&dev) != hipSuccess || hipDeviceGetAttribute(&cus, hipDeviceAttributeMultiprocessorCount, dev) != hipSuccess) { grid = -1; return; }
        if (hipFuncSetAttribute((const void*)mk_fwd, hipFuncAttributeMaxDynamicSharedMemorySize, LDS_BYTES) != hipSuccess) { fprintf(stderr, "kernel_launch: hipFuncSetAttribute failed\n"); grid = -1; return; }
        if (hipOccupancyMaxActiveBlocksPerMultiprocessor(&per_cu, (const void*)mk_fwd, NWAVES * 64, LDS_BYTES) != hipSuccess || per_cu < 1) fprintf(stderr, "kernel_launch: occupancy query says %d\n", per_cu);
        (void)hipGetLastError();
        grid = cus;
    }
    if (grid < 0) return;
    (void)hipMemsetAsync((char*)d_ws + WS_CTL, 0, CTL_ZERO_BYTES, stream);
    Args a{};
    for (int i = 0; i < 31; ++i) a.in[i] = (const float*)d_in[i];
    a.out = (float*)d_out; a.ws = (unsigned char*)d_ws;
    if (MK_PER_PHASE) { for (int p = 0; p < NPHASE; ++p) { a.ph_lo = p; a.ph_hi = p + 1; hipLaunchKernelGGL(mk_fwd, dim3(grid), dim3(NWAVES * 64), LDS_BYTES, stream, a); } }
    else { a.ph_lo = 0; a.ph_hi = NPHASE; hipLaunchKernelGGL(mk_fwd, dim3(grid), dim3(NWAVES * 64), LDS_BYTES, stream, a); }
}
```

```cpp
#include <hip/hip_runtime.h>
#include <cstdio>
#include <cstdint>

namespace pg8 {
#define PG8_LAS __attribute__((address_space(3)))
typedef unsigned short bf16_t;
typedef short bf16x8 __attribute__((ext_vector_type(8)));
typedef float f32x4 __attribute__((ext_vector_type(4)));
typedef unsigned u32x4 __attribute__((ext_vector_type(4)));
constexpr int BM = 256, BK = 64, HALF = 128, HTB = HALF * BK * 2  , STAGE_BYTES = 8 * HTB, NXCD = 8, WGM = 8;

__host__ __device__ __forceinline__ int lds_byte(int r, int c) { const int st = (r >> 4) * 2 + (c >> 5), rr = r & 15, cc = c & 31, ob = rr * 64 + cc * 2; return st * 1024 + (ob ^ (((ob >> 9) & 1) << 5)); }
__host__ __device__ __forceinline__ void stage_rc(int b, int& R, int& C) { const int st = b / 1024, sb = b % 1024, swz = sb ^ (((sb >> 9) & 1) << 5); R = (st >> 1) * 16 + swz / 64; C = (st & 1) * 32 + (swz % 64) / 2; }
__host__ __device__ __forceinline__ int perm32(int rho) { const int n = rho >> 4, i = rho & 15; return 8 * (i >> 2) + 4 * n + (i & 3); }

struct Unit { int pm, pn, e; };
struct Gemm { const bf16_t* A; const bf16_t* Bt; int K; size_t estride; };

struct StaticOrder {
    int nM, nN, nwg, G, c;
    __host__ __device__ void init(int M, int N, int G_, int c_) { nM = M / BM; nN = N / BM; nwg = nM * nN; G = G_; c = c_; }
    __host__ __device__ bool next(int i, Unit& u) const {
        const long L = (long)i * G + c; if (L >= nwg) return false;
        int wgid = (int)L; { const int q = nwg / NXCD, r = nwg % NXCD, xcd = wgid % NXCD, off = wgid / NXCD; wgid = (xcd < r ? xcd * (q + 1) : r * (q + 1) + (xcd - r) * q) + off; }
        const int nig = WGM * nN, gid = wgid / nig, fm = gid * WGM, gsz = (nM - fm) < WGM ? (nM - fm) : WGM;
        u.pm = fm + ((wgid % nig) % gsz); u.pn = (wgid % nig) / gsz; u.e = 0; return true;
    }
    __device__ __forceinline__ void a_ready(const Unit&) const {}
    __device__ __forceinline__ void done(const Unit&) const {}
};
struct GroupedOrder {
    int nM, nN, nwg, G, c; const int* pe;
    __device__ __forceinline__ bool next(int i, Unit& u) const {
        const long L = (long)i * G + c; if (L >= nwg) return false;
        int wgid = (int)L; { const int q = nwg / NXCD, r = nwg % NXCD, xcd = wgid % NXCD, off = wgid / NXCD; wgid = (xcd < r ? xcd * (q + 1) : r * (q + 1) + (xcd - r) * q) + off; }
        const int nig = WGM * nN, gid = wgid / nig, fm = gid * WGM, gsz = (nM - fm) < WGM ? (nM - fm) : WGM;
        u.pm = fm + ((wgid % nig) % gsz); u.pn = (wgid % nig) / gsz; u.e = __builtin_amdgcn_readfirstlane(pe[u.pm]); return true;
    }
    __device__ __forceinline__ void a_ready(const Unit&) const {}
    __device__ __forceinline__ void done(const Unit&) const {}
};

__device__ __forceinline__ unsigned cvt_pk_bf16(float lo, float hi) { unsigned r; asm volatile("v_cvt_pk_bf16_f32 %0, %1, %2" : "=v"(r) : "v"(lo), "v"(hi)); return r; }
typedef float f32x2 __attribute__((ext_vector_type(2)));

struct EpiBf16 {
    static constexpr bool PERM = true, AFTER_DRAIN = false;
    bf16_t* O; int ldc;
    __device__ __forceinline__ void operator()(const f32x4 (&acc)[2][2][4][2], const Unit& u, int wr, int wc, int fr, int fq) const {
        const int row0 = u.pm * BM + wr * 64 + fr; const int col0 = u.pn * BM + wc * 32 + 8 * fq;
#pragma unroll
        for (int ai = 0; ai < 2; ++ai)
#pragma unroll
            for (int m = 0; m < 4; ++m) { bf16_t* rowp = O + (size_t)(row0 + ai * HALF + m * 16) * ldc + col0;
#pragma unroll
                for (int bj = 0; bj < 2; ++bj) { const f32x4 v0 = acc[ai][bj][m][0], v1 = acc[ai][bj][m][1];
                    u32x4 w; w.x = cvt_pk_bf16(v0[0], v0[1]); w.y = cvt_pk_bf16(v0[2], v0[3]); w.z = cvt_pk_bf16(v1[0], v1[1]); w.w = cvt_pk_bf16(v1[2], v1[3]);
                    *(u32x4*)(rowp + bj * HALF) = w; } }
    }
};
struct EpiSwiglu {
    static constexpr bool PERM = true, AFTER_DRAIN = false;
    bf16_t* O; int ldc;
    __device__ __forceinline__ void operator()(const f32x4 (&acc)[2][2][4][2], const Unit& u, int wr, int wc, int fr, int fq) const {
        const int row0 = u.pm * BM + wr * 64 + fr; const int col0 = u.pn * HALF + wc * 32 + 8 * fq;
#pragma unroll
        for (int ai = 0; ai < 2; ++ai)
#pragma unroll
            for (int m = 0; m < 4; ++m) { bf16_t* rowp = O + (size_t)(row0 + ai * HALF + m * 16) * ldc + col0;
                float r[8];
#pragma unroll
                for (int n = 0; n < 2; ++n)
#pragma unroll
                    for (int j = 0; j < 4; ++j) { const float g = acc[ai][0][m][n][j], up = acc[ai][1][m][n][j];
                        r[n * 4 + j] = g * __builtin_amdgcn_rcpf(1.0f + __builtin_amdgcn_exp2f(-1.4426950408889634f * g)) * up; }
                u32x4 w; w.x = cvt_pk_bf16(r[0], r[1]); w.y = cvt_pk_bf16(r[2], r[3]); w.z = cvt_pk_bf16(r[4], r[5]); w.w = cvt_pk_bf16(r[6], r[7]);
                *(u32x4*)rowp = w; }
    }
};
template <int MAP> struct EpiResF32 {
    static constexpr bool PERM = false, AFTER_DRAIN = false;
    const float* base; float* out; int ldc;
    __device__ __forceinline__ void operator()(const f32x4 (&acc)[2][2][4][2], const Unit& u, int wr, int wc, int fr, int fq) const {
        const int row0 = u.pm * BM + wr * 64 + fr, col0 = u.pn * BM + wc * 32 + 4 * fq;
#pragma unroll
        for (int ai = 0; ai < 2; ++ai)
#pragma unroll
            for (int m = 0; m < 4; ++m) { const int r = row0 + ai * HALF + m * 16; const int br = MAP == 1 ? r + 16 * ((r >> 11) + 1) : r;
                const float* bp = base + (size_t)br * ldc + col0; float* op = out + (size_t)r * ldc + col0;
#pragma unroll
                for (int bj = 0; bj < 2; ++bj)
#pragma unroll
                    for (int n = 0; n < 2; ++n) { const f32x4 b = *(const f32x4*)(bp + bj * HALF + n * 16); *(f32x4*)(op + bj * HALF + n * 16) = b + acc[ai][bj][m][n]; } }
    }
};

template <class Epi, class Sched, bool ALIGN_EPI = false, bool SP2 = false>
__device__ __forceinline__ void gemm_phase(PG8_LAS unsigned char* lds, const Gemm g, const Sched& S, const Epi& E) {
    const int tid = threadIdx.x, wid = __builtin_amdgcn_readfirstlane(tid >> 6), lane = tid & 63, wr = wid >> 2, wc = wid & 3, fr = lane & 15, fq = lane >> 4;
    const int K = g.K, nt = K / BK;
    unsigned voffA[2], voffB[2];
#pragma unroll
    for (int i = 0; i < 2; ++i) { int R, C; stage_rc(tid * 16 + i * 8192, R, C); const int Rb = Epi::PERM ? ((R & ~31) + perm32(R & 31)) : R;
        voffA[i] = (unsigned)(R * K + C) * 2u; voffB[i] = (unsigned)(Rb * K + C) * 2u; }
    const size_t kstep = (size_t)(BK * 2);
    const size_t hstep = (size_t)HALF * K * 2;
    const size_t tstep = 2 * hstep;
    const unsigned ldsw = (unsigned)wid * 1024u;
    const int aoff = lds_byte(wr * 64 + fr, fq * 8), boff = lds_byte(wc * 32 + fr, fq * 8);
#define PG8_SA(b, h) (((b) * 2 + (h)) * HTB)
#define PG8_SB(b, h) ((4 + (b) * 2 + (h)) * HTB)
#define PG8_STAGE(bufoff, gbase, voff) do { _Pragma("unroll") for (int _i = 0; _i < 2; ++_i) \
        __builtin_amdgcn_global_load_lds((const unsigned*)((const char*)(gbase) + (voff)[_i]), (PG8_LAS unsigned*)(lds + (bufoff) + ldsw + _i * 8192), 16, 0, 0); } while (0)
#define PG8_LDA(dst, b, h) do { _Pragma("unroll") for (int m = 0; m < 4; ++m) _Pragma("unroll") for (int k = 0; k < 2; ++k) dst[m][k] = *(const PG8_LAS bf16x8*)(lds + PG8_SA(b, h) + aoff + m * 2048 + k * 1024); } while (0)
#define PG8_LDB(dst, b, h) do { _Pragma("unroll") for (int n = 0; n < 2; ++n) _Pragma("unroll") for (int k = 0; k < 2; ++k) dst[n][k] = *(const PG8_LAS bf16x8*)(lds + PG8_SB(b, h) + boff + n * 2048 + k * 1024); } while (0)
#define PG8_MMA(ai, bj, At, Bt) do { __builtin_amdgcn_s_setprio(1); _Pragma("unroll") for (int m = 0; m < 4; ++m) _Pragma("unroll") for (int n = 0; n < 2; ++n) _Pragma("unroll") for (int k = 0; k < 2; ++k) \
        acc[ai][bj][m][n] = __builtin_amdgcn_mfma_f32_16x16x32_bf16(Bt[n][k], At[m][k], acc[ai][bj][m][n], 0, 0, 0); __builtin_amdgcn_s_setprio(0); } while (0)
#define PG8_WAIT_V(n) asm volatile("s_waitcnt vmcnt(" #n ")" ::: "memory")
#define PG8_WAIT_L(n) asm volatile("s_waitcnt lgkmcnt(" #n ")" ::: "memory")
#define PG8_BAR __builtin_amdgcn_s_barrier()
#define PG8_SCHED __builtin_amdgcn_sched_barrier(0)
    Unit cur, nxt; int ui = 0;
    if (!S.next(0, cur)) return;
    f32x4 acc[2][2][4][2];
#pragma unroll
    for (int a = 0; a < 2; ++a)
#pragma unroll
        for (int b = 0; b < 2; ++b)
#pragma unroll
            for (int m = 0; m < 4; ++m)
#pragma unroll
                for (int n = 0; n < 2; ++n) acc[a][b][m][n] = (f32x4){0.f, 0.f, 0.f, 0.f};
    bf16x8 At[4][2], B0[2][2], B1[2][2];
    const char* cA = (const char*)g.A + (size_t)cur.pm * tstep; const char* cB = (const char*)g.Bt + (size_t)cur.e * g.estride + (size_t)cur.pn * tstep;
    S.a_ready(cur);
    if constexpr (SP2) {
        PG8_STAGE(PG8_SB(0, 0), cB, voffB); PG8_STAGE(PG8_SB(0, 1), cB + hstep, voffB); PG8_STAGE(PG8_SA(0, 0), cA, voffA); PG8_STAGE(PG8_SA(0, 1), cA + hstep, voffA);
        if (wr == 1) PG8_BAR;
        PG8_WAIT_V(2); PG8_BAR;
        PG8_STAGE(PG8_SB(1, 0), cB + kstep, voffB); PG8_STAGE(PG8_SA(1, 0), cA + kstep, voffA); PG8_STAGE(PG8_SB(1, 1), cB + hstep + kstep, voffB);
        PG8_WAIT_V(6); PG8_BAR;
    } else {
        PG8_STAGE(PG8_SB(0, 0), cB, voffB); PG8_STAGE(PG8_SA(0, 0), cA, voffA); PG8_STAGE(PG8_SB(0, 1), cB + hstep, voffB); PG8_STAGE(PG8_SA(0, 1), cA + hstep, voffA);
        if (wr == 1) PG8_BAR;
        PG8_WAIT_V(4); PG8_BAR;
        PG8_STAGE(PG8_SB(1, 0), cB + kstep, voffB); PG8_STAGE(PG8_SA(1, 0), cA + kstep, voffA); PG8_STAGE(PG8_SB(1, 1), cB + hstep + kstep, voffB);
        PG8_WAIT_V(6); PG8_BAR;
    }
    for (;;) {
        const bool has_next = S.next(ui + 1, nxt);
        const char* nA = has_next ? (const char*)g.A + (size_t)nxt.pm * tstep : cA; const char* nB = has_next ? (const char*)g.Bt + (size_t)nxt.e * g.estride + (size_t)nxt.pn * tstep : cB;
        for (int t = 0; t < nt; t += 2) {
            const bool last = (t == nt - 2);
            const char* a1 = cA + (size_t)(t + 1) * kstep;
            const char* a2 = last ? nA : cA + (size_t)(t + 2) * kstep; const char* b2 = last ? nB : cB + (size_t)(t + 2) * kstep;
            const char* a3 = a2 + kstep; const char* b3 = b2 + kstep;
            if (last && has_next) S.a_ready(nxt);
            if constexpr (SP2) {
            PG8_LDB(B0, 0, 0); PG8_LDB(B1, 0, 1); PG8_SCHED; PG8_LDA(At, 0, 0); PG8_STAGE(PG8_SA(1, 1), a1 + hstep, voffA);
            PG8_WAIT_V(8); PG8_WAIT_L(0); PG8_BAR; PG8_MMA(0, 0, At, B0); PG8_MMA(0, 1, At, B1); PG8_BAR; PG8_SCHED;
            PG8_LDA(At, 0, 1); PG8_STAGE(PG8_SB(0, 0), b2, voffB); PG8_STAGE(PG8_SB(0, 1), b2 + hstep, voffB); PG8_STAGE(PG8_SA(0, 0), a2, voffA);
            PG8_WAIT_V(8); PG8_WAIT_L(0); PG8_BAR; PG8_MMA(1, 0, At, B0); PG8_MMA(1, 1, At, B1); PG8_BAR; PG8_SCHED;
            PG8_LDB(B0, 1, 0); PG8_LDB(B1, 1, 1); PG8_SCHED; PG8_LDA(At, 1, 0); PG8_STAGE(PG8_SA(0, 1), a2 + hstep, voffA);
            PG8_WAIT_V(8); PG8_WAIT_L(0); PG8_BAR; PG8_MMA(0, 0, At, B0); PG8_MMA(0, 1, At, B1); PG8_BAR; PG8_SCHED;
            PG8_LDA(At, 1, 1); PG8_STAGE(PG8_SB(1, 0), b3, voffB); PG8_STAGE(PG8_SB(1, 1), b3 + hstep, voffB); PG8_STAGE(PG8_SA(1, 0), a3, voffA);
            PG8_WAIT_V(8); PG8_WAIT_L(0); PG8_BAR; PG8_MMA(1, 0, At, B0); PG8_MMA(1, 1, At, B1); PG8_BAR; PG8_SCHED;
            } else {
            PG8_LDB(B0, 0, 0); PG8_SCHED; PG8_LDA(At, 0, 0); PG8_STAGE(PG8_SA(1, 1), a1 + hstep, voffA);
            PG8_WAIT_L(8); PG8_BAR; PG8_WAIT_L(0); PG8_MMA(0, 0, At, B0); PG8_BAR; PG8_SCHED;
            PG8_LDB(B1, 0, 1); PG8_STAGE(PG8_SB(0, 0), b2, voffB);
            PG8_BAR; PG8_WAIT_L(0); PG8_MMA(0, 1, At, B1); PG8_BAR;
            PG8_LDA(At, 0, 1); PG8_STAGE(PG8_SA(0, 0), a2, voffA);
            PG8_BAR; PG8_WAIT_L(0); PG8_MMA(1, 0, At, B0); PG8_BAR; PG8_SCHED;
            PG8_STAGE(PG8_SB(0, 1), b2 + hstep, voffB);
            PG8_WAIT_V(6); PG8_BAR; PG8_MMA(1, 1, At, B1); PG8_BAR;
            PG8_LDB(B0, 1, 0); PG8_SCHED; PG8_LDA(At, 1, 0); PG8_STAGE(PG8_SA(0, 1), a2 + hstep, voffA);
            PG8_WAIT_L(8); PG8_BAR; PG8_WAIT_L(0); PG8_MMA(0, 0, At, B0); PG8_BAR; PG8_SCHED;
            PG8_LDB(B1, 1, 1); PG8_STAGE(PG8_SB(1, 0), b3, voffB);
            PG8_BAR; PG8_WAIT_L(0); PG8_MMA(0, 1, At, B1); PG8_BAR;
            PG8_LDA(At, 1, 1); PG8_STAGE(PG8_SA(1, 0), a3, voffA);
            PG8_BAR; PG8_WAIT_L(0); PG8_MMA(1, 0, At, B0); PG8_BAR; PG8_SCHED;
            PG8_STAGE(PG8_SB(1, 1), b3 + hstep, voffB);
            PG8_WAIT_V(6); PG8_BAR; PG8_MMA(1, 1, At, B1); PG8_BAR;
            }
        }
        if constexpr (ALIGN_EPI) { if (wr == 0) PG8_BAR; }
        if constexpr (!Epi::AFTER_DRAIN) { E(acc, cur, wr, wc, fr, fq); S.done(cur); }
        if (!has_next) break;
#pragma unroll
        for (int a = 0; a < 2; ++a)
#pragma unroll
            for (int b = 0; b < 2; ++b)
#pragma unroll
                for (int m = 0; m < 4; ++m)
#pragma unroll
                    for (int n = 0; n < 2; ++n) acc[a][b][m][n] = (f32x4){0.f, 0.f, 0.f, 0.f};
        cur = nxt; cA = nA; cB = nB; ++ui;
        if constexpr (ALIGN_EPI) { if (wr == 1) PG8_BAR; }
    }
    PG8_WAIT_V(0);
    if constexpr (!ALIGN_EPI) { if (wr == 0) PG8_BAR; }
    PG8_BAR;
    if constexpr (Epi::AFTER_DRAIN) { E.fused(acc, cur, wr, wc, fr, fq, lds, wid, lane); S.done(cur); }
#undef PG8_SA
#undef PG8_SB
#undef PG8_STAGE
#undef PG8_LDA
#undef PG8_LDB
#undef PG8_MMA
#undef PG8_WAIT_V
#undef PG8_WAIT_L
#undef PG8_BAR
#undef PG8_SCHED
}
}
#define GAS __attribute__((address_space(1)))
#define LAS __attribute__((address_space(3)))
typedef unsigned short bf16;
typedef unsigned v4u __attribute__((ext_vector_type(4)));
typedef float f32x4 __attribute__((ext_vector_type(4)));
typedef short bf16x8 __attribute__((ext_vector_type(8)));
typedef GAS unsigned gu32;
typedef GAS unsigned long long gu64;
#define RLX_AGENT __ATOMIC_RELAXED, __HIP_MEMORY_SCOPE_AGENT
#define LDS_WAIT() asm volatile("s_waitcnt lgkmcnt(0)" ::: "memory")
#define VM_WAIT() asm volatile("s_waitcnt vmcnt(0)" ::: "memory")
__device__ __forceinline__ unsigned long long rt() { return __builtin_amdgcn_s_memrealtime(); }
__device__ __forceinline__ unsigned f2bf(float f) { unsigned u = __builtin_bit_cast(unsigned, f); return (u + 0x7fffu + ((u >> 16) & 1u)) >> 16; }
__device__ __forceinline__ unsigned pk2(float lo, float hi) { return f2bf(lo) | (f2bf(hi) << 16); }

#define XB_TMO      128
#define XB_XCNT(j)  (256  + 64 * (j))
#define XB_XSUB(j)  (1280 + 64 * (j))
#define XB_XGEN(j)  (2304 + 64 * (j))
#define XB_TOP      3328
#define XB_TOPGEN   3392
#define XCD_BAR_WORDS 3456
#define XB_SPIN_CAP (1u << 22)

__device__ __forceinline__ unsigned xb_ld(unsigned* p)              { return __hip_atomic_load(p, __ATOMIC_RELAXED, __HIP_MEMORY_SCOPE_AGENT); }
__device__ __forceinline__ unsigned xb_add(unsigned* p, unsigned v) { return __hip_atomic_fetch_add(p, v, __ATOMIC_RELAXED, __HIP_MEMORY_SCOPE_AGENT); }
__device__ __forceinline__ unsigned xb_xcc_id() { return (unsigned)__builtin_amdgcn_s_getreg((3 << 11) | 20) & 0xFu; }
#define XB_SPIN(cond, bar) do { unsigned _sp = 0; while (cond) { __builtin_amdgcn_s_sleep(1); \
    if ((++_sp & 255u) == 0u) { if (xb_ld(&(bar)[XB_TMO])) break; if (_sp > XB_SPIN_CAP) { atomicAdd(&(bar)[XB_TMO], 1u); break; } } } } while (0)

struct XcdBarrier {
    unsigned* bar; unsigned x;
    volatile LAS unsigned* st;
};

__device__ __forceinline__ XcdBarrier xcd_barrier_post(unsigned* bar, volatile LAS unsigned* st) {
    XcdBarrier b; b.bar = bar; b.x = xb_xcc_id(); b.st = st;
    if (threadIdx.x == 0) (void)xb_add(&bar[XB_XCNT(b.x)], 1u);
    return b;
}
__device__ __forceinline__ void xcd_barrier_complete(unsigned* bar, unsigned x, unsigned& nloc, unsigned& nx) {
    const unsigned G = gridDim.x * gridDim.y * gridDim.z;
    unsigned sum, cnt, mine, sp = 0u;
    for (;;) {
        sum = 0u; cnt = 0u; mine = 0u;
#pragma unroll
        for (unsigned j = 0; j < 16; ++j) { const unsigned c = xb_ld(&bar[XB_XCNT(j)]); sum += c; cnt += (c > 0u) ? 1u : 0u; mine = (j == x) ? c : mine; }
        if (sum == G) break;
        __builtin_amdgcn_s_sleep(1);
        if ((++sp & 255u) == 0u) { if (xb_ld(&bar[XB_TMO])) break; if (sp > XB_SPIN_CAP) { atomicAdd(&bar[XB_TMO], 1u); break; } }
    }
    nloc = mine > 0u ? mine : 1u; nx = cnt > 0u ? cnt : 1u;
}

__device__ __forceinline__ void xcd_barrier(const XcdBarrier& b) {
    asm volatile("s_waitcnt vmcnt(0)" ::: "memory");
    __syncthreads();
    if (threadIdx.x == 0) {
        unsigned* bar = b.bar;
        __builtin_amdgcn_s_waitcnt(0);
        unsigned nloc = b.st[0], nx = b.st[1];
        if (nloc == 0u) { xcd_barrier_complete(bar, b.x, nloc, nx); b.st[0] = nloc; b.st[1] = nx; }
        const unsigned old = xb_add(&bar[XB_XSUB(b.x)], 1u);
        const unsigned gen = old / nloc;
        if (old + 1u == (gen + 1u) * nloc) {
            __builtin_amdgcn_fence(__ATOMIC_RELEASE, "agent");
            asm volatile("s_waitcnt vmcnt(0)" ::: "memory");
            const unsigned og = xb_add(&bar[XB_TOP], 1u);
            const unsigned tg = og / nx;
            if (og + 1u == (tg + 1u) * nx) xb_add(&bar[XB_TOPGEN], 1u);
            else XB_SPIN(xb_ld(&bar[XB_TOPGEN]) == tg, bar);
            __builtin_amdgcn_fence(__ATOMIC_ACQUIRE, "agent");
            xb_add(&bar[XB_XGEN(b.x)], 1u);
            asm volatile("s_waitcnt vmcnt(0)" ::: "memory");
        } else {
            XB_SPIN(xb_ld(&bar[XB_XGEN(b.x)]) == gen, bar);
            __builtin_amdgcn_fence(__ATOMIC_ACQUIRE, "agent");
            asm volatile("s_waitcnt vmcnt(0)" ::: "memory");
        }
    }
    __syncthreads();
}


constexpr int NB = 4, SEQ = 2048, DM = 2048, NMETA = 16, LSEQ = SEQ + NMETA, DFF = 5504, NH = 8, HDIM = 128, VDIM = 256, NEXP = 8;
constexpr int ML = NB * LSEQ;
constexpr int MLP = 8448;
constexpr int MS = NB * SEQ;
constexpr int NGU = 2 * DFF;
constexpr int MPERM = 18432;
constexpr float RMS_EPS = 1e-6f;
constexpr int NWAVES = 8;

constexpr size_t MiB = 1u << 20;
constexpr size_t WS_CTL = 0, CTL_ZERO_BYTES = 1 * MiB;
constexpr size_t WS_WKV = 1 * MiB;
constexpr size_t WS_WQ = WS_WKV + 16 * MiB;
constexpr size_t WS_WO2 = WS_WQ + 8 * MiB;
constexpr size_t WS_MGU = WS_WO2 + 8 * MiB;
constexpr size_t SZ_GU = (size_t)NGU * DM * 2;
constexpr size_t WS_MD = WS_MGU + 8 * SZ_GU;
constexpr size_t SZ_D = (size_t)DM * DFF * 2;
constexpr size_t WS_HBUF = WS_MD + 8 * SZ_D;
constexpr size_t WS_KVB = WS_HBUF + (size_t)MLP * DM * 4;
constexpr size_t WS_UQ = WS_KVB + (size_t)MLP * 4096 * 2;
constexpr size_t WS_QB = WS_UQ + (size_t)MS * DM * 2;
constexpr size_t WS_OB = WS_QB + (size_t)MS * DM * 2;
constexpr size_t WS_ON = WS_UQ;
constexpr size_t WS_H3 = WS_OB + (size_t)2 * MS * DM * 4;
constexpr size_t WS_UM = WS_QB;
constexpr size_t WS_MISC = WS_H3 + (size_t)MS * DM * 4;
constexpr size_t WS_R0 = WS_MISC + 4 * MiB;
constexpr size_t WS_WIN = WS_R0;
constexpr size_t WS_WG = WS_WIN + 16 * MiB;
constexpr size_t WS_WOUT = WS_WG + 1 * MiB;
constexpr size_t WS_WGU = WS_WOUT + 8 * MiB;
constexpr size_t WS_WD = WS_WGU + SZ_GU;
constexpr size_t WS_U = WS_WD + SZ_D;
constexpr size_t WS_XG = WS_U + (size_t)MLP * DM * 2;
constexpr size_t WS_HSL = WS_XG + (size_t)MLP * 4096 * 2;
constexpr size_t WS_PC = WS_HSL + (size_t)MLP * DM * 2;
constexpr size_t WS_CSUM = WS_PC + (size_t)MLP * DM * 2;
constexpr size_t WS_Y = WS_CSUM + 3 * MiB;
constexpr size_t WS_ACT = WS_Y + (size_t)MLP * DM * 2;
constexpr size_t WS_R0_L0END = WS_ACT + (size_t)MLP * DFF * 2;
constexpr size_t WS_XPERM = WS_R0;
constexpr size_t WS_ACTP = WS_XPERM + (size_t)MPERM * DM * 2;
constexpr size_t WS_YP = WS_ACTP + (size_t)MPERM * DFF * 2;
constexpr size_t WS_R0_MOEEND = WS_YP + (size_t)MPERM * DM * 2;
constexpr size_t WS_END = WS_R0_L0END > WS_R0_MOEEND ? WS_R0_L0END : WS_R0_MOEEND;
static_assert(WS_END <= (size_t)1442840576, "d_ws map exceeds the guaranteed workspace");
constexpr int CW_BAR = 4096;
constexpr int CW_CNT = 16384;
constexpr int CW_CUR = 16384 + 1024;

constexpr int SCR_BYTES = 133120;
constexpr int LDSCTL_OFF = SCR_BYTES, MISC_OFF = LDSCTL_OFF + 320;
constexpr int LDS_BYTES = 147456;
static_assert(MISC_OFF + 128 <= LDS_BYTES, "LDS map");

constexpr int NPHASE = 18;
struct Args { const float* in[31]; float* out; unsigned char* ws; int ph_lo, ph_hi; };
static_assert(sizeof(Args) == 33 * 8 + 8, "Args has no padding");
struct Ctx { LAS unsigned char* lds; int tid, lane, wave, G, gw, NGW; };

__device__ __forceinline__ float wave_sum(float v) {
#pragma unroll
    for (int o = 1; o < 64; o <<= 1) v += __shfl_xor(v, o);
    return v;
}
typedef unsigned long long u64;

template <int MODE>
__device__ __forceinline__ void transpose_item(const float* __restrict__ W, int K, int N, bf16* __restrict__ WT, LAS float* scr, int item, int lane) {
    const int nblk = N / 64, kb = item / nblk, nb = item % nblk, k0 = 64 * kb, n0 = 64 * nb;
    const float* src = W + (size_t)k0 * N + n0 + lane;
#pragma unroll 16
    for (int i = 0; i < 64; ++i) scr[i * 65 + lane] = src[(size_t)i * N];
    LDS_WAIT(); asm volatile("" ::: "memory");
    const int c = lane & 7, nl = lane >> 3;
    const int drow0 = MODE == 0 ? n0 : ((n0 >> 7) * 256 + (n0 & 127) + (MODE == 2 ? 128 : 0));
#pragma unroll
    for (int j = 0; j < 8; ++j) { const int n = nl + 8 * j; const LAS float* s = scr + (8 * c) * 65 + n;
        v4u o; o.x = pk2(s[0 * 65], s[1 * 65]); o.y = pk2(s[2 * 65], s[3 * 65]); o.z = pk2(s[4 * 65], s[5 * 65]); o.w = pk2(s[6 * 65], s[7 * 65]);
        *(GAS v4u*)(WT + (size_t)(drow0 + n) * K + k0 + 8 * c) = o; }
    LDS_WAIT(); asm volatile("" ::: "memory");
}
__device__ __forceinline__ void rms_row(const float* xrow, const float* __restrict__ g, bf16* orow, float* hcopy, int lane) {
    const GAS f32x4* xr = (const GAS f32x4*)xrow + lane; const GAS f32x4* gr = (const GAS f32x4*)g + lane;
    f32x4 v[8]; float s = 0.f;
#pragma unroll
    for (int j = 0; j < 8; ++j) { v[j] = xr[64 * j]; s += (v[j].x * v[j].x + v[j].y * v[j].y) + (v[j].z * v[j].z + v[j].w * v[j].w); }
    if (hcopy) { GAS f32x4* hc = (GAS f32x4*)hcopy + lane;
#pragma unroll
        for (int j = 0; j < 8; ++j) hc[64 * j] = v[j]; }
    const float rstd = 1.f / sqrtf(wave_sum(s) * (1.f / DM) + RMS_EPS);
    GAS u64* o8 = (GAS u64*)orow + lane;
#pragma unroll
    for (int j = 0; j < 8; ++j) { const f32x4 gg = gr[64 * j]; const f32x4 y = v[j] * rstd * gg;
        o8[64 * j] = (u64)pk2(y.x, y.y) | ((u64)pk2(y.z, y.w) << 32); }
}

__device__ __forceinline__ void rms_row2(const float* xrow, const float* __restrict__ g1, bf16* o1, const float* __restrict__ g2, bf16* o2, int lane) {
    const GAS f32x4* xr = (const GAS f32x4*)xrow + lane;
    f32x4 v[8]; float s = 0.f;
#pragma unroll
    for (int j = 0; j < 8; ++j) { v[j] = xr[64 * j]; s += (v[j].x * v[j].x + v[j].y * v[j].y) + (v[j].z * v[j].z + v[j].w * v[j].w); }
    const float rstd = 1.f / sqrtf(wave_sum(s) * (1.f / DM) + RMS_EPS);
    { const GAS f32x4* gr = (const GAS f32x4*)g1 + lane; GAS u64* o8 = (GAS u64*)o1 + lane;
#pragma unroll
      for (int j = 0; j < 8; ++j) { const f32x4 y = v[j] * rstd * gr[64 * j]; o8[64 * j] = (u64)pk2(y.x, y.y) | ((u64)pk2(y.z, y.w) << 32); } }
    if (o2) { const GAS f32x4* gr = (const GAS f32x4*)g2 + lane; GAS u64* o8 = (GAS u64*)o2 + lane;
#pragma unroll
      for (int j = 0; j < 8; ++j) { const f32x4 y = v[j] * rstd * gr[64 * j]; o8[64 * j] = (u64)pk2(y.x, y.y) | ((u64)pk2(y.z, y.w) << 32); } }
}

struct ThinBf16 { bf16* O; int ldc; __device__ __forceinline__ void operator()(int row, int col, f32x4 v0, f32x4) const {
    typedef unsigned u32x2 __attribute__((ext_vector_type(2))); u32x2 pk; pk.x = pk2(v0.x, v0.y); pk.y = pk2(v0.z, v0.w); *(GAS u32x2*)(O + (size_t)row * ldc + col) = pk; } };
struct ThinRes { float* H; int ldc; __device__ __forceinline__ void operator()(int row, int col, f32x4 v0, f32x4) const {
    GAS f32x4* p = (GAS f32x4*)(H + (size_t)row * ldc + col); *p = *p + v0; } };
struct ThinSwiglu { bf16* O; int ldc; __device__ __forceinline__ void operator()(int row, int col, f32x4 g, f32x4 up) const {
    typedef unsigned u32x2 __attribute__((ext_vector_type(2))); f32x4 r;
#pragma unroll
    for (int j = 0; j < 4; ++j) r[j] = g[j] * __builtin_amdgcn_rcpf(1.0f + __builtin_amdgcn_exp2f(-1.4426950408889634f * g[j])) * up[j];
    u32x2 pk; pk.x = pk2(r.x, r.y); pk.y = pk2(r.z, r.w); *(GAS u32x2*)(O + (size_t)row * ldc + col) = pk; } };
template <int SETS, class Epi>
__device__ __forceinline__ void thin_gemm(const Ctx& C, const bf16* __restrict__ A, const bf16* __restrict__ Bt, int K, int nunits, int r0, const Epi& E) {
    const int lane = C.lane, w = C.wave, fr = lane & 15, fq = lane >> 4;
    const int nsteps = K / 32, s_lo = (w * nsteps) / 8, s_hi = ((w + 1) * nsteps) / 8;
    LAS float* red = (LAS float*)C.lds;
    for (int u = blockIdx.x; u < nunits; u += C.G) {
        const int hc = 16 * u;
        const size_t brow0 = SETS == 1 ? (size_t)(hc + fr) : (size_t)((hc >> 7) * 256 + (hc & 127) + fr);
        const bf16* bp0 = Bt + brow0 * K + 32 * s_lo + 8 * fq;
        const bf16* ap = A + (size_t)(r0 + fr) * K + 32 * s_lo + 8 * fq;
        f32x4 acc0[4], acc1[4];
#pragma unroll
        for (int mt = 0; mt < 4; ++mt) { acc0[mt] = (f32x4){0.f, 0.f, 0.f, 0.f}; acc1[mt] = (f32x4){0.f, 0.f, 0.f, 0.f}; }
#pragma unroll 2
        for (int k = 0; k < 32 * (s_hi - s_lo); k += 32) {
            const bf16x8 b0 = *(const GAS bf16x8*)(bp0 + k);
            bf16x8 b1 = b0; if (SETS == 2) b1 = *(const GAS bf16x8*)(bp0 + (size_t)128 * K + k);
#pragma unroll
            for (int mt = 0; mt < 4; ++mt) { const bf16x8 af = *(const GAS bf16x8*)(ap + (size_t)(16 * mt) * K + k);
                acc0[mt] = __builtin_amdgcn_mfma_f32_16x16x32_bf16(b0, af, acc0[mt], 0, 0, 0);
                if (SETS == 2) acc1[mt] = __builtin_amdgcn_mfma_f32_16x16x32_bf16(b1, af, acc1[mt], 0, 0, 0); }
        }
#pragma unroll
        for (int mt = 0; mt < 4; ++mt) { *(LAS f32x4*)(red + ((w * SETS + 0) * 4 + mt) * 256 + lane * 4) = acc0[mt];
            if (SETS == 2) *(LAS f32x4*)(red + ((w * SETS + 1) * 4 + mt) * 256 + lane * 4) = acc1[mt]; }
        __syncthreads();
        if (C.tid < 256) { const int mt = C.tid >> 6, l = C.tid & 63;
            f32x4 s0 = {0.f, 0.f, 0.f, 0.f}, s1 = {0.f, 0.f, 0.f, 0.f};
#pragma unroll
            for (int ww = 0; ww < 8; ++ww) { s0 += *(const LAS f32x4*)(red + ((ww * SETS + 0) * 4 + mt) * 256 + l * 4);
                if (SETS == 2) s1 += *(const LAS f32x4*)(red + ((ww * SETS + 1) * 4 + mt) * 256 + l * 4); }
            E(r0 + 16 * mt + (l & 15), hc + 4 * (l >> 4), s0, s1); }
        __syncthreads();
    }
}

constexpr int P2_T = 48, P2_NCH = LSEQ / P2_T  , P2_UNITS = 16 * NB * P2_NCH  ;
constexpr int P2_XS = 0, P2_XCF = P2_XS + 51 * 128 * 4, P2_XCB = P2_XCF + 48 * 128 * 4, P2_AS = P2_XCB + 48 * 272, P2_BS = P2_AS + 48 * 128 * 4, P2_END = P2_BS + 48 * 128 * 4;
static_assert(P2_END <= SCR_BYTES, "P2 LDS");
__device__ __forceinline__ float sigmoid_fast(float x) { return __builtin_amdgcn_rcpf(1.0f + __builtin_amdgcn_exp2f(-1.4426950408889634f * x)); }
__device__ __forceinline__ void phase2(const Args& a, const Ctx& C) {
    unsigned char* ws = a.ws;
    const bf16* XG = (const bf16*)(ws + WS_XG); const bf16* WG = (const bf16*)(ws + WS_WG);
    bf16* HSL = (bf16*)(ws + WS_HSL); bf16* PCb = (bf16*)(ws + WS_PC); float* CS = (float*)(ws + WS_CSUM);
    LAS float* XS = (LAS float*)(C.lds + P2_XS); LAS float* XCF = (LAS float*)(C.lds + P2_XCF); LAS unsigned char* XCB = C.lds + P2_XCB;
    LAS float* AS = (LAS float*)(C.lds + P2_AS); LAS float* BS = (LAS float*)(C.lds + P2_BS);
    const int tid = C.tid, lane = C.lane, w = C.wave, fr = lane & 15, fq = lane >> 4;
    const int per = (P2_UNITS + C.G - 1) / C.G;
    for (int k = 0; k < per; ++k) {
        const int u = (int)blockIdx.x * per + k; if (u >= P2_UNITS) break;
        const int g = u / (NB * P2_NCH), rem = u - g * (NB * P2_NCH), b = rem / P2_NCH, c = rem - b * P2_NCH;
        const int t0 = c * P2_T; const size_t Rb = (size_t)b * LSEQ;
        bf16x8 wr_[4], wi_[4];
        { const bf16* wrow = WG + ((size_t)g * 256 + 16 * w + fr) * 128 + 8 * fq;
#pragma unroll
          for (int ks = 0; ks < 4; ++ks) { wr_[ks] = *(const GAS bf16x8*)(wrow + 32 * ks); wi_[ks] = *(const GAS bf16x8*)(wrow + 128 * 128 + 32 * ks); } }
#pragma unroll
        for (int p = 0; p < 2; ++p) { const int q = tid + 512 * p; if (q < 51 * 16) { const int j = q >> 4, c8 = q & 15; const int t = t0 - 3 + j;
            f32x4 lo = {0.f, 0.f, 0.f, 0.f}, hi = {0.f, 0.f, 0.f, 0.f};
            if (t >= 0) { const v4u raw = *(const GAS v4u*)(XG + (Rb + t) * 4096 + 128 * g + 8 * c8);
                lo = (f32x4){__uint_as_float(raw.x << 16), __uint_as_float(raw.x & 0xffff0000u), __uint_as_float(raw.y << 16), __uint_as_float(raw.y & 0xffff0000u)};
                hi = (f32x4){__uint_as_float(raw.z << 16), __uint_as_float(raw.z & 0xffff0000u), __uint_as_float(raw.w << 16), __uint_as_float(raw.w & 0xffff0000u)}; }
            *(LAS f32x4*)(XS + j * 128 + 8 * c8) = lo; *(LAS f32x4*)(XS + j * 128 + 8 * c8 + 4) = hi; } }
        __syncthreads();
        { const int ch4 = tid & 31, rsub = tid >> 5; const int gc = 128 * g + 4 * ch4;
          const f32x4 cb = *(const GAS f32x4*)(a.in[5] + gc);
          f32x4 cw[4];
#pragma unroll
          for (int kk = 0; kk < 4; ++kk) cw[kk] = *(const GAS f32x4*)(a.in[4] + kk * DM + gc);
#pragma unroll
          for (int rr = 0; rr < 3; ++rr) { const int row = rsub + 16 * rr; f32x4 y = cb;
#pragma unroll
              for (int kk = 0; kk < 4; ++kk) y += cw[kk] * *(const LAS f32x4*)(XS + (row + kk) * 128 + 4 * ch4);
              *(LAS f32x4*)(XCF + row * 128 + 4 * ch4) = y;
              typedef unsigned u32x2 __attribute__((ext_vector_type(2)));
              u32x2 pk; pk.x = pk2(y.x, y.y); pk.y = pk2(y.z, y.w);
              *(LAS u32x2*)(XCB + row * 272 + 8 * ch4) = pk; } }
        __syncthreads();
        f32x4 accR[3], accI[3];
#pragma unroll
        for (int mt = 0; mt < 3; ++mt) { accR[mt] = (f32x4){0.f, 0.f, 0.f, 0.f}; accI[mt] = (f32x4){0.f, 0.f, 0.f, 0.f}; }
#pragma unroll
        for (int ks = 0; ks < 4; ++ks)
#pragma unroll
            for (int mt = 0; mt < 3; ++mt) { const bf16x8 af = *(const LAS bf16x8*)(XCB + (16 * mt + fr) * 272 + 64 * ks + 16 * fq);
                accR[mt] = __builtin_amdgcn_mfma_f32_16x16x32_bf16(wr_[ks], af, accR[mt], 0, 0, 0);
                accI[mt] = __builtin_amdgcn_mfma_f32_16x16x32_bf16(wi_[ks], af, accI[mt], 0, 0, 0); }
        { const int ch0 = 16 * w + 4 * fq, gc = 128 * g + ch0;
          const f32x4 brg = *(const GAS f32x4*)(a.in[7] + gc), big = *(const GAS f32x4*)(a.in[9] + gc), lam = *(const GAS f32x4*)(a.in[10] + gc);
          f32x4 sp8;
#pragma unroll
          for (int j = 0; j < 4; ++j) sp8[j] = -8.0f * log1pf(__expf(-lam[j]));
#pragma unroll
          for (int mt = 0; mt < 3; ++mt) { const int row = 16 * mt + fr; const f32x4 xc = *(const LAS f32x4*)(XCF + row * 128 + ch0);
              f32x4 av, bv;
#pragma unroll
              for (int j = 0; j < 4; ++j) { const float r = sigmoid_fast(accR[mt][j] + brg[j]), ig = sigmoid_fast(accI[mt][j] + big[j]);
                  const float la = r * sp8[j]; av[j] = __expf(la); bv[j] = sqrtf(-expm1f(2.0f * la)) * (ig * xc[j]); }
              *(LAS f32x4*)(AS + row * 128 + ch0) = av; *(LAS f32x4*)(BS + row * 128 + ch0) = bv; } }
        __syncthreads();
        if (tid < 128) { float h = 0.f, P = 1.f; const size_t o0 = (Rb + t0) * DM + 128 * g + tid;
#pragma unroll 8
            for (int row = 0; row < P2_T; ++row) { const float av = AS[row * 128 + tid], bv = BS[row * 128 + tid]; h = av * h + bv; P *= av;
                HSL[o0 + (size_t)row * DM] = (bf16)f2bf(h); PCb[o0 + (size_t)row * DM] = (bf16)f2bf(P); }
            const size_t cs = ((size_t)b * P2_NCH + c) * DM + 128 * g + tid; CS[cs] = P; CS[(size_t)NB * P2_NCH * DM + cs] = h; }
        __syncthreads();
    }
}
__device__ __forceinline__ void phase3(const Args& a, const Ctx& C) {
    unsigned char* ws = a.ws;
    const bf16* XG = (const bf16*)(ws + WS_XG); const bf16* HSL = (const bf16*)(ws + WS_HSL); const bf16* PCb = (const bf16*)(ws + WS_PC); const float* CS = (const float*)(ws + WS_CSUM);
    bf16* Y = (bf16*)(ws + WS_Y);
    typedef unsigned u32x2 __attribute__((ext_vector_type(2)));
    for (int wu = C.gw; wu < NB * P2_NCH * 8; wu += C.NGW) {
        const int cb = wu & 7, bc = wu >> 3, b = bc / P2_NCH, c = bc - b * P2_NCH; const int ch = 256 * cb + 4 * C.lane;
        f32x4 carry = {0.f, 0.f, 0.f, 0.f};
        for (int cc = 0; cc < c; ++cc) { const size_t cs = ((size_t)b * P2_NCH + cc) * DM + ch;
            const f32x4 A = *(const GAS f32x4*)(CS + cs), H = *(const GAS f32x4*)(CS + (size_t)NB * P2_NCH * DM + cs); carry = A * carry + H; }
        const size_t r0 = (size_t)b * LSEQ + (size_t)c * P2_T;
#pragma unroll 4
        for (int row = 0; row < P2_T; ++row) { const size_t o = (r0 + row) * DM + ch;
            const u32x2 hs = *(const GAS u32x2*)(HSL + o), pc = *(const GAS u32x2*)(PCb + o), gg = *(const GAS u32x2*)(XG + (r0 + row) * 4096 + DM + ch);
            const f32x4 hv = {__uint_as_float(hs.x << 16), __uint_as_float(hs.x & 0xffff0000u), __uint_as_float(hs.y << 16), __uint_as_float(hs.y & 0xffff0000u)};
            const f32x4 pv = {__uint_as_float(pc.x << 16), __uint_as_float(pc.x & 0xffff0000u), __uint_as_float(pc.y << 16), __uint_as_float(pc.y & 0xffff0000u)};
            const f32x4 gv = {__uint_as_float(gg.x << 16), __uint_as_float(gg.x & 0xffff0000u), __uint_as_float(gg.y << 16), __uint_as_float(gg.y & 0xffff0000u)};
            f32x4 y;
#pragma unroll
            for (int j = 0; j < 4; ++j) { const float gx = gv[j]; const float z2 = 1.5957691216057308f * (gx + 0.044715f * gx * gx * gx);
                const float gl = gx * __builtin_amdgcn_rcpf(1.0f + __builtin_amdgcn_exp2f(-1.4426950408889634f * z2)); y[j] = (hv[j] + pv[j] * carry[j]) * gl; }
            u32x2 pk; pk.x = pk2(y.x, y.y); pk.y = pk2(y.z, y.w); *(GAS u32x2*)(Y + o) = pk; }
    }
}

namespace attn {
constexpr int D = 128;
constexpr float THR = 8.f;
constexpr bool WSKIP = false;
constexpr int QP = 2048, KVP = 4096, OP = 2048;
constexpr float SCALE = 0.08838834764831845f;
constexpr int NW = 8, QBLK = 32, KVBLK = 64, QB = NW * QBLK;
constexpr int SHM_V = KVBLK * D * 2, SHM_K = KVBLK * D * 2;
constexpr int LDS_BYTES = 2 * SHM_V + 2 * SHM_K + NW * 64 * 4;
typedef unsigned short bf16;
typedef short bf16x8 __attribute__((ext_vector_type(8)));
typedef short s16x4 __attribute__((ext_vector_type(4)));
typedef float f32x16 __attribute__((ext_vector_type(16)));
typedef float f32x4 __attribute__((ext_vector_type(4)));
typedef unsigned u32x4 __attribute__((ext_vector_type(4)));
template <class A, class Bt> struct same_t { static constexpr bool v = false; };
template <class A> struct same_t<A, A> { static constexpr bool v = true; };
#define KSWZ(row, colB) ((row) * 256 + ((colB) ^ (((row) & 7) << 4)))
#define SBAR() __builtin_amdgcn_sched_barrier(0)
__device__ __forceinline__ int v_st(int k, int c) { const int kk = (k & ~0xC) | ((k & 4) << 1) | ((k & 8) >> 1); return ((kk >> 3) * 4 + (c >> 5)) * 512 + ((kk & 7) * 32 + (c & 31)) * 2; }
__device__ __forceinline__ int v_rd_base(int lane) { return ((lane & 3) << 3) | (((lane >> 2) & 3) << 6) | (((lane >> 4) & 1) << 5) | (((lane >> 5) & 1) << 8); }
constexpr int v_rd_off(int d0, int ks, int half) { return d0 * 512 + ks * 4096 + half * 2048; }
__device__ __forceinline__ int crow(int r, int hi) { return (r & 3) + 8 * (r >> 2) + 4 * hi; }
__device__ __forceinline__ unsigned cvtpk(float lo, float hi) {
    unsigned r; asm volatile("v_cvt_pk_bf16_f32 %0, %1, %2" : "=v"(r) : "v"(lo), "v"(hi)); return r;
}
__device__ __forceinline__ bf16x8 pack8(f32x4 a, f32x4 b) {
    u32x4 w = {cvtpk(a[0], a[1]), cvtpk(a[2], a[3]), cvtpk(b[0], b[1]), cvtpk(b[2], b[3])};
    return *reinterpret_cast<bf16x8*>(&w);
}
template <class T> __device__ __forceinline__ bf16x8 load8(const T* p) {
    if constexpr (same_t<T, float>::v) { return pack8(*(const f32x4*)p, *(const f32x4*)(p + 4)); }
    else { return *reinterpret_cast<const bf16x8*>(p); }
}
__device__ __forceinline__ void bias_tile(f32x16& p0, f32x16& p1, float cb, float b0) {
    const float b1 = fmaf(cb, 32.f, b0);
#pragma unroll
    for (int r = 0; r < 16; ++r) { const float c = (float)((r & 3) + 8 * (r >> 2)); p0[r] += fmaf(cb, c, b0); p1[r] += fmaf(cb, c, b1); }
}
__device__ __forceinline__ void mask_tile(f32x16& p0, f32x16& p1, int dq, unsigned W) {
    const float NEG = -__builtin_inff();
#pragma unroll
    for (int r = 0; r < 16; ++r) {
        const int c = (r & 3) + 8 * (r >> 2);
        if ((unsigned)(dq - c) >= W) p0[r] = NEG;
        if ((unsigned)(dq - c - 32) >= W) p1[r] = NEG;
    }
}
__device__ __forceinline__ void partialSM(f32x16& p0, f32x16& p1, float& m_reg, float& mn, float& alpha) {
    float pmax = p0[0]; for (int r = 1; r < 16; ++r) pmax = fmaxf(pmax, p0[r]); for (int r = 0; r < 16; ++r) pmax = fmaxf(pmax, p1[r]);
    { auto rr = __builtin_amdgcn_permlane32_swap(__float_as_uint(pmax), __float_as_uint(pmax), false, false);
      pmax = fmaxf(__uint_as_float(rr[0]), __uint_as_float(rr[1])); }
    constexpr float C2 = 1.4426950408889634f * SCALE;
    if (__builtin_expect(__all((pmax - m_reg) * SCALE <= THR), 1)) { mn = m_reg; alpha = 1.f; }
    else { mn = fmaxf(m_reg, pmax); alpha = __builtin_amdgcn_exp2f((m_reg - mn) * C2); m_reg = mn; }
    const float mnL = -mn * C2;
    for (int r = 0; r < 16; ++r) p0[r] = fmaf(p0[r], C2, mnL); for (int r = 0; r < 16; ++r) p1[r] = fmaf(p1[r], C2, mnL);
    for (int r = 0; r < 16; ++r) p0[r] = __builtin_amdgcn_exp2f(p0[r]);
}
__device__ __forceinline__ void finishSM(f32x16& p0, f32x16& p1, float alpha, float& l_reg, bf16x8& pa0, bf16x8& pa1, bf16x8& pa2, bf16x8& pa3) {
    for (int r = 0; r < 16; ++r) p1[r] = __builtin_amdgcn_exp2f(p1[r]);
    float ps = 0; for (int r = 0; r < 16; ++r) ps += p0[r]; for (int r = 0; r < 16; ++r) ps += p1[r];
    { auto rr = __builtin_amdgcn_permlane32_swap(__float_as_uint(ps), __float_as_uint(ps), false, false);
      ps = __uint_as_float(rr[0]) + __uint_as_float(rr[1]); }
    l_reg = l_reg * alpha + ps;
#define PK4(P, B_, OUT) do { unsigned a0 = cvtpk(P[B_+0], P[B_+1]), a1 = cvtpk(P[B_+2], P[B_+3]);                          \
        unsigned b0 = cvtpk(P[B_+4], P[B_+5]), b1 = cvtpk(P[B_+6], P[B_+7]);                                             \
        auto r0 = __builtin_amdgcn_permlane32_swap(a0, b0, false, false); auto r1 = __builtin_amdgcn_permlane32_swap(a1, b1, false, false); \
        u32x4 w = {r0[0], r1[0], r0[1], r1[1]}; OUT = *reinterpret_cast<bf16x8*>(&w); } while (0)
    PK4(p0, 0, pa0); PK4(p0, 8, pa1); PK4(p1, 0, pa2); PK4(p1, 8, pa3);
#undef PK4
}
template <int KB, bool SK>
__device__ __forceinline__ void qkt(f32x16& p0, f32x16& p1, const char* K_lds, int r32, int hi, const bf16x8* qr, bool act) {
    if (SK && !act) { const float NEG = -__builtin_inff();
#pragma unroll
        for (int r = 0; r < 16; ++r) { p0[r] = NEG; p1[r] = NEG; } return; }
    p0 = f32x16{}; p1 = f32x16{};
    const char* kb[4];
#pragma unroll
    for (int dd = 0; dd < 4; ++dd) kb[dd] = K_lds + KB * SHM_K + KSWZ(r32, (dd * 16 + hi * 8) * 2);
#pragma unroll
    for (int d0 = 0; d0 < 8; ++d0) { const char* a = kb[d0 & 3] + (d0 >> 2) * 128;
        bf16x8 b0 = *reinterpret_cast<const bf16x8*>(a);
        bf16x8 b1 = *reinterpret_cast<const bf16x8*>(a + 32 * 256);
        p0 = __builtin_amdgcn_mfma_f32_32x32x16_bf16(b0, qr[d0], p0, 0, 0, 0);
        p1 = __builtin_amdgcn_mfma_f32_32x32x16_bf16(b1, qr[d0], p1, 0, 0, 0); }
}
template <int VB, bool SK>
__device__ __forceinline__ void pv_tile(f32x16* o, int vb0, bf16x8 pa0, bf16x8 pa1, bf16x8 pa2, bf16x8 pa3, bool act) {
    if (SK && !act) return;
#define TRRD(dst, off) asm volatile("ds_read_b64_tr_b16 %0, %1 offset:%2" : "=&v"(dst) : "v"(vb0), "i"(off) : "memory")
#define PV_D0(d0) do { s16x4 l0, l1, l2, l3, h0, h1, h2, h3; constexpr int b_ = VB * SHM_V + v_rd_off(d0, 0, 0);     \
        TRRD(l0, b_); TRRD(h0, b_ + 2048); TRRD(l1, b_ + 4096); TRRD(h1, b_ + 6144); TRRD(l2, b_ + 8192); TRRD(h2, b_ + 10240); TRRD(l3, b_ + 12288); TRRD(h3, b_ + 14336); \
        asm volatile("s_waitcnt lgkmcnt(0)" ::: "memory"); SBAR();                 \
        o[d0] = __builtin_amdgcn_mfma_f32_32x32x16_bf16(pa0, (bf16x8){l0[0], l0[1], l0[2], l0[3], h0[0], h0[1], h0[2], h0[3]}, o[d0], 0, 0, 0);   \
        o[d0] = __builtin_amdgcn_mfma_f32_32x32x16_bf16(pa1, (bf16x8){l1[0], l1[1], l1[2], l1[3], h1[0], h1[1], h1[2], h1[3]}, o[d0], 0, 0, 0);   \
        o[d0] = __builtin_amdgcn_mfma_f32_32x32x16_bf16(pa2, (bf16x8){l2[0], l2[1], l2[2], l2[3], h2[0], h2[1], h2[2], h2[3]}, o[d0], 0, 0, 0);   \
        o[d0] = __builtin_amdgcn_mfma_f32_32x32x16_bf16(pa3, (bf16x8){l3[0], l3[1], l3[2], l3[3], h3[0], h3[1], h3[2], h3[3]}, o[d0], 0, 0, 0); } while (0)
    PV_D0(0); PV_D0(1); PV_D0(2); PV_D0(3);
#undef PV_D0
#undef TRRD
}

template <class TIn, class TOut> struct BlockRef { const TIn* Q; const TIn* K; const TIn* V; TOut* O; int P0; float cb; };
template <class TIn> struct Seam {
    bf16x8 qr[8];
    bf16x8 st_v0, st_v1, st_k0, st_k1; f32x4 sf0, sf1, sf2, sf3;
    f32x4 tq[16];
};
__device__ __forceinline__ int swa_jlo(int P0, int W) { const int lowk = P0 - W + 1; return lowk > 0 ? lowk / KVBLK : 0; }
#define ROW(p, k0, rr) ((p) + (size_t)((k0) + (rr) - sr) * KVP + (unsigned)(sr * KVP + sc))
#define VMW() asm volatile("s_waitcnt vmcnt(0)" ::: "memory")
#define VMWN(n) asm volatile("s_waitcnt vmcnt(%0)" :: "i"(n) : "memory")
#define SLOAD_H(Kp, Vp, k0) do { S.st_v0 = load8<TIn>(ROW(Vp, k0, sr)); S.st_v1 = load8<TIn>(ROW(Vp, k0, 32 + sr));              \
                         S.st_k0 = load8<TIn>(ROW(Kp, k0, sr)); S.st_k1 = load8<TIn>(ROW(Kp, k0, 32 + sr)); } while (0)
#define SWRITE_HK(bf) do { *(bf16x8*)(K_lds + (bf) * SHM_K + kws) = S.st_k0; *(bf16x8*)(K_lds + (bf) * SHM_K + kws + 32 * 256) = S.st_k1; } while (0)
#define SWRITE_HV(bf) do { *(bf16x8*)(V_lds + (bf) * SHM_V + vst0) = S.st_v0; *(bf16x8*)(V_lds + (bf) * SHM_V + vst1) = S.st_v1; } while (0)
#define SWRITE_H(bf) do { SWRITE_HV(bf); SWRITE_HK(bf); } while (0)
#define SLOAD_F(p, k0) do { S.sf0 = *(const f32x4*)ROW(p, k0, sr); S.sf1 = *(const f32x4*)(ROW(p, k0, sr) + 4);                \
                            S.sf2 = *(const f32x4*)ROW(p, k0, 32 + sr); S.sf3 = *(const f32x4*)(ROW(p, k0, 32 + sr) + 4); } while (0)
#define SWRITE_KF(bf) do { *(bf16x8*)(K_lds + (bf) * SHM_K + kws) = pack8(S.sf0, S.sf1); *(bf16x8*)(K_lds + (bf) * SHM_K + kws + 32 * 256) = pack8(S.sf2, S.sf3); } while (0)
#define SWRITE_VF(bf) do { *(bf16x8*)(V_lds + (bf) * SHM_V + vst0) = pack8(S.sf0, S.sf1); *(bf16x8*)(V_lds + (bf) * SHM_V + vst1) = pack8(S.sf2, S.sf3); } while (0)
template <class TIn, class TOut>
__device__ __forceinline__ void causal_swa_prime(const BlockRef<TIn, TOut>& cur, int W, char* lds, Seam<TIn>& S) {
    constexpr bool F32 = same_t<TIn, float>::v;
    const int tid = threadIdx.x, wid = __builtin_amdgcn_readfirstlane(tid >> 6), lane = tid & 63, r32 = lane & 31, hi = lane >> 5;
    const int sr = tid >> 4, sc = (tid & 15) * 8, kws = KSWZ(sr, sc * 2); char* K_lds = lds + 2 * SHM_V;
    const int kb0 = swa_jlo(cur.P0, W) * KVBLK;
    for (int d0 = 0; d0 < 8; ++d0) S.qr[d0] = load8<TIn>(cur.Q + (size_t)(wid * QBLK) * QP + (unsigned)(r32 * QP + hi * 8) + d0 * 16);
    if constexpr (F32) { SLOAD_F((const float*)cur.K, kb0); VMW(); SWRITE_KF(0); SBAR(); SLOAD_F((const float*)cur.V, kb0); }
    else { SLOAD_H(cur.K, cur.V, kb0); VMW(); SWRITE_HK(0); }
    __syncthreads();
}
template <class TIn, class TOut>
__device__ __forceinline__ void causal_swa_block(const BlockRef<TIn, TOut>& cur, const BlockRef<TIn, TOut>& nxt, int skv, int W, char* lds, Seam<TIn>& S) {
    constexpr bool F32 = same_t<TIn, float>::v;
    const int tid = threadIdx.x, wid = __builtin_amdgcn_readfirstlane(tid >> 6), lane = tid & 63, r32 = lane & 31, hi = lane >> 5;
    const int j_lo = swa_jlo(cur.P0, W);
    int j_hi = (cur.P0 + QB - 1) / KVBLK + 1; if (j_hi > skv / KVBLK) j_hi = skv / KVBLK;
    const int NT = j_hi - j_lo;
    const int kbn = swa_jlo(nxt.P0, W) * KVBLK;
    const int qlo = cur.P0 + wid * QBLK, qm = qlo + r32 - 4 * hi;
    char* V_lds = lds; char* K_lds = lds + 2 * SHM_V;
    float* ws = (float*)(lds + 2 * SHM_V + 2 * SHM_K) + wid * 64; float* li_l = ws, * al_l = ws + 32;
    float m_reg = -1e30f, l_reg = 0; f32x16 o[4] = {};
    const int sr = tid >> 4, sc = (tid & 15) * 8, vst0 = v_st(sr, sc), vst1 = v_st(32 + sr, sc), kws = KSWZ(sr, sc * 2);
    const int vb0 = (int)(uintptr_t)V_lds + v_rd_base(lane);
    const TIn* Kh = cur.K; const TIn* Vh = cur.V;
#define RESC(a) do { if (__any((a) < 1.f)) { if (hi == 0) al_l[r32] = (a); asm volatile("s_waitcnt lgkmcnt(0)" ::: "memory");              \
                     for (int d_ = 0; d_ < 4; ++d_) for (int r = 0; r < 16; ++r) o[d_][r] *= al_l[crow(r, hi)]; } } while (0)
#define KBASE(t) ((j_lo + (t)) * KVBLK)
#define ACT(t) (KBASE(t) <= qlo + QBLK - 1 && KBASE(t) + KVBLK - 1 >= qlo - W + 1)
#define MASKT(P0_, P1_, t) do { const int kb_ = KBASE(t); bias_tile(P0_, P1_, cur.cb, cur.cb * (float)(kb_ + 4 * hi)); if ((!SK || ACT(t)) && (kb_ + KVBLK - 1 > qlo || kb_ <= qlo + QBLK - 1 - W)) mask_tile(P0_, P1_, qm - kb_, (unsigned)W); } while (0)
    constexpr int NQL = F32 ? 16 : 8;
    constexpr bool SK = WSKIP && !F32;
#define SEAM_K0() do { VMWN(NQL); if constexpr (F32) { SWRITE_KF(0); SBAR(); SLOAD_F((const float*)nxt.V, kbn); } else { SWRITE_HK(0); } SBAR(); } while (0)
    f32x16 pA0, pA1, pB0, pB1; float mnA, mnB, alA, alB; bf16x8 pa0, pa1, pa2, pa3;
    if constexpr (F32) { VMW(); SWRITE_VF(0); SBAR(); } else { SWRITE_HV(0); SBAR(); }
    if (NT > 1) { if constexpr (F32) SLOAD_F((const float*)Kh, KBASE(1)); else SLOAD_H(Kh, Vh, KBASE(1)); }
    SBAR(); qkt<0, SK>(pA0, pA1, K_lds, r32, hi, S.qr, ACT(0));
    if constexpr (F32) { if (NT > 1) { VMW(); SWRITE_KF(1); SBAR(); SLOAD_F((const float*)Vh, KBASE(1)); } }
    MASKT(pA0, pA1, 0); partialSM(pA0, pA1, m_reg, mnA, alA);
    if (NT > 1) { VMW(); if constexpr (F32) { SWRITE_VF(1); SBAR(); if (NT > 2) SLOAD_F((const float*)Kh, KBASE(2)); } else SWRITE_H(1); }
    __syncthreads();
#define HALF_STEP(PX0, PX1, mnX, alX, PY0, PY1, alY, t, KB, VB, SB) do {                                                      \
        SBAR(); qkt<KB, SK>(PX0, PX1, K_lds, r32, hi, S.qr, ACT(t));                                             \
        finishSM(PY0, PY1, alY, l_reg, pa0, pa1, pa2, pa3); SBAR();                                                           \
        if ((t) + 1 < NT) { if constexpr (F32) { VMW(); SWRITE_KF(SB); SBAR(); SLOAD_F((const float*)Vh, KBASE((t) + 1)); }  \
                            else { SLOAD_H(Kh, Vh, KBASE((t) + 1)); } SBAR(); }                                               \
        pv_tile<VB, SK>(o, vb0, pa0, pa1, pa2, pa3, ACT((t) - 1)); MASKT(PX0, PX1, (t)); partialSM(PX0, PX1, m_reg, mnX, alX);                                        \
        __syncthreads();                                                                                                      \
        if ((t) + 1 < NT) { VMW(); if constexpr (F32) { SWRITE_VF(SB); SBAR(); if ((t) + 2 < NT) SLOAD_F((const float*)Kh, KBASE((t) + 2)); } \
                            else { SWRITE_H(SB); } }                                                                          \
        RESC(alX); __syncthreads(); } while (0)
    for (int t = 1; t + 1 < NT; t += 2) {
        HALF_STEP(pB0, pB1, mnB, alB, pA0, pA1, alA, t, 1, 0, 0);
        HALF_STEP(pA0, pA1, mnA, alA, pB0, pB1, alB, t + 1, 0, 1, 1);
    }
    const bool even = (NT & 1) == 0;
    if (even) { SBAR(); qkt<1, SK>(pB0, pB1, K_lds, r32, hi, S.qr, ACT(NT - 1)); SBAR(); }
#define QROW(e) (nxt.Q + (size_t)(wid * QBLK + r32) * QP + ((e) >> 1) * 16 + hi * 8 + ((e) & 1) * 4)
    if constexpr (F32) { SLOAD_F((const float*)nxt.K, kbn); SBAR();
#pragma unroll
        for (int e = 0; e < 8; ++e) S.tq[e] = *(const f32x4*)QROW(e); }
    else { SLOAD_H(nxt.K, nxt.V, kbn); SBAR();
#pragma unroll
        for (int d0 = 0; d0 < 8; ++d0) S.qr[d0] = load8<TIn>(nxt.Q + (size_t)(wid * QBLK) * QP + (unsigned)(r32 * QP + hi * 8) + d0 * 16); }
    SBAR();
    finishSM(pA0, pA1, alA, l_reg, pa0, pa1, pa2, pa3); SBAR();
    if constexpr (F32) {
#pragma unroll
        for (int e = 8; e < 16; ++e) S.tq[e] = *(const f32x4*)QROW(e); SBAR(); }
#undef QROW
    pv_tile<0, SK>(o, vb0, pa0, pa1, pa2, pa3, ACT(even ? NT - 2 : NT - 1));
    if (even) { MASKT(pB0, pB1, NT - 1); partialSM(pB0, pB1, m_reg, mnB, alB); __syncthreads(); RESC(alB);
        finishSM(pB0, pB1, alB, l_reg, pa0, pa1, pa2, pa3); SBAR(); pv_tile<1, SK>(o, vb0, pa0, pa1, pa2, pa3, ACT(NT - 1)); }
    SBAR(); SEAM_K0();
    if (hi == 0) li_l[r32] = l_reg; asm volatile("s_waitcnt lgkmcnt(0)" ::: "memory");
    float rli[16];
#pragma unroll
    for (int r = 0; r < 16; ++r) rli[r] = __builtin_amdgcn_rcpf(li_l[crow(r, hi)]);
    TOut* Ow = cur.O + (size_t)(wid * QBLK) * OP;
#pragma unroll
    for (int r = 0; r < 16; ++r) { const int orow = crow(r, hi);
#pragma unroll
        for (int d0 = 0; d0 < 4; ++d0) { const float v = o[d0][r] * rli[r];
            if constexpr (same_t<TOut, float>::v) { Ow[(size_t)orow * OP + d0 * 32 + r32] = v; }
            else { const float vn = __shfl_xor(v, 1);
                   if ((r32 & 1) == 0) *(unsigned*)(Ow + (size_t)orow * OP + d0 * 32 + r32) = cvtpk(v, vn); } } }
    if constexpr (F32) {
#pragma unroll
        for (int d0 = 0; d0 < 8; ++d0) S.qr[d0] = pack8(S.tq[2 * d0], S.tq[2 * d0 + 1]); }
    __syncthreads();
#undef RESC
#undef KBASE
#undef ACT
#undef MASKT
#undef SEAM_K0
#undef HALF_STEP
}
#undef ROW
#undef VMW
#undef VMWN
#undef SLOAD_H
#undef SWRITE_HK
#undef SWRITE_HV
#undef SWRITE_H
#undef SLOAD_F
#undef SWRITE_KF
#undef SWRITE_VF
}

constexpr float LAMBDA_INIT = 0.35550906759096924f;
__device__ __forceinline__ attn::BlockRef<attn::bf16, float> attn_ref(unsigned char* ws, int bh, int qb) {
    const int b = bh >> 5, h = (bh >> 2) & 7, map = (bh >> 1) & 1, vh = bh & 1;
    attn::BlockRef<attn::bf16, float> r;
    r.Q = (const attn::bf16*)(ws + WS_QB) + ((size_t)b * SEQ + (size_t)qb * 256) * DM + map * 1024 + h * 128;
    r.K = (const attn::bf16*)(ws + WS_KVB) + (size_t)b * LSEQ * 4096 + map * 1024 + h * 128;
    r.V = (const attn::bf16*)(ws + WS_KVB) + (size_t)b * LSEQ * 4096 + 2048 + h * 256 + vh * 128;
    r.O = (float*)(ws + WS_OB) + (size_t)map * MS * DM + ((size_t)b * SEQ + (size_t)qb * 256) * DM + h * 256 + vh * 128;
    r.P0 = NMETA + qb * 256;
    r.cb = __builtin_amdgcn_exp2f(-(float)(h + 1)) * 11.313708498984761f;
    return r;
}
__device__ __forceinline__ void phase10(const Args& a, const Ctx& C, char* lds) {
    using namespace attn;
    constexpr int total = 4 * 128;
    constexpr int SKV = 2112, W = 0x40000000;
    int L = blockIdx.x; const int stride = C.G;
    if (L < total) {
        int bh = L >> 2, x = L & 3, pass = 0;
        BlockRef<bf16, float> cur = attn_ref(a.ws, bh, x);
        Seam<bf16> S;
        causal_swa_prime<bf16, float>(cur, W, lds, S);
        for (;;) {
            const bool more_pass = pass == 0, more_item = L + stride < total, last = !more_pass && !more_item;
            int bhn = bh, xn = x, passn = pass + 1, Ln = L;
            if (!more_pass) { passn = 0; Ln = more_item ? L + stride : L; bhn = Ln >> 2; xn = Ln & 3; }
            const BlockRef<bf16, float> nxt = last ? cur : attn_ref(a.ws, bhn, passn ? 7 - xn : xn);
            causal_swa_block<bf16, float>(cur, nxt, SKV, W, lds, S);
            if (last) break;
            cur = nxt; bh = bhn; x = xn; pass = passn; L = Ln;
        }
    }
}
__device__ __forceinline__ void phase11(const Args& a, const Ctx& C) {
    unsigned char* ws = a.ws;
    const float* O1 = (const float*)(ws + WS_OB); const float* O2 = O1 + (size_t)MS * DM; bf16* ON = (bf16*)(ws + WS_ON);
    const int lane = C.lane;
    float lam;
    { const float s1 = wave_sum(a.in[16][lane] * a.in[17][lane] + a.in[16][lane + 64] * a.in[17][lane + 64]);
      const float s2 = wave_sum(a.in[18][lane] * a.in[19][lane] + a.in[18][lane + 64] * a.in[19][lane + 64]);
      lam = __expf(s1) - __expf(s2) + LAMBDA_INIT; }
    const f32x4 gs = *((const GAS f32x4*)a.in[20] + lane) * (1.0f - LAMBDA_INIT);
    for (int row = C.gw; row < MS; row += C.NGW) {
        const GAS f32x4* p1 = (const GAS f32x4*)(O1 + (size_t)row * DM) + lane; const GAS f32x4* p2 = (const GAS f32x4*)(O2 + (size_t)row * DM) + lane;
        GAS u64* o8 = (GAS u64*)(ON + (size_t)row * DM) + lane;
        f32x4 v[8];
#pragma unroll
        for (int j = 0; j < 8; ++j) v[j] = p1[64 * j] - lam * p2[64 * j];
#pragma unroll
        for (int j = 0; j < 8; ++j) { const float s = wave_sum((v[j].x * v[j].x + v[j].y * v[j].y) + (v[j].z * v[j].z + v[j].w * v[j].w));
            const float rstd = 1.f / sqrtf(s * (1.f / VDIM) + RMS_EPS); const f32x4 y = v[j] * rstd * gs;
            o8[64 * j] = (u64)pk2(y.x, y.y) | ((u64)pk2(y.z, y.w) << 32); }
    }
}

constexpr size_t MISC_TOKE = 0, MISC_TOKW = 64 * 1024, MISC_TOKS = 128 * 1024, MISC_PE = 192 * 1024;
__device__ __forceinline__ void phase13(const Args& a, const Ctx& C) {
    unsigned char* ws = a.ws; const int lane = C.lane;
    const float* H3 = (const float*)(ws + WS_H3); bf16* UM = (bf16*)(ws + WS_UM);
    int* TOKE = (int*)(ws + WS_MISC + MISC_TOKE); float* TOKW = (float*)(ws + WS_MISC + MISC_TOKW);
    LAS float* RL = (LAS float*)C.lds;
    LAS unsigned* hist = (LAS unsigned*)(C.lds + MISC_OFF) + 16;
    for (int i = C.tid; i < DM * NEXP / 4; i += NWAVES * 64) *((LAS f32x4*)RL + i) = *((const GAS f32x4*)a.in[26] + i);
    __syncthreads();
    const float* gain = a.in[22] + DM;
    for (int row = C.gw; row < MS; row += C.NGW) {
        const GAS f32x4* xr = (const GAS f32x4*)(H3 + (size_t)row * DM) + lane; const GAS f32x4* gr = (const GAS f32x4*)gain + lane;
        f32x4 v[8]; float s = 0.f;
#pragma unroll
        for (int j = 0; j < 8; ++j) { v[j] = xr[64 * j]; s += (v[j].x * v[j].x + v[j].y * v[j].y) + (v[j].z * v[j].z + v[j].w * v[j].w); }
        const float rstd = 1.f / sqrtf(wave_sum(s) * (1.f / DM) + RMS_EPS);
        GAS u64* o8 = (GAS u64*)(UM + (size_t)row * DM) + lane;
        float p[8];
#pragma unroll
        for (int e = 0; e < 8; ++e) p[e] = 0.f;
#pragma unroll
        for (int j = 0; j < 8; ++j) { const f32x4 y = v[j] * rstd * gr[64 * j];
            o8[64 * j] = (u64)pk2(y.x, y.y) | ((u64)pk2(y.z, y.w) << 32);
#pragma unroll
            for (int i = 0; i < 4; ++i) { const LAS f32x4* rr = (const LAS f32x4*)(RL + (256 * j + 4 * lane + i) * 8); const f32x4 r0 = rr[0], r1 = rr[1];
                p[0] += y[i] * r0.x; p[1] += y[i] * r0.y; p[2] += y[i] * r0.z; p[3] += y[i] * r0.w; p[4] += y[i] * r1.x; p[5] += y[i] * r1.y; p[6] += y[i] * r1.z; p[7] += y[i] * r1.w; } }
#pragma unroll
        for (int e = 0; e < 8; ++e) p[e] = wave_sum(p[e]);
        int i1 = 0; float v1 = p[0];
#pragma unroll
        for (int e = 1; e < 8; ++e) if (p[e] > v1) { v1 = p[e]; i1 = e; }
        int i2 = -1; float v2 = -__builtin_inff();
#pragma unroll
        for (int e = 0; e < 8; ++e) if (e != i1 && p[e] > v2) { v2 = p[e]; i2 = e; }
        const float e2 = __expf(v2 - v1), w1 = 1.f / (1.f + e2), w2 = e2 * w1;
        if (lane == 0) { TOKE[2 * row] = i1; TOKE[2 * row + 1] = i2; TOKW[2 * row] = w1; TOKW[2 * row + 1] = w2;
            __hip_atomic_fetch_add(hist + i1, 1u, __ATOMIC_RELAXED, __HIP_MEMORY_SCOPE_WORKGROUP); __hip_atomic_fetch_add(hist + i2, 1u, __ATOMIC_RELAXED, __HIP_MEMORY_SCOPE_WORKGROUP); }
    }
    __syncthreads();
    if (C.tid < 8) { const unsigned hcount = hist[C.tid]; if (hcount) __hip_atomic_fetch_add((unsigned*)((gu32*)(ws + WS_CTL) + CW_CNT + 64 * C.tid), hcount, RLX_AGENT); }
}
struct ExpTab { int cnt[8], np[8], pb[8]; int npanels; };
__device__ __forceinline__ void load_exptab(unsigned char* ws, ExpTab& T) {
    int acc = 0;
#pragma unroll
    for (int e = 0; e < 8; ++e) { const int c = __builtin_amdgcn_readfirstlane((int)__hip_atomic_load((unsigned*)((gu32*)(ws + WS_CTL) + CW_CNT + 64 * e), RLX_AGENT));
        T.cnt[e] = c; T.np[e] = (c + 255) >> 8; T.pb[e] = acc; acc += T.np[e]; }
    T.npanels = acc;
}
__device__ __forceinline__ void phase14(const Args& a, const Ctx& C) {
    unsigned char* ws = a.ws; const int lane = C.lane;
    const bf16* UM = (const bf16*)(ws + WS_UM); bf16* XP = (bf16*)(ws + WS_XPERM);
    const int* TOKE = (const int*)(ws + WS_MISC + MISC_TOKE); int* TOKS = (int*)(ws + WS_MISC + MISC_TOKS);
    ExpTab T; load_exptab(ws, T);
    for (int row = C.gw; row < MS; row += C.NGW) {
        int s1 = 0, s2 = 0;
        if (lane == 0) { const int e1 = TOKE[2 * row], e2 = TOKE[2 * row + 1]; int b1 = 0, b2 = 0;
#pragma unroll
            for (int e = 0; e < 8; ++e) { if (e == e1) b1 = T.pb[e]; if (e == e2) b2 = T.pb[e]; }
            s1 = b1 * 256 + (int)__hip_atomic_fetch_add((unsigned*)((gu32*)(ws + WS_CTL) + CW_CUR + 64 * e1), 1u, RLX_AGENT);
            s2 = b2 * 256 + (int)__hip_atomic_fetch_add((unsigned*)((gu32*)(ws + WS_CTL) + CW_CUR + 64 * e2), 1u, RLX_AGENT);
            TOKS[2 * row] = s1; TOKS[2 * row + 1] = s2; }
        s1 = __builtin_amdgcn_readfirstlane(s1); s2 = __builtin_amdgcn_readfirstlane(s2);
        const GAS v4u* src = (const GAS v4u*)(UM + (size_t)row * DM) + lane; GAS v4u* d1 = (GAS v4u*)(XP + (size_t)s1 * DM) + lane; GAS v4u* d2 = (GAS v4u*)(XP + (size_t)s2 * DM) + lane;
#pragma unroll
        for (int j = 0; j < 4; ++j) { const v4u x = src[64 * j]; d1[64 * j] = x; d2[64 * j] = x; }
    }
    if (blockIdx.x == 0 && C.tid < 128 && C.tid < T.npanels) { int e = 0;
#pragma unroll
        for (int q = 1; q < 8; ++q) e += (C.tid >= T.pb[q]) ? 1 : 0;
        ((int*)(ws + WS_MISC + MISC_PE))[C.tid] = e; }
    for (int pr = C.gw; pr < 8 * 256; pr += C.NGW) { const int e = pr >> 8, r = pr & 255; int cnt = 0, pb = 0, np = 0;
#pragma unroll
        for (int q = 0; q < 8; ++q) if (q == e) { cnt = T.cnt[q]; pb = T.pb[q]; np = T.np[q]; }
        const int row = pb * 256 + cnt + r;
        if (row < (pb + np) * 256) { GAS v4u* d = (GAS v4u*)(XP + (size_t)row * DM) + lane; const v4u z = {0u, 0u, 0u, 0u};
#pragma unroll
            for (int j = 0; j < 4; ++j) d[64 * j] = z; } }
}
__device__ __forceinline__ void make_grouped(unsigned char* ws, pg8::GroupedOrder& S, int nN, int G, int c) {
    int npanels = 0;
#pragma unroll
    for (int e = 0; e < 8; ++e) { const int cn = __builtin_amdgcn_readfirstlane((int)__hip_atomic_load((unsigned*)((gu32*)(ws + WS_CTL) + CW_CNT + 64 * e), RLX_AGENT)); npanels += (cn + 255) >> 8; }
    S.nM = npanels; S.nN = nN; S.nwg = npanels * nN; S.G = G; S.c = c; S.pe = (const int*)(ws + WS_MISC + MISC_PE);
}
__device__ __forceinline__ void phase17(const Args& a, const Ctx& C) {
    unsigned char* ws = a.ws; const int lane = C.lane;
    const float* H3 = (const float*)(ws + WS_H3); const bf16* YP = (const bf16*)(ws + WS_YP);
    const int* TOKS = (const int*)(ws + WS_MISC + MISC_TOKS); const float* TOKW = (const float*)(ws + WS_MISC + MISC_TOKW);
    typedef unsigned u32x2 __attribute__((ext_vector_type(2)));
    for (int row = C.gw; row < MS; row += C.NGW) {
        const int s1 = TOKS[2 * row], s2 = TOKS[2 * row + 1]; const float w1 = TOKW[2 * row], w2 = TOKW[2 * row + 1];
        const GAS f32x4* xr = (const GAS f32x4*)(H3 + (size_t)row * DM) + lane; const GAS f32x4* gr = (const GAS f32x4*)a.in[30] + lane;
        const GAS u32x2* y1 = (const GAS u32x2*)(YP + (size_t)s1 * DM) + lane; const GAS u32x2* y2 = (const GAS u32x2*)(YP + (size_t)s2 * DM) + lane;
        f32x4 v[8]; float s = 0.f;
#pragma unroll
        for (int j = 0; j < 8; ++j) { const u32x2 q1 = y1[64 * j], q2 = y2[64 * j];
            const f32x4 f1 = {__uint_as_float(q1.x << 16), __uint_as_float(q1.x & 0xffff0000u), __uint_as_float(q1.y << 16), __uint_as_float(q1.y & 0xffff0000u)};
            const f32x4 f2 = {__uint_as_float(q2.x << 16), __uint_as_float(q2.x & 0xffff0000u), __uint_as_float(q2.y << 16), __uint_as_float(q2.y & 0xffff0000u)};
            v[j] = xr[64 * j] + w1 * f1 + w2 * f2; s += (v[j].x * v[j].x + v[j].y * v[j].y) + (v[j].z * v[j].z + v[j].w * v[j].w); }
        const float rstd = 1.f / sqrtf(wave_sum(s) * (1.f / DM) + RMS_EPS);
        GAS f32x4* op = (GAS f32x4*)(a.out + (size_t)row * DM) + lane;
#pragma unroll
        for (int j = 0; j < 8; ++j) op[64 * j] = v[j] * rstd * gr[64 * j];
    }
}


__device__ __forceinline__ void phase0(const Args& a, const Ctx& C) {
    unsigned char* ws = a.ws;
    LAS float* scr = (LAS float*)(C.lds + C.wave * 16640);
    constexpr int I_SQ = 32 * 32, I_IN = 32 * 64, I_GU = 32 * 86, I_DN = 86 * 32, I_E = 2 * I_GU + I_DN;
    constexpr int NITEMS = 8 * I_E + I_IN + 2 * I_SQ + (2 * I_GU + I_DN) + I_SQ + I_IN;
    for (int it = C.gw; it < NITEMS; it += C.NGW) {
        int r = it;
        if (r < 8 * I_E) { const int e = r / I_E; int q = r - e * I_E;
            if (q < I_GU) { transpose_item<1>(a.in[27] + (size_t)e * DM * DFF, DM, DFF, (bf16*)(ws + WS_MGU + e * SZ_GU), scr, q, C.lane); continue; } q -= I_GU;
            if (q < I_GU) { transpose_item<2>(a.in[28] + (size_t)e * DM * DFF, DM, DFF, (bf16*)(ws + WS_MGU + e * SZ_GU), scr, q, C.lane); continue; } q -= I_GU;
            transpose_item<0>(a.in[29] + (size_t)e * DFF * DM, DFF, DM, (bf16*)(ws + WS_MD + e * SZ_D), scr, q, C.lane); continue; }
        r -= 8 * I_E;
        if (r < I_IN) { transpose_item<0>(a.in[13], DM, 4096, (bf16*)(ws + WS_WKV), scr, r, C.lane); continue; } r -= I_IN;
        if (r < I_SQ) { transpose_item<0>(a.in[15], DM, DM, (bf16*)(ws + WS_WQ), scr, r, C.lane); continue; } r -= I_SQ;
        if (r < I_SQ) { transpose_item<0>(a.in[21], DM, DM, (bf16*)(ws + WS_WO2), scr, r, C.lane); continue; } r -= I_SQ;
        if (r < I_GU) { transpose_item<1>(a.in[23], DM, DFF, (bf16*)(ws + WS_WGU), scr, r, C.lane); continue; } r -= I_GU;
        if (r < I_GU) { transpose_item<2>(a.in[24], DM, DFF, (bf16*)(ws + WS_WGU), scr, r, C.lane); continue; } r -= I_GU;
        if (r < I_DN) { transpose_item<0>(a.in[25], DFF, DM, (bf16*)(ws + WS_WD), scr, r, C.lane); continue; } r -= I_DN;
        if (r < I_SQ) { transpose_item<0>(a.in[11], DM, DM, (bf16*)(ws + WS_WOUT), scr, r, C.lane); continue; } r -= I_SQ;
        transpose_item<0>(a.in[3], DM, 4096, (bf16*)(ws + WS_WIN), scr, r, C.lane);
    }
    { bf16* wg = (bf16*)(ws + WS_WG); const float* rg = a.in[6]; const float* ig = a.in[8];
      for (int idx = C.gw * 64 + C.lane; idx < 16 * 256 * 128; idx += C.NGW * 64) { const int g = idx >> 15, jj = (idx >> 7) & 255, i = idx & 127;
          const float v = (jj < 128 ? rg : ig)[(size_t)g * 16384 + i * 128 + (jj & 127)]; wg[idx] = (bf16)f2bf(v); } }
    { v4u* z = (v4u*)(ws + WS_KVB + (size_t)ML * 4096 * 2); const v4u zero = {0u, 0u, 0u, 0u}; for (int i = C.gw * 64 + C.lane; i < 64 * 4096 * 2 / 16; i += C.NGW * 64) z[i] = zero; }
    { float* hb = (float*)(ws + WS_HBUF); bf16* U = (bf16*)(ws + WS_U);
      for (int row = C.gw; row < ML; row += C.NGW) { const int b = row / LSEQ, t = row - b * LSEQ;
          const float* src = t < NMETA ? a.in[1] + (size_t)t * DM : a.in[0] + ((size_t)b * SEQ + (t - NMETA)) * DM;
          rms_row(src, a.in[2], U + (size_t)row * DM, hb + (size_t)row * DM, C.lane); } }
}

__global__ void __launch_bounds__(NWAVES * 64, 2) mk_fwd(Args args) {
    extern __shared__ __attribute__((aligned(16))) unsigned char lds_raw[];
    Ctx C;
    C.lds = (LAS unsigned char*)lds_raw;
    C.tid = threadIdx.x; C.lane = C.tid & 63; C.wave = __builtin_amdgcn_readfirstlane(C.tid >> 6);
    C.G = gridDim.x; C.gw = blockIdx.x * NWAVES + C.wave; C.NGW = C.G * NWAVES;
    volatile LAS unsigned* MISC = (volatile LAS unsigned*)(C.lds + MISC_OFF);
    unsigned char* ws = args.ws;
    gu32* ctl = (gu32*)(ws + WS_CTL);
    for (int u = C.tid; u < (LDS_BYTES - LDSCTL_OFF) / 4; u += NWAVES * 64) ((LAS unsigned*)(C.lds + LDSCTL_OFF))[u] = 0u;
    __syncthreads();
    const int lo = args.ph_lo, hi = args.ph_hi;
    XcdBarrier bar; bar.bar = (unsigned*)(ctl + CW_BAR); bar.x = 0; bar.st = nullptr;
    if (hi - lo > 1) bar = xcd_barrier_post((unsigned*)(ctl + CW_BAR), MISC + 8);
#define IN(k) (lo <= (k) && (k) < hi)
#define SEAM(k) do { if (IN(k) && IN((k) + 1)) xcd_barrier(bar); } while (0)

    if (IN(0)) { phase0(args, C); }
    SEAM(0);
    if (IN(1)) {
        pg8::Gemm g{(const pg8::bf16_t*)(ws + WS_U), (const pg8::bf16_t*)(ws + WS_WIN), DM, 0}; pg8::StaticOrder S; S.init(MS, 4096, C.G, (int)blockIdx.x);
        pg8::EpiBf16 E{(pg8::bf16_t*)(ws + WS_XG), 4096};
        thin_gemm<1>(C, (const bf16*)(ws + WS_U), (const bf16*)(ws + WS_WIN), DM, 4096 / 16, MS, ThinBf16{(bf16*)(ws + WS_XG), 4096});
        pg8::gemm_phase<pg8::EpiBf16, pg8::StaticOrder, true, true>(C.lds, g, S, E);
    }
    SEAM(1);
    if (IN(2)) { phase2(args, C); }
    SEAM(2);
    if (IN(3)) { phase3(args, C); }
    SEAM(3);
    if (IN(4)) {
        thin_gemm<1>(C, (const bf16*)(ws + WS_Y), (const bf16*)(ws + WS_WOUT), DM, DM / 16, MS, ThinRes{(float*)(ws + WS_HBUF), DM});
        pg8::Gemm g{(const pg8::bf16_t*)(ws + WS_Y), (const pg8::bf16_t*)(ws + WS_WOUT), DM, 0}; pg8::StaticOrder S; S.init(MS, DM, C.G, (int)blockIdx.x);
        pg8::EpiResF32<0> E{(const float*)(ws + WS_HBUF), (float*)(ws + WS_HBUF), DM};
        pg8::gemm_phase<pg8::EpiResF32<0>, pg8::StaticOrder, true, true>(C.lds, g, S, E);
    }
    SEAM(4);
    if (IN(5)) {
        const float* hb = (const float*)(ws + WS_HBUF); bf16* U = (bf16*)(ws + WS_U);
        for (int row = C.gw; row < ML; row += C.NGW) rms_row(hb + (size_t)row * DM, args.in[22], U + (size_t)row * DM, nullptr, C.lane);
    }
    SEAM(5);
    if (IN(6)) {
        thin_gemm<2>(C, (const bf16*)(ws + WS_U), (const bf16*)(ws + WS_WGU), DM, DFF / 16, MS, ThinSwiglu{(bf16*)(ws + WS_ACT), DFF});
        pg8::Gemm g{(const pg8::bf16_t*)(ws + WS_U), (const pg8::bf16_t*)(ws + WS_WGU), DM, 0}; pg8::StaticOrder S; S.init(MS, NGU, C.G, (int)blockIdx.x);
        pg8::EpiSwiglu E{(pg8::bf16_t*)(ws + WS_ACT), DFF};
        pg8::gemm_phase<pg8::EpiSwiglu, pg8::StaticOrder, true, true>(C.lds, g, S, E);
    }
    SEAM(6);
    if (IN(7)) {
        thin_gemm<1>(C, (const bf16*)(ws + WS_ACT), (const bf16*)(ws + WS_WD), DFF, DM / 16, MS, ThinRes{(float*)(ws + WS_HBUF), DM});
        pg8::Gemm g{(const pg8::bf16_t*)(ws + WS_ACT), (const pg8::bf16_t*)(ws + WS_WD), DFF, 0}; pg8::StaticOrder S; S.init(MS, DM, C.G, (int)blockIdx.x);
        pg8::EpiResF32<0> E{(const float*)(ws + WS_HBUF), (float*)(ws + WS_HBUF), DM};
        pg8::gemm_phase<pg8::EpiResF32<0>, pg8::StaticOrder, true, true>(C.lds, g, S, E);
    }
    SEAM(7);
    if (IN(8)) {
        const float* hb = (const float*)(ws + WS_HBUF); bf16* U = (bf16*)(ws + WS_U); bf16* UQ = (bf16*)(ws + WS_UQ);
        for (int row = C.gw; row < ML; row += C.NGW) { const int b = row / LSEQ, t = row - b * LSEQ;
            rms_row2(hb + (size_t)row * DM, args.in[12], U + (size_t)row * DM, args.in[14], t >= NMETA ? UQ + ((size_t)b * SEQ + (t - NMETA)) * DM : nullptr, C.lane); }
    }
    SEAM(8);
    if (IN(9)) {
        thin_gemm<1>(C, (const bf16*)(ws + WS_U), (const bf16*)(ws + WS_WKV), DM, 4096 / 16, MS, ThinBf16{(bf16*)(ws + WS_KVB), 4096});
        { pg8::Gemm g{(const pg8::bf16_t*)(ws + WS_U), (const pg8::bf16_t*)(ws + WS_WKV), DM, 0}; pg8::StaticOrder S; S.init(MS, 4096, C.G, (int)blockIdx.x);
          pg8::EpiBf16 E{(pg8::bf16_t*)(ws + WS_KVB), 4096};
          pg8::gemm_phase<pg8::EpiBf16, pg8::StaticOrder, true, true>(C.lds, g, S, E); }
        { pg8::Gemm g{(const pg8::bf16_t*)(ws + WS_UQ), (const pg8::bf16_t*)(ws + WS_WQ), DM, 0}; pg8::StaticOrder S; S.init(MS, DM, C.G, (int)blockIdx.x);
          pg8::EpiBf16 E{(pg8::bf16_t*)(ws + WS_QB), DM};
          pg8::gemm_phase<pg8::EpiBf16, pg8::StaticOrder, true, true>(C.lds, g, S, E); }
    }
    SEAM(9);
    if (IN(10)) { phase10(args, C, (char*)lds_raw); }
    SEAM(10);
    if (IN(11)) { phase11(args, C); }
    SEAM(11);
    if (IN(12)) {
        pg8::Gemm g{(const pg8::bf16_t*)(ws + WS_ON), (const pg8::bf16_t*)(ws + WS_WO2), DM, 0}; pg8::StaticOrder S; S.init(MS, DM, C.G, (int)blockIdx.x);
        pg8::EpiResF32<1> E{(const float*)(ws + WS_HBUF), (float*)(ws + WS_H3), DM};
        pg8::gemm_phase<pg8::EpiResF32<1>, pg8::StaticOrder, true, true>(C.lds, g, S, E);
    }
    SEAM(12);
    if (IN(13)) { phase13(args, C); }
    SEAM(13);
    if (IN(14)) { phase14(args, C); }
    SEAM(14);
    if (IN(15)) {
        pg8::Gemm g{(const pg8::bf16_t*)(ws + WS_XPERM), (const pg8::bf16_t*)(ws + WS_MGU), DM, SZ_GU}; pg8::GroupedOrder S; make_grouped(ws, S, NGU / 256, C.G, (int)blockIdx.x);
        pg8::EpiSwiglu E{(pg8::bf16_t*)(ws + WS_ACTP), DFF};
        pg8::gemm_phase<pg8::EpiSwiglu, pg8::GroupedOrder, true, true>(C.lds, g, S, E);
    }
    SEAM(15);
    if (IN(16)) {
        pg8::Gemm g{(const pg8::bf16_t*)(ws + WS_ACTP), (const pg8::bf16_t*)(ws + WS_MD), DFF, SZ_D}; pg8::GroupedOrder S; make_grouped(ws, S, DM / 256, C.G, (int)blockIdx.x);
        pg8::EpiBf16 E{(pg8::bf16_t*)(ws + WS_YP), DM};
        pg8::gemm_phase<pg8::EpiBf16, pg8::GroupedOrder, true, true>(C.lds, g, S, E);
    }
    SEAM(16);
    if (IN(17)) { phase17(args, C); }
#undef IN
#undef SEAM
}

#ifndef MK_PER_PHASE
#define MK_PER_PHASE 0
#endif
extern "C" void kernel_launch(void* const* d_in, const int* in_sizes, int n_in, void* d_out, int out_size, void* d_ws, size_t ws_size, hipStream_t stream) {
    static int grid = 0;
    if (grid == 0) {
        if (n_in != 31 || ws_size < WS_END || out_size != MS * DM) { fprintf(stderr, "kernel_launch: unexpected n_in %d / out %d / ws %zu (need %zu)\n", n_in, out_size, ws_size, (size_t)WS_END); grid = -1; return; }
        int dev = 0, cus = 0, per_cu = 0;
        if (hipGetDevice(&dev) != hipSuccess || hipDeviceGetAttribute(&cus, hipDeviceAttributeMultiprocessorCount, dev) != hipSuccess) { grid = -1; return; }
        if (hipFuncSetAttribute((const void*)mk_fwd, hipFuncAttributeMaxDynamicSharedMemorySize, LDS_BYTES) != hipSuccess) { fprintf(stderr, "kernel_launch: hipFuncSetAttribute failed\n"); grid = -1; return; }
        if (hipOccupancyMaxActiveBlocksPerMultiprocessor(&per_cu, (const void*)mk_fwd, NWAVES * 64, LDS_BYTES) != hipSuccess || per_cu < 1) fprintf(stderr, "kernel_launch: occupancy query says %d\n", per_cu);
        (void)hipGetLastError();
        grid = cus;
    }
    if (grid < 0) return;
    (void)hipMemsetAsync((char*)d_ws + WS_CTL, 0, CTL_ZERO_BYTES, stream);
    Args a{};
    for (int i = 0; i < 31; ++i) a.in[i] = (const float*)d_in[i];
    a.out = (float*)d_out; a.ws = (unsigned char*)d_ws;
    if (MK_PER_PHASE) { for (int p = 0; p < NPHASE; ++p) { a.ph_lo = p; a.ph_hi = p + 1; hipLaunchKernelGGL(mk_fwd, dim3(grid), dim3(NWAVES * 64), LDS_BYTES, stream, a); } }
    else { a.ph_lo = 0; a.ph_hi = NPHASE; hipLaunchKernelGGL(mk_fwd, dim3(grid), dim3(NWAVES * 64), LDS_BYTES, stream, a); }
}
```

```cpp
#include <hip/hip_runtime.h>
#include <cstdio>
#include <cstdint>
__device__ __forceinline__ int mk_lane() { int l; asm volatile("v_mbcnt_lo_u32_b32 %0, -1, 0\n\tv_mbcnt_hi_u32_b32 %0, -1, %0" : "=v"(l)); return l & 63; }

namespace pg8 {
#define PG8_LAS __attribute__((address_space(3)))
typedef unsigned short bf16_t;
typedef short bf16x8 __attribute__((ext_vector_type(8)));
typedef float f32x4 __attribute__((ext_vector_type(4)));
typedef unsigned u32x4 __attribute__((ext_vector_type(4)));
constexpr int BM = 256, BK = 64, HALF = 128, HTB = HALF * BK * 2  , STAGE_BYTES = 8 * HTB, NXCD = 8, WGM = 8;

__host__ __device__ __forceinline__ int lds_byte(int r, int c) { const int st = (r >> 4) * 2 + (c >> 5), rr = r & 15, cc = c & 31, ob = rr * 64 + cc * 2; return st * 1024 + (ob ^ (((ob >> 9) & 1) << 5)); }
__host__ __device__ __forceinline__ void stage_rc(int b, int& R, int& C) { const int st = b / 1024, sb = b % 1024, swz = sb ^ (((sb >> 9) & 1) << 5); R = (st >> 1) * 16 + swz / 64; C = (st & 1) * 32 + (swz % 64) / 2; }
__host__ __device__ __forceinline__ int perm32(int rho) { const int n = rho >> 4, i = rho & 15; return 8 * (i >> 2) + 4 * n + (i & 3); }

struct Unit { int pm, pn, e; };
struct Gemm { const void* A; const void* Bt; int KB; size_t estride; };
typedef int i32x4 __attribute__((ext_vector_type(4)));
typedef int i32x8 __attribute__((ext_vector_type(8)));

struct StaticOrder {
    int nM, nN, nwg, G, c;
    __host__ __device__ void init(int M, int N, int G_, int c_) { nM = M / BM; nN = N / BM; nwg = nM * nN; G = G_; c = c_; }
    __host__ __device__ bool next(int i, Unit& u) const {
        const long L = (long)i * G + c; if (L >= nwg) return false;
        int wgid = (int)L; { const int q = nwg / NXCD, r = nwg % NXCD, xcd = wgid % NXCD, off = wgid / NXCD; wgid = (xcd < r ? xcd * (q + 1) : r * (q + 1) + (xcd - r) * q) + off; }
        const int nig = WGM * nN, gid = wgid / nig, fm = gid * WGM, gsz = (nM - fm) < WGM ? (nM - fm) : WGM;
        u.pm = fm + ((wgid % nig) % gsz); u.pn = (wgid % nig) / gsz; u.e = 0; return true;
    }
    __device__ __forceinline__ void a_ready(const Unit&) const {}
    __device__ __forceinline__ void done(const Unit&) const {}
};
struct GroupedOrder {
    int nM, nN, nwg, G, c; const int* pe;
    __device__ __forceinline__ bool next(int i, Unit& u) const {
        const long L = (long)i * G + c; if (L >= nwg) return false;
        int wgid = (int)L; { const int q = nwg / NXCD, r = nwg % NXCD, xcd = wgid % NXCD, off = wgid / NXCD; wgid = (xcd < r ? xcd * (q + 1) : r * (q + 1) + (xcd - r) * q) + off; }
        const int nig = WGM * nN, gid = wgid / nig, fm = gid * WGM, gsz = (nM - fm) < WGM ? (nM - fm) : WGM;
        u.pm = fm + ((wgid % nig) % gsz); u.pn = (wgid % nig) / gsz; u.e = __builtin_amdgcn_readfirstlane(pe[u.pm]); return true;
    }
    __device__ __forceinline__ void a_ready(const Unit&) const {}
    __device__ __forceinline__ void done(const Unit&) const {}
};

__device__ __forceinline__ unsigned cvt_pk_bf16(float lo, float hi) { unsigned r; asm volatile("v_cvt_pk_bf16_f32 %0, %1, %2" : "=v"(r) : "v"(lo), "v"(hi)); return r; }
typedef float f32x2 __attribute__((ext_vector_type(2)));

struct EpiBf16 {
    static constexpr bool PERM = true, AFTER_DRAIN = false;
    bf16_t* O; int ldc;
    __device__ __forceinline__ void operator()(const f32x4 (&acc)[2][2][4][2], const Unit& u, int wr, int wc, int fr, int fq) const {
        const int row0 = u.pm * BM + wr * 64 + fr; const int col0 = u.pn * BM + wc * 32 + 8 * fq;
#pragma unroll
        for (int ai = 0; ai < 2; ++ai)
#pragma unroll
            for (int m = 0; m < 4; ++m) { bf16_t* rowp = O + (size_t)(row0 + ai * HALF + m * 16) * ldc + col0;
#pragma unroll
                for (int bj = 0; bj < 2; ++bj) { const f32x4 v0 = acc[ai][bj][m][0], v1 = acc[ai][bj][m][1];
                    u32x4 w; w.x = cvt_pk_bf16(v0[0], v0[1]); w.y = cvt_pk_bf16(v0[2], v0[3]); w.z = cvt_pk_bf16(v1[0], v1[1]); w.w = cvt_pk_bf16(v1[2], v1[3]);
                    *(u32x4*)(rowp + bj * HALF) = w; } }
    }
};
struct EpiSwiglu {
    static constexpr bool PERM = true, AFTER_DRAIN = false;
    bf16_t* O; int ldc;
    __device__ __forceinline__ void operator()(const f32x4 (&acc)[2][2][4][2], const Unit& u, int wr, int wc, int fr, int fq) const {
        const int row0 = u.pm * BM + wr * 64 + fr; const int col0 = u.pn * HALF + wc * 32 + 8 * fq;
#pragma unroll
        for (int ai = 0; ai < 2; ++ai)
#pragma unroll
            for (int m = 0; m < 4; ++m) { bf16_t* rowp = O + (size_t)(row0 + ai * HALF + m * 16) * ldc + col0;
                float r[8];
#pragma unroll
                for (int n = 0; n < 2; ++n)
#pragma unroll
                    for (int j = 0; j < 4; ++j) { const float g = acc[ai][0][m][n][j], up = acc[ai][1][m][n][j];
                        r[n * 4 + j] = g * __builtin_amdgcn_rcpf(1.0f + __builtin_amdgcn_exp2f(-1.4426950408889634f * g)) * up; }
                u32x4 w; w.x = cvt_pk_bf16(r[0], r[1]); w.y = cvt_pk_bf16(r[2], r[3]); w.z = cvt_pk_bf16(r[4], r[5]); w.w = cvt_pk_bf16(r[6], r[7]);
                *(u32x4*)rowp = w; }
    }
};
struct EpiSwiglu8 {
    static constexpr bool PERM = true, AFTER_DRAIN = false;
    unsigned char* O; int ldc;
    __device__ __forceinline__ void operator()(const f32x4 (&acc)[2][2][4][2], const Unit& u, int wr, int wc, int fr, int fq) const {
        const int row0 = u.pm * BM + wr * 64 + fr; const int col0 = u.pn * HALF + wc * 32 + 8 * fq;
        typedef unsigned u32x2 __attribute__((ext_vector_type(2)));
#pragma unroll
        for (int ai = 0; ai < 2; ++ai)
#pragma unroll
            for (int m = 0; m < 4; ++m) { unsigned char* rowp = O + (size_t)(row0 + ai * HALF + m * 16) * ldc + col0;
                float r[8];
#pragma unroll
                for (int n = 0; n < 2; ++n)
#pragma unroll
                    for (int j = 0; j < 4; ++j) { const float g = acc[ai][0][m][n][j], up = acc[ai][1][m][n][j];
                        r[n * 4 + j] = __builtin_amdgcn_fmed3f(16.0f * g * __builtin_amdgcn_rcpf(1.0f + __builtin_amdgcn_exp2f(-1.4426950408889634f * g)) * up, -448.f, 448.f); }
                u32x2 w; int t = __builtin_amdgcn_cvt_pk_fp8_f32(r[0], r[1], 0, false); t = __builtin_amdgcn_cvt_pk_fp8_f32(r[2], r[3], t, true); w.x = (unsigned)t;
                t = __builtin_amdgcn_cvt_pk_fp8_f32(r[4], r[5], 0, false); t = __builtin_amdgcn_cvt_pk_fp8_f32(r[6], r[7], t, true); w.y = (unsigned)t;
                *(u32x2*)rowp = w; }
    }
};
template <int MAP> struct EpiResF32 {
    static constexpr bool PERM = false, AFTER_DRAIN = false;
    const float* base; float* out; int ldc;
    __device__ __forceinline__ void operator()(const f32x4 (&acc)[2][2][4][2], const Unit& u, int wr, int wc, int fr, int fq) const {
        const int row0 = u.pm * BM + wr * 64 + fr, col0 = u.pn * BM + wc * 32 + 4 * fq;
#pragma unroll
        for (int ai = 0; ai < 2; ++ai)
#pragma unroll
            for (int m = 0; m < 4; ++m) { const int r = row0 + ai * HALF + m * 16; const int br = MAP == 1 ? r + 16 * ((r >> 11) + 1) : r;
                const float* bp = base + (size_t)br * ldc + col0; float* op = out + (size_t)r * ldc + col0;
#pragma unroll
                for (int bj = 0; bj < 2; ++bj)
#pragma unroll
                    for (int n = 0; n < 2; ++n) { const f32x4 b = *(const f32x4*)(bp + bj * HALF + n * 16); *(f32x4*)(op + bj * HALF + n * 16) = b + acc[ai][bj][m][n]; } }
    }
};

template <class Epi, class Sched, bool ALIGN_EPI = false, bool SP2 = false, bool FP8 = false, int SCA = 127, int SCB = 127>
__device__ __forceinline__ void gemm_phase(PG8_LAS unsigned char* lds, const Gemm g, const Sched& S, const Epi& E, const int wid) {
    __builtin_assume(wid >= 0 && wid < 8); const int lane = mk_lane(), tid = wid * 64 + lane, wr = wid >> 2, wc = wid & 3, fr = lane & 15, fq = lane >> 4;
    const int KB = g.KB, nt = KB / (BK * 2);
    unsigned voffA[2], voffB[2];
#pragma unroll
    for (int i = 0; i < 2; ++i) { int R, C; stage_rc(tid * 16 + i * 8192, R, C); const int Rb = Epi::PERM ? ((R & ~31) + perm32(R & 31)) : R;
        voffA[i] = (unsigned)(R * KB + C * 2); voffB[i] = (unsigned)(Rb * KB + C * 2); }
    const unsigned rstep64 = 64u * (unsigned)KB;
    const unsigned kstep = BK * 2;
    const unsigned hstep = (unsigned)HALF * (unsigned)KB;
    const unsigned tstep = 2 * hstep;
    const unsigned ldsw = (unsigned)wid * 1024u;
    const int aoff = lds_byte(wr * 64 + fr, fq * 8), boff = lds_byte(wc * 32 + fr, fq * 8);
#define PG8_SA(b, h) (((b) * 2 + (h)) * HTB)
#define PG8_SB(b, h) ((4 + (b) * 2 + (h)) * HTB)
    const __amdgpu_buffer_rsrc_t rs_voffA = __builtin_amdgcn_make_buffer_rsrc((void*)g.A, (short)0, 0x7fffffff, 0x00020000), rs_voffB = __builtin_amdgcn_make_buffer_rsrc((void*)g.Bt, (short)0, 0x7fffffff, 0x00020000);
#define PG8_STAGE(bufoff, soff, voff) do { _Pragma("unroll") for (int _i = 0; _i < 2; ++_i) \
        __builtin_amdgcn_raw_ptr_buffer_load_lds(rs_##voff, (PG8_LAS unsigned*)(lds + (bufoff) + ldsw + _i * 8192), 16, (voff)[0], (int)((soff) + (unsigned)_i * rstep64), 0, 0); } while (0)
#define PG8_LDA(dst, b, h) do { _Pragma("unroll") for (int m = 0; m < 4; ++m) _Pragma("unroll") for (int k = 0; k < 2; ++k) dst[m][k] = *(const PG8_LAS bf16x8*)(lds + PG8_SA(b, h) + aoff + m * 2048 + k * 1024); } while (0)
#define PG8_LDB(dst, b, h) do { _Pragma("unroll") for (int n = 0; n < 2; ++n) _Pragma("unroll") for (int k = 0; k < 2; ++k) dst[n][k] = *(const PG8_LAS bf16x8*)(lds + PG8_SB(b, h) + boff + n * 2048 + k * 1024); } while (0)
#define PG8_CAT(x, y) __builtin_shufflevector(__builtin_bit_cast(i32x4, x), __builtin_bit_cast(i32x4, y), 0, 1, 2, 3, 4, 5, 6, 7)
#define PG8_MMA(ai, bj, At, Bt) do { __builtin_amdgcn_s_setprio(1); if constexpr (FP8) { _Pragma("unroll") for (int m = 0; m < 4; ++m) _Pragma("unroll") for (int n = 0; n < 2; ++n) \
        acc[ai][bj][m][n] = __builtin_amdgcn_mfma_scale_f32_16x16x128_f8f6f4(PG8_CAT(Bt[n][0], Bt[n][1]), PG8_CAT(At[m][0], At[m][1]), acc[ai][bj][m][n], 0, 0, 0, SCB, 0, SCA); } \
        else { _Pragma("unroll") for (int m = 0; m < 4; ++m) _Pragma("unroll") for (int n = 0; n < 2; ++n) _Pragma("unroll") for (int k = 0; k < 2; ++k) \
        acc[ai][bj][m][n] = __builtin_amdgcn_mfma_f32_16x16x32_bf16(Bt[n][k], At[m][k], acc[ai][bj][m][n], 0, 0, 0); } __builtin_amdgcn_s_setprio(0); } while (0)
#define PG8_WAIT_V(n) asm volatile("s_waitcnt vmcnt(" #n ")" ::: "memory")
#define PG8_WAIT_L(n) asm volatile("s_waitcnt lgkmcnt(" #n ")" ::: "memory")
#define PG8_BAR __builtin_amdgcn_s_barrier()
#define PG8_SCHED __builtin_amdgcn_sched_barrier(0)
    Unit cur, nxt; int ui = 0;
    if (!S.next(0, cur)) return;
    f32x4 acc[2][2][4][2];
#pragma unroll
    for (int a = 0; a < 2; ++a)
#pragma unroll
        for (int b = 0; b < 2; ++b)
#pragma unroll
            for (int m = 0; m < 4; ++m)
#pragma unroll
                for (int n = 0; n < 2; ++n) acc[a][b][m][n] = (f32x4){0.f, 0.f, 0.f, 0.f};
    bf16x8 At[4][2], B0[2][2], B1[2][2];
    unsigned cA = (unsigned)cur.pm * tstep, cB = (unsigned)cur.e * (unsigned)g.estride + (unsigned)cur.pn * tstep;
    S.a_ready(cur);
    if constexpr (SP2) {
        PG8_STAGE(PG8_SB(0, 0), cB, voffB); PG8_STAGE(PG8_SB(0, 1), cB + hstep, voffB); PG8_STAGE(PG8_SA(0, 0), cA, voffA); PG8_STAGE(PG8_SA(0, 1), cA + hstep, voffA);
        if (wr == 1) PG8_BAR;
        PG8_WAIT_V(2); PG8_BAR;
        PG8_STAGE(PG8_SB(1, 0), cB + kstep, voffB); PG8_STAGE(PG8_SA(1, 0), cA + kstep, voffA); PG8_STAGE(PG8_SB(1, 1), cB + hstep + kstep, voffB);
        PG8_WAIT_V(6); PG8_BAR;
    } else {
        PG8_STAGE(PG8_SB(0, 0), cB, voffB); PG8_STAGE(PG8_SA(0, 0), cA, voffA); PG8_STAGE(PG8_SB(0, 1), cB + hstep, voffB); PG8_STAGE(PG8_SA(0, 1), cA + hstep, voffA);
        if (wr == 1) PG8_BAR;
        PG8_WAIT_V(4); PG8_BAR;
        PG8_STAGE(PG8_SB(1, 0), cB + kstep, voffB); PG8_STAGE(PG8_SA(1, 0), cA + kstep, voffA); PG8_STAGE(PG8_SB(1, 1), cB + hstep + kstep, voffB);
        PG8_WAIT_V(6); PG8_BAR;
    }
    for (;;) {
        const bool has_next = S.next(ui + 1, nxt);
        const unsigned nA = has_next ? (unsigned)nxt.pm * tstep : cA, nB = has_next ? (unsigned)nxt.e * (unsigned)g.estride + (unsigned)nxt.pn * tstep : cB;
        for (int t = 0; t < nt; t += 2) {
            const bool last = (t == nt - 2);
            const unsigned a1 = cA + (unsigned)(t + 1) * kstep;
            const unsigned a2 = last ? nA : cA + (unsigned)(t + 2) * kstep, b2 = last ? nB : cB + (unsigned)(t + 2) * kstep;
            const unsigned a3 = a2 + kstep, b3 = b2 + kstep;
            if (last && has_next) S.a_ready(nxt);
            if constexpr (SP2) {
            PG8_LDB(B0, 0, 0); PG8_LDB(B1, 0, 1); PG8_SCHED; PG8_LDA(At, 0, 0); PG8_STAGE(PG8_SA(1, 1), a1 + hstep, voffA);
            PG8_WAIT_V(8); PG8_WAIT_L(0); PG8_BAR; PG8_MMA(0, 0, At, B0); PG8_MMA(0, 1, At, B1); PG8_BAR; PG8_SCHED;
            PG8_LDA(At, 0, 1); PG8_STAGE(PG8_SB(0, 0), b2, voffB); PG8_STAGE(PG8_SB(0, 1), b2 + hstep, voffB); PG8_STAGE(PG8_SA(0, 0), a2, voffA);
            PG8_WAIT_V(8); PG8_WAIT_L(0); PG8_BAR; PG8_MMA(1, 0, At, B0); PG8_MMA(1, 1, At, B1); PG8_BAR; PG8_SCHED;
            PG8_LDB(B0, 1, 0); PG8_LDB(B1, 1, 1); PG8_SCHED; PG8_LDA(At, 1, 0); PG8_STAGE(PG8_SA(0, 1), a2 + hstep, voffA);
            PG8_WAIT_V(8); PG8_WAIT_L(0); PG8_BAR; PG8_MMA(0, 0, At, B0); PG8_MMA(0, 1, At, B1); PG8_BAR; PG8_SCHED;
            PG8_LDA(At, 1, 1); PG8_STAGE(PG8_SB(1, 0), b3, voffB); PG8_STAGE(PG8_SB(1, 1), b3 + hstep, voffB); PG8_STAGE(PG8_SA(1, 0), a3, voffA);
            PG8_WAIT_V(8); PG8_WAIT_L(0); PG8_BAR; PG8_MMA(1, 0, At, B0); PG8_MMA(1, 1, At, B1); PG8_BAR; PG8_SCHED;
            } else {
            PG8_LDB(B0, 0, 0); PG8_SCHED; PG8_LDA(At, 0, 0); PG8_STAGE(PG8_SA(1, 1), a1 + hstep, voffA);
            PG8_WAIT_L(8); PG8_BAR; PG8_WAIT_L(0); PG8_MMA(0, 0, At, B0); PG8_BAR; PG8_SCHED;
            PG8_LDB(B1, 0, 1); PG8_STAGE(PG8_SB(0, 0), b2, voffB);
            PG8_BAR; PG8_WAIT_L(0); PG8_MMA(0, 1, At, B1); PG8_BAR;
            PG8_LDA(At, 0, 1); PG8_STAGE(PG8_SA(0, 0), a2, voffA);
            PG8_BAR; PG8_WAIT_L(0); PG8_MMA(1, 0, At, B0); PG8_BAR; PG8_SCHED;
            PG8_STAGE(PG8_SB(0, 1), b2 + hstep, voffB);
            PG8_WAIT_V(6); PG8_BAR; PG8_MMA(1, 1, At, B1); PG8_BAR;
            PG8_LDB(B0, 1, 0); PG8_SCHED; PG8_LDA(At, 1, 0); PG8_STAGE(PG8_SA(0, 1), a2 + hstep, voffA);
            PG8_WAIT_L(8); PG8_BAR; PG8_WAIT_L(0); PG8_MMA(0, 0, At, B0); PG8_BAR; PG8_SCHED;
            PG8_LDB(B1, 1, 1); PG8_STAGE(PG8_SB(1, 0), b3, voffB);
            PG8_BAR; PG8_WAIT_L(0); PG8_MMA(0, 1, At, B1); PG8_BAR;
            PG8_LDA(At, 1, 1); PG8_STAGE(PG8_SA(1, 0), a3, voffA);
            PG8_BAR; PG8_WAIT_L(0); PG8_MMA(1, 0, At, B0); PG8_BAR; PG8_SCHED;
            PG8_STAGE(PG8_SB(1, 1), b3 + hstep, voffB);
            PG8_WAIT_V(6); PG8_BAR; PG8_MMA(1, 1, At, B1); PG8_BAR;
            }
        }
        if constexpr (ALIGN_EPI) { if (wr == 0) PG8_BAR; }
        if constexpr (!Epi::AFTER_DRAIN) { E(acc, cur, wr, wc, fr, fq); S.done(cur); }
        if (!has_next) break;
#pragma unroll
        for (int a = 0; a < 2; ++a)
#pragma unroll
            for (int b = 0; b < 2; ++b)
#pragma unroll
                for (int m = 0; m < 4; ++m)
#pragma unroll
                    for (int n = 0; n < 2; ++n) acc[a][b][m][n] = (f32x4){0.f, 0.f, 0.f, 0.f};
        cur = nxt; cA = nA; cB = nB; ++ui;
        if constexpr (ALIGN_EPI) { if (wr == 1) PG8_BAR; }
    }
    PG8_WAIT_V(0);
    if constexpr (!ALIGN_EPI) { if (wr == 0) PG8_BAR; }
    PG8_BAR;
    if constexpr (Epi::AFTER_DRAIN) { E.fused(acc, cur, wr, wc, fr, fq, lds, wid, lane); S.done(cur); }
#undef PG8_SA
#undef PG8_SB
#undef PG8_STAGE
#undef PG8_LDA
#undef PG8_LDB
#undef PG8_MMA
#undef PG8_CAT
#undef PG8_WAIT_V
#undef PG8_WAIT_L
#undef PG8_BAR
#undef PG8_SCHED
}
}
#define GAS __attribute__((address_space(1)))
#define LAS __attribute__((address_space(3)))
typedef unsigned short bf16;
typedef unsigned v4u __attribute__((ext_vector_type(4)));
typedef float f32x4 __attribute__((ext_vector_type(4)));
typedef short bf16x8 __attribute__((ext_vector_type(8)));
typedef GAS unsigned gu32;
typedef GAS unsigned long long gu64;
#define RLX_AGENT __ATOMIC_RELAXED, __HIP_MEMORY_SCOPE_AGENT
#define LDS_WAIT() asm volatile("s_waitcnt lgkmcnt(0)" ::: "memory")
#define VM_WAIT() asm volatile("s_waitcnt vmcnt(0)" ::: "memory")
__device__ __forceinline__ unsigned long long rt() { return __builtin_amdgcn_s_memrealtime(); }
__device__ __forceinline__ unsigned f2bf(float f) { unsigned u = __builtin_bit_cast(unsigned, f); return (u + 0x7fffu + ((u >> 16) & 1u)) >> 16; }
__device__ __forceinline__ unsigned pk2(float lo, float hi) { return f2bf(lo) | (f2bf(hi) << 16); }

#define XB_TMO      128
#define XB_XCNT(j)  (256  + 64 * (j))
#define XB_XSUB(j)  (1280 + 64 * (j))
#define XB_XGEN(j)  (2304 + 64 * (j))
#define XB_TOP      3328
#define XB_TOPGEN   3392
#define XCD_BAR_WORDS 3456
#define XB_SPIN_CAP (1u << 22)

__device__ __forceinline__ unsigned xb_ld(unsigned* p)              { return __hip_atomic_load(p, __ATOMIC_RELAXED, __HIP_MEMORY_SCOPE_AGENT); }
__device__ __forceinline__ unsigned xb_add(unsigned* p, unsigned v) { return __hip_atomic_fetch_add(p, v, __ATOMIC_RELAXED, __HIP_MEMORY_SCOPE_AGENT); }
__device__ __forceinline__ unsigned xb_xcc_id() { return (unsigned)__builtin_amdgcn_s_getreg((3 << 11) | 20) & 0xFu; }
#define XB_SPIN(cond, bar) do { unsigned _sp = 0; while (cond) { __builtin_amdgcn_s_sleep(1); \
    if ((++_sp & 255u) == 0u) { if (xb_ld(&(bar)[XB_TMO])) break; if (_sp > XB_SPIN_CAP) { atomicAdd(&(bar)[XB_TMO], 1u); break; } } } } while (0)

struct XcdBarrier {
    unsigned* bar; unsigned x;
    volatile LAS unsigned* st;
};

__device__ __forceinline__ XcdBarrier xcd_barrier_post(unsigned* bar, volatile LAS unsigned* st, const bool thread0) {
    XcdBarrier b; b.bar = bar; b.x = xb_xcc_id(); b.st = st;
    if (thread0) (void)xb_add(&bar[XB_XCNT(b.x)], 1u);
    return b;
}
__device__ __forceinline__ void xcd_barrier_complete(unsigned* bar, unsigned x, unsigned& nloc, unsigned& nx) {
    const unsigned G = gridDim.x * gridDim.y * gridDim.z;
    unsigned sum, cnt, mine, sp = 0u;
    for (;;) {
        sum = 0u; cnt = 0u; mine = 0u;
#pragma unroll
        for (unsigned j = 0; j < 16; ++j) { const unsigned c = xb_ld(&bar[XB_XCNT(j)]); sum += c; cnt += (c > 0u) ? 1u : 0u; mine = (j == x) ? c : mine; }
        if (sum == G) break;
        __builtin_amdgcn_s_sleep(1);
        if ((++sp & 255u) == 0u) { if (xb_ld(&bar[XB_TMO])) break; if (sp > XB_SPIN_CAP) { atomicAdd(&bar[XB_TMO], 1u); break; } }
    }
    nloc = mine > 0u ? mine : 1u; nx = cnt > 0u ? cnt : 1u;
}

__device__ __forceinline__ void xcd_barrier(const XcdBarrier& b, const bool thread0) {
    asm volatile("s_waitcnt vmcnt(0)" ::: "memory");
    __syncthreads();
    if (thread0) {
        unsigned* bar = b.bar;
        __builtin_amdgcn_s_waitcnt(0);
        unsigned nloc = b.st[0], nx = b.st[1];
        if (nloc == 0u) { xcd_barrier_complete(bar, b.x, nloc, nx); b.st[0] = nloc; b.st[1] = nx; }
        const unsigned old = xb_add(&bar[XB_XSUB(b.x)], 1u);
        const unsigned gen = old / nloc;
        if (old + 1u == (gen + 1u) * nloc) {
            __builtin_amdgcn_fence(__ATOMIC_RELEASE, "agent");
            asm volatile("s_waitcnt vmcnt(0)" ::: "memory");
            const unsigned og = xb_add(&bar[XB_TOP], 1u);
            const unsigned tg = og / nx;
            if (og + 1u == (tg + 1u) * nx) xb_add(&bar[XB_TOPGEN], 1u);
            else XB_SPIN(xb_ld(&bar[XB_TOPGEN]) == tg, bar);
            __builtin_amdgcn_fence(__ATOMIC_ACQUIRE, "agent");
            xb_add(&bar[XB_XGEN(b.x)], 1u);
            asm volatile("s_waitcnt vmcnt(0)" ::: "memory");
        } else {
            XB_SPIN(xb_ld(&bar[XB_XGEN(b.x)]) == gen, bar);
            __builtin_amdgcn_fence(__ATOMIC_ACQUIRE, "agent");
            asm volatile("s_waitcnt vmcnt(0)" ::: "memory");
        }
    }
    __syncthreads();
}


constexpr int NB = 4, SEQ = 2048, DM = 2048, NMETA = 16, LSEQ = SEQ + NMETA, DFF = 5504, NH = 8, HDIM = 128, VDIM = 256, NEXP = 8;
constexpr int ML = NB * LSEQ;
constexpr int MLP = 8448;
constexpr int MS = NB * SEQ;
constexpr int NGU = 2 * DFF;
constexpr int MPERM = 18432;
constexpr float RMS_EPS = 1e-6f;
constexpr int NWAVES = 8;

constexpr size_t MiB = 1u << 20;
constexpr size_t WS_CTL = 0, CTL_ZERO_BYTES = 1 * MiB;
constexpr size_t WS_WKV = 1 * MiB;
constexpr size_t WS_WQ = WS_WKV + 16 * MiB;
constexpr size_t WS_WO2 = WS_WQ + 8 * MiB;
constexpr int DFFP = 5632;
constexpr size_t WS_MGU = WS_WO2 + 8 * MiB;
constexpr size_t SZ_GU = (size_t)NGU * DM * 2;
constexpr size_t SZ_GU8 = (size_t)NGU * DM;
constexpr size_t WS_MD = WS_MGU + 8 * SZ_GU8;
constexpr size_t SZ_D = (size_t)DM * DFF * 2;
constexpr size_t SZ_D8 = (size_t)DM * DFFP;
constexpr size_t WS_HBUF = WS_MD + 8 * SZ_D8;
constexpr size_t WS_KVB = WS_HBUF + (size_t)MLP * DM * 4;
constexpr size_t WS_UQ = WS_KVB + (size_t)MLP * 4096 * 2;
constexpr size_t WS_QB = WS_UQ + (size_t)MS * DM * 2;
constexpr size_t WS_OB = WS_QB + (size_t)MS * DM * 2;
constexpr size_t WS_ON = WS_UQ;
constexpr size_t WS_H3 = WS_OB + (size_t)2 * MS * DM * 4;
constexpr size_t WS_UM = WS_QB;
constexpr size_t WS_MISC = WS_H3 + (size_t)MS * DM * 4;
constexpr size_t WS_R0 = WS_MISC + 4 * MiB;
constexpr size_t WS_WIN = WS_R0;
constexpr size_t WS_WG = WS_WIN + 16 * MiB;
constexpr size_t WS_WOUT = WS_WG + 1 * MiB;
constexpr size_t WS_WGU = WS_WOUT + 8 * MiB;
constexpr size_t WS_WD = WS_WGU + SZ_GU;
constexpr size_t WS_U = WS_WD + SZ_D;
constexpr size_t WS_XG = WS_U + (size_t)MLP * DM * 2;
constexpr size_t WS_HSL = WS_XG + (size_t)MLP * 4096 * 2;
constexpr size_t WS_PC = WS_HSL + (size_t)MLP * DM * 2;
constexpr size_t WS_CSUM = WS_PC + (size_t)MLP * DM * 2;
constexpr size_t WS_Y = WS_CSUM + 3 * MiB;
constexpr size_t WS_ACT = WS_Y + (size_t)MLP * DM * 2;
constexpr size_t WS_R0_L0END = WS_ACT + (size_t)MLP * DFF * 2;
constexpr size_t WS_XPERM = WS_R0;
constexpr size_t WS_ACTP = WS_XPERM + (size_t)MPERM * DM;
constexpr size_t WS_YP = WS_ACTP + (size_t)MPERM * DFFP;
constexpr size_t WS_R0_MOEEND = WS_YP + (size_t)MPERM * DM * 2;
constexpr size_t WS_END = WS_R0_L0END > WS_R0_MOEEND ? WS_R0_L0END : WS_R0_MOEEND;
static_assert(WS_END <= (size_t)1442840576, "d_ws map exceeds the guaranteed workspace");
constexpr int CW_BAR = 4096;
constexpr int CW_CNT = 16384;
constexpr int CW_CUR = 16384 + 1024;

constexpr int SCR_BYTES = 133120;
constexpr int LDSCTL_OFF = SCR_BYTES, MISC_OFF = LDSCTL_OFF + 320;
constexpr int LDS_BYTES = 147456;
static_assert(MISC_OFF + 128 <= LDS_BYTES, "LDS map");

constexpr int NPHASE = 18;
struct Args { const float* in[31]; float* out; unsigned char* ws; int ph_lo, ph_hi; };
static_assert(sizeof(Args) == 33 * 8 + 8, "Args has no padding");
typedef const __attribute__((address_space(4))) Args* KArgs;
__device__ __forceinline__ KArgs kargs() { KArgs p = (KArgs)__builtin_amdgcn_kernarg_segment_ptr(); asm volatile("" : "+s"(p)); return p; }
struct Ctx { LAS unsigned char* lds; int tid, lane, wave, G, gw, NGW; };

__device__ __forceinline__ float wave_sum(float v) {
#pragma unroll
    for (int o = 1; o < 64; o <<= 1) v += __shfl_xor(v, o);
    return v;
}
typedef unsigned long long u64;

template <int MODE>
__device__ __forceinline__ void transpose_item(const float* __restrict__ W, int K, int N, bf16* __restrict__ WT, LAS float* scr, int item, int lane) {
    const int nblk = N / 64, kb = item / nblk, nb = item % nblk, k0 = 64 * kb, n0 = 64 * nb;
    const float* src = W + (size_t)k0 * N + n0 + lane;
#pragma unroll 16
    for (int i = 0; i < 64; ++i) scr[i * 65 + lane] = src[(size_t)i * N];
    LDS_WAIT(); asm volatile("" ::: "memory");
    const int c = lane & 7, nl = lane >> 3;
    const int drow0 = MODE == 0 ? n0 : ((n0 >> 7) * 256 + (n0 & 127) + (MODE == 2 ? 128 : 0));
#pragma unroll
    for (int j = 0; j < 8; ++j) { const int n = nl + 8 * j; const LAS float* s = scr + (8 * c) * 65 + n;
        v4u o; o.x = pk2(s[0 * 65], s[1 * 65]); o.y = pk2(s[2 * 65], s[3 * 65]); o.z = pk2(s[4 * 65], s[5 * 65]); o.w = pk2(s[6 * 65], s[7 * 65]);
        *(GAS v4u*)(WT + (size_t)(drow0 + n) * K + k0 + 8 * c) = o; }
    LDS_WAIT(); asm volatile("" ::: "memory");
}
__device__ __forceinline__ void rms_row(const float* xrow, const float* __restrict__ g, bf16* orow, float* hcopy, int lane) {
    const GAS f32x4* xr = (const GAS f32x4*)xrow + lane; const GAS f32x4* gr = (const GAS f32x4*)g + lane;
    f32x4 v[8]; float s = 0.f;
#pragma unroll
    for (int j = 0; j < 8; ++j) { v[j] = xr[64 * j]; s += (v[j].x * v[j].x + v[j].y * v[j].y) + (v[j].z * v[j].z + v[j].w * v[j].w); }
    if (hcopy) { GAS f32x4* hc = (GAS f32x4*)hcopy + lane;
#pragma unroll
        for (int j = 0; j < 8; ++j) hc[64 * j] = v[j]; }
    const float rstd = 1.f / sqrtf(wave_sum(s) * (1.f / DM) + RMS_EPS);
    GAS u64* o8 = (GAS u64*)orow + lane;
#pragma unroll
    for (int j = 0; j < 8; ++j) { const f32x4 gg = gr[64 * j]; const f32x4 y = v[j] * rstd * gg;
        o8[64 * j] = (u64)pk2(y.x, y.y) | ((u64)pk2(y.z, y.w) << 32); }
}

__device__ __forceinline__ void rms_row2(const float* xrow, const float* __restrict__ g1, bf16* o1, const float* __restrict__ g2, bf16* o2, int lane) {
    const GAS f32x4* xr = (const GAS f32x4*)xrow + lane;
    f32x4 v[8]; float s = 0.f;
#pragma unroll
    for (int j = 0; j < 8; ++j) { v[j] = xr[64 * j]; s += (v[j].x * v[j].x + v[j].y * v[j].y) + (v[j].z * v[j].z + v[j].w * v[j].w); }
    const float rstd = 1.f / sqrtf(wave_sum(s) * (1.f / DM) + RMS_EPS);
    { const GAS f32x4* gr = (const GAS f32x4*)g1 + lane; GAS u64* o8 = (GAS u64*)o1 + lane;
#pragma unroll
      for (int j = 0; j < 8; ++j) { const f32x4 y = v[j] * rstd * gr[64 * j]; o8[64 * j] = (u64)pk2(y.x, y.y) | ((u64)pk2(y.z, y.w) << 32); } }
    if (o2) { const GAS f32x4* gr = (const GAS f32x4*)g2 + lane; GAS u64* o8 = (GAS u64*)o2 + lane;
#pragma unroll
      for (int j = 0; j < 8; ++j) { const f32x4 y = v[j] * rstd * gr[64 * j]; o8[64 * j] = (u64)pk2(y.x, y.y) | ((u64)pk2(y.z, y.w) << 32); } }
}

__device__ __forceinline__ unsigned pk4_fp8(float a, float b, float c, float d) {
    a = __builtin_amdgcn_fmed3f(a, -448.f, 448.f); b = __builtin_amdgcn_fmed3f(b, -448.f, 448.f); c = __builtin_amdgcn_fmed3f(c, -448.f, 448.f); d = __builtin_amdgcn_fmed3f(d, -448.f, 448.f);
    int r = __builtin_amdgcn_cvt_pk_fp8_f32(a, b, 0, false); r = __builtin_amdgcn_cvt_pk_fp8_f32(c, d, r, true); return (unsigned)r;
}
template <int MODE>
__device__ __forceinline__ void transpose_item_fp8(const float* __restrict__ W, int N, unsigned char* __restrict__ WT, int KP, float scale, LAS float* scr, int item, int lane) {
    const int nblk = N / 64, kb = item / nblk, nb = item % nblk, k0 = 64 * kb, n0 = 64 * nb;
    const float* src = W + (size_t)k0 * N + n0 + lane;
#pragma unroll 16
    for (int i = 0; i < 64; ++i) scr[i * 65 + lane] = src[(size_t)i * N];
    LDS_WAIT(); asm volatile("" ::: "memory");
    const int c = lane & 3, nl = lane >> 2;
    const int drow0 = MODE == 0 ? n0 : ((n0 >> 7) * 256 + (n0 & 127) + (MODE == 2 ? 128 : 0));
#pragma unroll
    for (int j = 0; j < 4; ++j) { const int n = nl + 16 * j; const LAS float* s = scr + (16 * c) * 65 + n;
        v4u o; o.x = pk4_fp8(s[0 * 65] * scale, s[1 * 65] * scale, s[2 * 65] * scale, s[3 * 65] * scale); o.y = pk4_fp8(s[4 * 65] * scale, s[5 * 65] * scale, s[6 * 65] * scale, s[7 * 65] * scale);
        o.z = pk4_fp8(s[8 * 65] * scale, s[9 * 65] * scale, s[10 * 65] * scale, s[11 * 65] * scale); o.w = pk4_fp8(s[12 * 65] * scale, s[13 * 65] * scale, s[14 * 65] * scale, s[15 * 65] * scale);
        *(GAS v4u*)(WT + (size_t)(drow0 + n) * KP + k0 + 16 * c) = o; }
    LDS_WAIT(); asm volatile("" ::: "memory");
}

struct ThinBf16 { bf16* O; int ldc; __device__ __forceinline__ void operator()(int row, int col, f32x4 v0, f32x4) const {
    typedef unsigned u32x2 __attribute__((ext_vector_type(2))); u32x2 pk; pk.x = pk2(v0.x, v0.y); pk.y = pk2(v0.z, v0.w); *(GAS u32x2*)(O + (size_t)row * ldc + col) = pk; } };
struct ThinRes { float* H; int ldc; __device__ __forceinline__ void operator()(int row, int col, f32x4 v0, f32x4) const {
    GAS f32x4* p = (GAS f32x4*)(H + (size_t)row * ldc + col); *p = *p + v0; } };
struct ThinSwiglu { bf16* O; int ldc; __device__ __forceinline__ void operator()(int row, int col, f32x4 g, f32x4 up) const {
    typedef unsigned u32x2 __attribute__((ext_vector_type(2))); f32x4 r;
#pragma unroll
    for (int j = 0; j < 4; ++j) r[j] = g[j] * __builtin_amdgcn_rcpf(1.0f + __builtin_amdgcn_exp2f(-1.4426950408889634f * g[j])) * up[j];
    u32x2 pk; pk.x = pk2(r.x, r.y); pk.y = pk2(r.z, r.w); *(GAS u32x2*)(O + (size_t)row * ldc + col) = pk; } };
template <int SETS, class Epi>
__device__ __forceinline__ void thin_gemm(const Ctx& C, const bf16* __restrict__ A, const bf16* __restrict__ Bt, int K, int nunits, int r0, const Epi& E) {
    const int lane = C.lane, w = C.wave, fr = lane & 15, fq = lane >> 4;
    const int nsteps = K / 32, s_lo = (w * nsteps) / 8, s_hi = ((w + 1) * nsteps) / 8;
    LAS float* red = (LAS float*)C.lds;
    for (int u = blockIdx.x; u < nunits; u += C.G) {
        const int hc = 16 * u;
        const size_t brow0 = SETS == 1 ? (size_t)(hc + fr) : (size_t)((hc >> 7) * 256 + (hc & 127) + fr);
        const bf16* bp0 = Bt + brow0 * K + 32 * s_lo + 8 * fq;
        const bf16* ap = A + (size_t)(r0 + fr) * K + 32 * s_lo + 8 * fq;
        f32x4 acc0[4], acc1[4];
#pragma unroll
        for (int mt = 0; mt < 4; ++mt) { acc0[mt] = (f32x4){0.f, 0.f, 0.f, 0.f}; acc1[mt] = (f32x4){0.f, 0.f, 0.f, 0.f}; }
#pragma unroll 2
        for (int k = 0; k < 32 * (s_hi - s_lo); k += 32) {
            const bf16x8 b0 = *(const GAS bf16x8*)(bp0 + k);
            bf16x8 b1 = b0; if (SETS == 2) b1 = *(const GAS bf16x8*)(bp0 + (size_t)128 * K + k);
#pragma unroll
            for (int mt = 0; mt < 4; ++mt) { const bf16x8 af = *(const GAS bf16x8*)(ap + (size_t)(16 * mt) * K + k);
                acc0[mt] = __builtin_amdgcn_mfma_f32_16x16x32_bf16(b0, af, acc0[mt], 0, 0, 0);
                if (SETS == 2) acc1[mt] = __builtin_amdgcn_mfma_f32_16x16x32_bf16(b1, af, acc1[mt], 0, 0, 0); }
        }
#pragma unroll
        for (int mt = 0; mt < 4; ++mt) { *(LAS f32x4*)(red + ((w * SETS + 0) * 4 + mt) * 256 + lane * 4) = acc0[mt];
            if (SETS == 2) *(LAS f32x4*)(red + ((w * SETS + 1) * 4 + mt) * 256 + lane * 4) = acc1[mt]; }
        __syncthreads();
        if (C.tid < 256) { const int mt = C.tid >> 6, l = C.tid & 63;
            f32x4 s0 = {0.f, 0.f, 0.f, 0.f}, s1 = {0.f, 0.f, 0.f, 0.f};
#pragma unroll
            for (int ww = 0; ww < 8; ++ww) { s0 += *(const LAS f32x4*)(red + ((ww * SETS + 0) * 4 + mt) * 256 + l * 4);
                if (SETS == 2) s1 += *(const LAS f32x4*)(red + ((ww * SETS + 1) * 4 + mt) * 256 + l * 4); }
            E(r0 + 16 * mt + (l & 15), hc + 4 * (l >> 4), s0, s1); }
        __syncthreads();
    }
}

constexpr int P2_T = 48, P2_NCH = LSEQ / P2_T  , P2_UNITS = 16 * NB * P2_NCH  ;
constexpr int P2_XS = 0, P2_XCF = P2_XS + 51 * 128 * 4, P2_XCB = P2_XCF + 48 * 128 * 4, P2_AS = P2_XCB + 48 * 272, P2_BS = P2_AS + 48 * 128 * 4, P2_END = P2_BS + 48 * 128 * 4;
static_assert(P2_END <= SCR_BYTES, "P2 LDS");
__device__ __forceinline__ float sigmoid_fast(float x) { return __builtin_amdgcn_rcpf(1.0f + __builtin_amdgcn_exp2f(-1.4426950408889634f * x)); }
__device__ __forceinline__ void phase2(KArgs a, const Ctx& C) {
    unsigned char* ws = a->ws;
    const bf16* XG = (const bf16*)(ws + WS_XG); const bf16* WG = (const bf16*)(ws + WS_WG);
    bf16* HSL = (bf16*)(ws + WS_HSL); bf16* PCb = (bf16*)(ws + WS_PC); float* CS = (float*)(ws + WS_CSUM);
    LAS float* XS = (LAS float*)(C.lds + P2_XS); LAS float* XCF = (LAS float*)(C.lds + P2_XCF); LAS unsigned char* XCB = C.lds + P2_XCB;
    LAS float* AS = (LAS float*)(C.lds + P2_AS); LAS float* BS = (LAS float*)(C.lds + P2_BS);
    const int tid = C.tid, lane = C.lane, w = C.wave, fr = lane & 15, fq = lane >> 4;
    const int per = (P2_UNITS + C.G - 1) / C.G;
    for (int k = 0; k < per; ++k) {
        const int u = (int)blockIdx.x * per + k; if (u >= P2_UNITS) break;
        const int g = u / (NB * P2_NCH), rem = u - g * (NB * P2_NCH), b = rem / P2_NCH, c = rem - b * P2_NCH;
        const int t0 = c * P2_T; const size_t Rb = (size_t)b * LSEQ;
        bf16x8 wr_[4], wi_[4];
        { const bf16* wrow = WG + ((size_t)g * 256 + 16 * w + fr) * 128 + 8 * fq;
#pragma unroll
          for (int ks = 0; ks < 4; ++ks) { wr_[ks] = *(const GAS bf16x8*)(wrow + 32 * ks); wi_[ks] = *(const GAS bf16x8*)(wrow + 128 * 128 + 32 * ks); } }
#pragma unroll
        for (int p = 0; p < 2; ++p) { const int q = tid + 512 * p; if (q < 51 * 16) { const int j = q >> 4, c8 = q & 15; const int t = t0 - 3 + j;
            f32x4 lo = {0.f, 0.f, 0.f, 0.f}, hi = {0.f, 0.f, 0.f, 0.f};
            if (t >= 0) { const v4u raw = *(const GAS v4u*)(XG + (Rb + t) * 4096 + 128 * g + 8 * c8);
                lo = (f32x4){__uint_as_float(raw.x << 16), __uint_as_float(raw.x & 0xffff0000u), __uint_as_float(raw.y << 16), __uint_as_float(raw.y & 0xffff0000u)};
                hi = (f32x4){__uint_as_float(raw.z << 16), __uint_as_float(raw.z & 0xffff0000u), __uint_as_float(raw.w << 16), __uint_as_float(raw.w & 0xffff0000u)}; }
            *(LAS f32x4*)(XS + j * 128 + 8 * c8) = lo; *(LAS f32x4*)(XS + j * 128 + 8 * c8 + 4) = hi; } }
        __syncthreads();
        { const int ch4 = tid & 31, rsub = tid >> 5; const int gc = 128 * g + 4 * ch4;
          const f32x4 cb = *(const GAS f32x4*)(a->in[5] + gc);
          f32x4 cw[4];
#pragma unroll
          for (int kk = 0; kk < 4; ++kk) cw[kk] = *(const GAS f32x4*)(a->in[4] + kk * DM + gc);
#pragma unroll
          for (int rr = 0; rr < 3; ++rr) { const int row = rsub + 16 * rr; f32x4 y = cb;
#pragma unroll
              for (int kk = 0; kk < 4; ++kk) y += cw[kk] * *(const LAS f32x4*)(XS + (row + kk) * 128 + 4 * ch4);
              *(LAS f32x4*)(XCF + row * 128 + 4 * ch4) = y;
              typedef unsigned u32x2 __attribute__((ext_vector_type(2)));
              u32x2 pk; pk.x = pk2(y.x, y.y); pk.y = pk2(y.z, y.w);
              *(LAS u32x2*)(XCB + row * 272 + 8 * ch4) = pk; } }
        __syncthreads();
        f32x4 accR[3], accI[3];
#pragma unroll
        for (int mt = 0; mt < 3; ++mt) { accR[mt] = (f32x4){0.f, 0.f, 0.f, 0.f}; accI[mt] = (f32x4){0.f, 0.f, 0.f, 0.f}; }
#pragma unroll
        for (int ks = 0; ks < 4; ++ks)
#pragma unroll
            for (int mt = 0; mt < 3; ++mt) { const bf16x8 af = *(const LAS bf16x8*)(XCB + (16 * mt + fr) * 272 + 64 * ks + 16 * fq);
                accR[mt] = __builtin_amdgcn_mfma_f32_16x16x32_bf16(wr_[ks], af, accR[mt], 0, 0, 0);
                accI[mt] = __builtin_amdgcn_mfma_f32_16x16x32_bf16(wi_[ks], af, accI[mt], 0, 0, 0); }
        { const int ch0 = 16 * w + 4 * fq, gc = 128 * g + ch0;
          const f32x4 brg = *(const GAS f32x4*)(a->in[7] + gc), big = *(const GAS f32x4*)(a->in[9] + gc), lam = *(const GAS f32x4*)(a->in[10] + gc);
          f32x4 sp8;
#pragma unroll
          for (int j = 0; j < 4; ++j) sp8[j] = -8.0f * log1pf(__expf(-lam[j]));
#pragma unroll
          for (int mt = 0; mt < 3; ++mt) { const int row = 16 * mt + fr; const f32x4 xc = *(const LAS f32x4*)(XCF + row * 128 + ch0);
              f32x4 av, bv;
#pragma unroll
              for (int j = 0; j < 4; ++j) { const float r = sigmoid_fast(accR[mt][j] + brg[j]), ig = sigmoid_fast(accI[mt][j] + big[j]);
                  const float la = r * sp8[j]; av[j] = __expf(la); bv[j] = sqrtf(-expm1f(2.0f * la)) * (ig * xc[j]); }
              *(LAS f32x4*)(AS + row * 128 + ch0) = av; *(LAS f32x4*)(BS + row * 128 + ch0) = bv; } }
        __syncthreads();
        if (tid < 128) { float h = 0.f, P = 1.f; const size_t o0 = (Rb + t0) * DM + 128 * g + tid;
#pragma unroll 8
            for (int row = 0; row < P2_T; ++row) { const float av = AS[row * 128 + tid], bv = BS[row * 128 + tid]; h = av * h + bv; P *= av;
                HSL[o0 + (size_t)row * DM] = (bf16)f2bf(h); PCb[o0 + (size_t)row * DM] = (bf16)f2bf(P); }
            const size_t cs = ((size_t)b * P2_NCH + c) * DM + 128 * g + tid; CS[cs] = P; CS[(size_t)NB * P2_NCH * DM + cs] = h; }
        __syncthreads();
    }
}
__device__ __forceinline__ void phase3(KArgs a, const Ctx& C) {
    unsigned char* ws = a->ws;
    const bf16* XG = (const bf16*)(ws + WS_XG); const bf16* HSL = (const bf16*)(ws + WS_HSL); const bf16* PCb = (const bf16*)(ws + WS_PC); const float* CS = (const float*)(ws + WS_CSUM);
    bf16* Y = (bf16*)(ws + WS_Y);
    typedef unsigned u32x2 __attribute__((ext_vector_type(2)));
    for (int wu = C.gw; wu < NB * P2_NCH * 8; wu += C.NGW) {
        const int cb = wu & 7, bc = wu >> 3, b = bc / P2_NCH, c = bc - b * P2_NCH; const int ch = 256 * cb + 4 * C.lane;
        f32x4 carry = {0.f, 0.f, 0.f, 0.f};
        for (int cc = 0; cc < c; ++cc) { const size_t cs = ((size_t)b * P2_NCH + cc) * DM + ch;
            const f32x4 A = *(const GAS f32x4*)(CS + cs), H = *(const GAS f32x4*)(CS + (size_t)NB * P2_NCH * DM + cs); carry = A * carry + H; }
        const size_t r0 = (size_t)b * LSEQ + (size_t)c * P2_T;
#pragma unroll 4
        for (int row = 0; row < P2_T; ++row) { const size_t o = (r0 + row) * DM + ch;
            const u32x2 hs = *(const GAS u32x2*)(HSL + o), pc = *(const GAS u32x2*)(PCb + o), gg = *(const GAS u32x2*)(XG + (r0 + row) * 4096 + DM + ch);
            const f32x4 hv = {__uint_as_float(hs.x << 16), __uint_as_float(hs.x & 0xffff0000u), __uint_as_float(hs.y << 16), __uint_as_float(hs.y & 0xffff0000u)};
            const f32x4 pv = {__uint_as_float(pc.x << 16), __uint_as_float(pc.x & 0xffff0000u), __uint_as_float(pc.y << 16), __uint_as_float(pc.y & 0xffff0000u)};
            const f32x4 gv = {__uint_as_float(gg.x << 16), __uint_as_float(gg.x & 0xffff0000u), __uint_as_float(gg.y << 16), __uint_as_float(gg.y & 0xffff0000u)};
            f32x4 y;
#pragma unroll
            for (int j = 0; j < 4; ++j) { const float gx = gv[j]; const float z2 = 1.5957691216057308f * (gx + 0.044715f * gx * gx * gx);
                const float gl = gx * __builtin_amdgcn_rcpf(1.0f + __builtin_amdgcn_exp2f(-1.4426950408889634f * z2)); y[j] = (hv[j] + pv[j] * carry[j]) * gl; }
            u32x2 pk; pk.x = pk2(y.x, y.y); pk.y = pk2(y.z, y.w); *(GAS u32x2*)(Y + o) = pk; }
    }
}

namespace attn {
constexpr int D = 128;
constexpr float THR = 8.f;
constexpr bool WSKIP = false;
constexpr int QP = 2048, KVP = 4096, OP = 2048;
constexpr float SCALE = 0.08838834764831845f;
constexpr int NW = 8, QBLK = 32, KVBLK = 64, QB = NW * QBLK;
constexpr int SHM_V = KVBLK * D * 2, SHM_K = KVBLK * D * 2;
constexpr int LDS_BYTES = 2 * SHM_V + 2 * SHM_K + NW * 64 * 4;
typedef unsigned short bf16;
typedef short bf16x8 __attribute__((ext_vector_type(8)));
typedef short s16x4 __attribute__((ext_vector_type(4)));
typedef float f32x16 __attribute__((ext_vector_type(16)));
typedef float f32x4 __attribute__((ext_vector_type(4)));
typedef unsigned u32x4 __attribute__((ext_vector_type(4)));
template <class A, class Bt> struct same_t { static constexpr bool v = false; };
template <class A> struct same_t<A, A> { static constexpr bool v = true; };
#define KSWZ(row, colB) ((row) * 256 + ((colB) ^ (((row) & 7) << 4)))
#define SBAR() __builtin_amdgcn_sched_barrier(0)
__device__ __forceinline__ int v_st(int k, int c) { const int kk = (k & ~0xC) | ((k & 4) << 1) | ((k & 8) >> 1); return ((kk >> 3) * 4 + (c >> 5)) * 512 + ((kk & 7) * 32 + (c & 31)) * 2; }
__device__ __forceinline__ int v_rd_base(int lane) { return ((lane & 3) << 3) | (((lane >> 2) & 3) << 6) | (((lane >> 4) & 1) << 5) | (((lane >> 5) & 1) << 8); }
constexpr int v_rd_off(int d0, int ks, int half) { return d0 * 512 + ks * 4096 + half * 2048; }
__device__ __forceinline__ int crow(int r, int hi) { return (r & 3) + 8 * (r >> 2) + 4 * hi; }
__device__ __forceinline__ unsigned cvtpk(float lo, float hi) {
    unsigned r; asm volatile("v_cvt_pk_bf16_f32 %0, %1, %2" : "=v"(r) : "v"(lo), "v"(hi)); return r;
}
__device__ __forceinline__ bf16x8 pack8(f32x4 a, f32x4 b) {
    u32x4 w = {cvtpk(a[0], a[1]), cvtpk(a[2], a[3]), cvtpk(b[0], b[1]), cvtpk(b[2], b[3])};
    return *reinterpret_cast<bf16x8*>(&w);
}
template <class T> __device__ __forceinline__ bf16x8 load8(const T* p) {
    if constexpr (same_t<T, float>::v) { return pack8(*(const f32x4*)p, *(const f32x4*)(p + 4)); }
    else { return *reinterpret_cast<const bf16x8*>(p); }
}
__device__ __forceinline__ void bias_tile(f32x16& p0, f32x16& p1, float cb, float b0) {
    const float b1 = fmaf(cb, 32.f, b0);
#pragma unroll
    for (int r = 0; r < 16; ++r) { const float c = (float)((r & 3) + 8 * (r >> 2)); p0[r] += fmaf(cb, c, b0); p1[r] += fmaf(cb, c, b1); }
}
__device__ __forceinline__ void mask_tile(f32x16& p0, f32x16& p1, int dq, unsigned W) {
    const float NEG = -__builtin_inff();
#pragma unroll
    for (int r = 0; r < 16; ++r) {
        const int c = (r & 3) + 8 * (r >> 2);
        if ((unsigned)(dq - c) >= W) p0[r] = NEG;
        if ((unsigned)(dq - c - 32) >= W) p1[r] = NEG;
    }
}
__device__ __forceinline__ void partialSM(f32x16& p0, f32x16& p1, float& m_reg, float& mn, float& alpha) {
    float pmax = p0[0]; for (int r = 1; r < 16; ++r) pmax = fmaxf(pmax, p0[r]); for (int r = 0; r < 16; ++r) pmax = fmaxf(pmax, p1[r]);
    { auto rr = __builtin_amdgcn_permlane32_swap(__float_as_uint(pmax), __float_as_uint(pmax), false, false);
      pmax = fmaxf(__uint_as_float(rr[0]), __uint_as_float(rr[1])); }
    constexpr float C2 = 1.4426950408889634f * SCALE;
    if (__builtin_expect(__all((pmax - m_reg) * SCALE <= THR), 1)) { mn = m_reg; alpha = 1.f; }
    else { mn = fmaxf(m_reg, pmax); alpha = __builtin_amdgcn_exp2f((m_reg - mn) * C2); m_reg = mn; }
    const float mnL = -mn * C2;
    for (int r = 0; r < 16; ++r) p0[r] = fmaf(p0[r], C2, mnL); for (int r = 0; r < 16; ++r) p1[r] = fmaf(p1[r], C2, mnL);
    for (int r = 0; r < 16; ++r) p0[r] = __builtin_amdgcn_exp2f(p0[r]);
}
__device__ __forceinline__ void finishSM(f32x16& p0, f32x16& p1, float alpha, float& l_reg, bf16x8& pa0, bf16x8& pa1, bf16x8& pa2, bf16x8& pa3) {
    for (int r = 0; r < 16; ++r) p1[r] = __builtin_amdgcn_exp2f(p1[r]);
    float ps = 0; for (int r = 0; r < 16; ++r) ps += p0[r]; for (int r = 0; r < 16; ++r) ps += p1[r];
    { auto rr = __builtin_amdgcn_permlane32_swap(__float_as_uint(ps), __float_as_uint(ps), false, false);
      ps = __uint_as_float(rr[0]) + __uint_as_float(rr[1]); }
    l_reg = l_reg * alpha + ps;
#define PK4(P, B_, OUT) do { unsigned a0 = cvtpk(P[B_+0], P[B_+1]), a1 = cvtpk(P[B_+2], P[B_+3]);                          \
        unsigned b0 = cvtpk(P[B_+4], P[B_+5]), b1 = cvtpk(P[B_+6], P[B_+7]);                                             \
        auto r0 = __builtin_amdgcn_permlane32_swap(a0, b0, false, false); auto r1 = __builtin_amdgcn_permlane32_swap(a1, b1, false, false); \
        u32x4 w = {r0[0], r1[0], r0[1], r1[1]}; OUT = *reinterpret_cast<bf16x8*>(&w); } while (0)
    PK4(p0, 0, pa0); PK4(p0, 8, pa1); PK4(p1, 0, pa2); PK4(p1, 8, pa3);
#undef PK4
}
template <int KB, bool SK>
__device__ __forceinline__ void qkt(f32x16& p0, f32x16& p1, const char* K_lds, int r32, int hi, const bf16x8* qr, bool act) {
    if (SK && !act) { const float NEG = -__builtin_inff();
#pragma unroll
        for (int r = 0; r < 16; ++r) { p0[r] = NEG; p1[r] = NEG; } return; }
    p0 = f32x16{}; p1 = f32x16{};
    const char* kb[4];
#pragma unroll
    for (int dd = 0; dd < 4; ++dd) kb[dd] = K_lds + KB * SHM_K + KSWZ(r32, (dd * 16 + hi * 8) * 2);
#pragma unroll
    for (int d0 = 0; d0 < 8; ++d0) { const char* a = kb[d0 & 3] + (d0 >> 2) * 128;
        bf16x8 b0 = *reinterpret_cast<const bf16x8*>(a);
        bf16x8 b1 = *reinterpret_cast<const bf16x8*>(a + 32 * 256);
        p0 = __builtin_amdgcn_mfma_f32_32x32x16_bf16(b0, qr[d0], p0, 0, 0, 0);
        p1 = __builtin_amdgcn_mfma_f32_32x32x16_bf16(b1, qr[d0], p1, 0, 0, 0); }
}
template <int VB, bool SK>
__device__ __forceinline__ void pv_tile(f32x16* o, int vb0, bf16x8 pa0, bf16x8 pa1, bf16x8 pa2, bf16x8 pa3, bool act) {
    if (SK && !act) return;
#define TRRD(dst, off) asm volatile("ds_read_b64_tr_b16 %0, %1 offset:%2" : "=&v"(dst) : "v"(vb0), "i"(off) : "memory")
#define PV_D0(d0) do { s16x4 l0, l1, l2, l3, h0, h1, h2, h3; constexpr int b_ = VB * SHM_V + v_rd_off(d0, 0, 0);     \
        TRRD(l0, b_); TRRD(h0, b_ + 2048); TRRD(l1, b_ + 4096); TRRD(h1, b_ + 6144); TRRD(l2, b_ + 8192); TRRD(h2, b_ + 10240); TRRD(l3, b_ + 12288); TRRD(h3, b_ + 14336); \
        asm volatile("s_waitcnt lgkmcnt(0)" ::: "memory"); SBAR();                 \
        o[d0] = __builtin_amdgcn_mfma_f32_32x32x16_bf16(pa0, (bf16x8){l0[0], l0[1], l0[2], l0[3], h0[0], h0[1], h0[2], h0[3]}, o[d0], 0, 0, 0);   \
        o[d0] = __builtin_amdgcn_mfma_f32_32x32x16_bf16(pa1, (bf16x8){l1[0], l1[1], l1[2], l1[3], h1[0], h1[1], h1[2], h1[3]}, o[d0], 0, 0, 0);   \
        o[d0] = __builtin_amdgcn_mfma_f32_32x32x16_bf16(pa2, (bf16x8){l2[0], l2[1], l2[2], l2[3], h2[0], h2[1], h2[2], h2[3]}, o[d0], 0, 0, 0);   \
        o[d0] = __builtin_amdgcn_mfma_f32_32x32x16_bf16(pa3, (bf16x8){l3[0], l3[1], l3[2], l3[3], h3[0], h3[1], h3[2], h3[3]}, o[d0], 0, 0, 0); } while (0)
    PV_D0(0); PV_D0(1); PV_D0(2); PV_D0(3);
#undef PV_D0
#undef TRRD
}

template <class TIn, class TOut> struct BlockRef { const TIn* Q; const TIn* K; const TIn* V; TOut* O; int P0; float cb; };
template <class TIn> struct Seam {
    bf16x8 qr[8];
    bf16x8 st_v0, st_v1, st_k0, st_k1; f32x4 sf0, sf1, sf2, sf3;
    f32x4 tq[16];
};
__device__ __forceinline__ int swa_jlo(int P0, int W) { const int lowk = P0 - W + 1; return lowk > 0 ? lowk / KVBLK : 0; }
#define ROW(p, k0, rr) ((p) + (size_t)((k0) + (rr) - sr) * KVP + (unsigned)(sr * KVP + sc))
#define VMW() asm volatile("s_waitcnt vmcnt(0)" ::: "memory")
#define VMWN(n) asm volatile("s_waitcnt vmcnt(%0)" :: "i"(n) : "memory")
#define SLOAD_H(Kp, Vp, k0) do { S.st_v0 = load8<TIn>(ROW(Vp, k0, sr)); S.st_v1 = load8<TIn>(ROW(Vp, k0, 32 + sr));              \
                         S.st_k0 = load8<TIn>(ROW(Kp, k0, sr)); S.st_k1 = load8<TIn>(ROW(Kp, k0, 32 + sr)); } while (0)
#define SWRITE_HK(bf) do { *(bf16x8*)(K_lds + (bf) * SHM_K + kws) = S.st_k0; *(bf16x8*)(K_lds + (bf) * SHM_K + kws + 32 * 256) = S.st_k1; } while (0)
#define SWRITE_HV(bf) do { *(bf16x8*)(V_lds + (bf) * SHM_V + vst0) = S.st_v0; *(bf16x8*)(V_lds + (bf) * SHM_V + vst1) = S.st_v1; } while (0)
#define SWRITE_H(bf) do { SWRITE_HV(bf); SWRITE_HK(bf); } while (0)
#define SLOAD_F(p, k0) do { S.sf0 = *(const f32x4*)ROW(p, k0, sr); S.sf1 = *(const f32x4*)(ROW(p, k0, sr) + 4);                \
                            S.sf2 = *(const f32x4*)ROW(p, k0, 32 + sr); S.sf3 = *(const f32x4*)(ROW(p, k0, 32 + sr) + 4); } while (0)
#define SWRITE_KF(bf) do { *(bf16x8*)(K_lds + (bf) * SHM_K + kws) = pack8(S.sf0, S.sf1); *(bf16x8*)(K_lds + (bf) * SHM_K + kws + 32 * 256) = pack8(S.sf2, S.sf3); } while (0)
#define SWRITE_VF(bf) do { *(bf16x8*)(V_lds + (bf) * SHM_V + vst0) = pack8(S.sf0, S.sf1); *(bf16x8*)(V_lds + (bf) * SHM_V + vst1) = pack8(S.sf2, S.sf3); } while (0)
template <class TIn, class TOut>
__device__ __forceinline__ void causal_swa_prime(const BlockRef<TIn, TOut>& cur, int W, char* lds, Seam<TIn>& S, const int wid_in) {
    constexpr bool F32 = same_t<TIn, float>::v;
    __builtin_assume(wid_in >= 0 && wid_in < 8); const int wid = wid_in, lane = mk_lane(), tid = wid * 64 + lane, r32 = lane & 31, hi = lane >> 5;
    const int sr = tid >> 4, sc = (tid & 15) * 8, kws = KSWZ(sr, sc * 2); char* K_lds = lds + 2 * SHM_V;
    const int kb0 = swa_jlo(cur.P0, W) * KVBLK;
    for (int d0 = 0; d0 < 8; ++d0) S.qr[d0] = load8<TIn>(cur.Q + (size_t)(wid * QBLK) * QP + (unsigned)(r32 * QP + hi * 8) + d0 * 16);
    if constexpr (F32) { SLOAD_F((const float*)cur.K, kb0); VMW(); SWRITE_KF(0); SBAR(); SLOAD_F((const float*)cur.V, kb0); }
    else { SLOAD_H(cur.K, cur.V, kb0); VMW(); SWRITE_HK(0); }
    __syncthreads();
}
template <class TIn, class TOut>
__device__ __forceinline__ void causal_swa_block(const BlockRef<TIn, TOut>& cur, const BlockRef<TIn, TOut>& nxt, int skv, int W, char* lds, Seam<TIn>& S, const int wid_in) {
    constexpr bool F32 = same_t<TIn, float>::v;
    __builtin_assume(wid_in >= 0 && wid_in < 8); const int wid = wid_in, lane = mk_lane(), tid = wid * 64 + lane, r32 = lane & 31, hi = lane >> 5;
    const int j_lo = swa_jlo(cur.P0, W);
    int j_hi = (cur.P0 + QB - 1) / KVBLK + 1; if (j_hi > skv / KVBLK) j_hi = skv / KVBLK;
    const int NT = j_hi - j_lo;
    const int kbn = swa_jlo(nxt.P0, W) * KVBLK;
    const int qlo = cur.P0 + wid * QBLK, qm = qlo + r32 - 4 * hi;
    char* V_lds = lds; char* K_lds = lds + 2 * SHM_V;
    float* ws = (float*)(lds + 2 * SHM_V + 2 * SHM_K) + wid * 64; float* li_l = ws, * al_l = ws + 32;
    float m_reg = -1e30f, l_reg = 0; f32x16 o[4] = {};
    const int sr = tid >> 4, sc = (tid & 15) * 8, vst0 = v_st(sr, sc), vst1 = v_st(32 + sr, sc), kws = KSWZ(sr, sc * 2);
    const int vb0 = (int)(uintptr_t)V_lds + v_rd_base(lane);
    const TIn* Kh = cur.K; const TIn* Vh = cur.V;
#define RESC(a) do { if (__any((a) < 1.f)) { if (hi == 0) al_l[r32] = (a); asm volatile("s_waitcnt lgkmcnt(0)" ::: "memory");              \
                     for (int d_ = 0; d_ < 4; ++d_) for (int r = 0; r < 16; ++r) o[d_][r] *= al_l[crow(r, hi)]; } } while (0)
#define KBASE(t) ((j_lo + (t)) * KVBLK)
#define ACT(t) (KBASE(t) <= qlo + QBLK - 1 && KBASE(t) + KVBLK - 1 >= qlo - W + 1)
#define MASKT(P0_, P1_, t) do { const int kb_ = KBASE(t); bias_tile(P0_, P1_, cur.cb, cur.cb * (float)(kb_ + 4 * hi)); if ((!SK || ACT(t)) && (kb_ + KVBLK - 1 > qlo || kb_ <= qlo + QBLK - 1 - W)) mask_tile(P0_, P1_, qm - kb_, (unsigned)W); } while (0)
    constexpr int NQL = F32 ? 16 : 8;
    constexpr bool SK = WSKIP && !F32;
#define SEAM_K0() do { VMWN(NQL); if constexpr (F32) { SWRITE_KF(0); SBAR(); SLOAD_F((const float*)nxt.V, kbn); } else { SWRITE_HK(0); } SBAR(); } while (0)
    f32x16 pA0, pA1, pB0, pB1; float mnA, mnB, alA, alB; bf16x8 pa0, pa1, pa2, pa3;
    if constexpr (F32) { VMW(); SWRITE_VF(0); SBAR(); } else { SWRITE_HV(0); SBAR(); }
    if (NT > 1) { if constexpr (F32) SLOAD_F((const float*)Kh, KBASE(1)); else SLOAD_H(Kh, Vh, KBASE(1)); }
    SBAR(); qkt<0, SK>(pA0, pA1, K_lds, r32, hi, S.qr, ACT(0));
    if constexpr (F32) { if (NT > 1) { VMW(); SWRITE_KF(1); SBAR(); SLOAD_F((const float*)Vh, KBASE(1)); } }
    MASKT(pA0, pA1, 0); partialSM(pA0, pA1, m_reg, mnA, alA);
    if (NT > 1) { VMW(); if constexpr (F32) { SWRITE_VF(1); SBAR(); if (NT > 2) SLOAD_F((const float*)Kh, KBASE(2)); } else SWRITE_H(1); }
    __syncthreads();
#define HALF_STEP(PX0, PX1, mnX, alX, PY0, PY1, alY, t, KB, VB, SB) do {                                                      \
        SBAR(); qkt<KB, SK>(PX0, PX1, K_lds, r32, hi, S.qr, ACT(t));                                             \
        finishSM(PY0, PY1, alY, l_reg, pa0, pa1, pa2, pa3); SBAR();                                                           \
        if ((t) + 1 < NT) { if constexpr (F32) { VMW(); SWRITE_KF(SB); SBAR(); SLOAD_F((const float*)Vh, KBASE((t) + 1)); }  \
                            else { SLOAD_H(Kh, Vh, KBASE((t) + 1)); } SBAR(); }                                               \
        pv_tile<VB, SK>(o, vb0, pa0, pa1, pa2, pa3, ACT((t) - 1)); MASKT(PX0, PX1, (t)); partialSM(PX0, PX1, m_reg, mnX, alX);                                        \
        __syncthreads();                                                                                                      \
        if ((t) + 1 < NT) { VMW(); if constexpr (F32) { SWRITE_VF(SB); SBAR(); if ((t) + 2 < NT) SLOAD_F((const float*)Kh, KBASE((t) + 2)); } \
                            else { SWRITE_H(SB); } }                                                                          \
        RESC(alX); __syncthreads(); } while (0)
    for (int t = 1; t + 1 < NT; t += 2) {
        HALF_STEP(pB0, pB1, mnB, alB, pA0, pA1, alA, t, 1, 0, 0);
        HALF_STEP(pA0, pA1, mnA, alA, pB0, pB1, alB, t + 1, 0, 1, 1);
    }
    const bool even = (NT & 1) == 0;
    if (even) { SBAR(); qkt<1, SK>(pB0, pB1, K_lds, r32, hi, S.qr, ACT(NT - 1)); SBAR(); }
#define QROW(e) (nxt.Q + (size_t)(wid * QBLK + r32) * QP + ((e) >> 1) * 16 + hi * 8 + ((e) & 1) * 4)
    if constexpr (F32) { SLOAD_F((const float*)nxt.K, kbn); SBAR();
#pragma unroll
        for (int e = 0; e < 8; ++e) S.tq[e] = *(const f32x4*)QROW(e); }
    else { SLOAD_H(nxt.K, nxt.V, kbn); SBAR();
#pragma unroll
        for (int d0 = 0; d0 < 8; ++d0) S.qr[d0] = load8<TIn>(nxt.Q + (size_t)(wid * QBLK) * QP + (unsigned)(r32 * QP + hi * 8) + d0 * 16); }
    SBAR();
    finishSM(pA0, pA1, alA, l_reg, pa0, pa1, pa2, pa3); SBAR();
    if constexpr (F32) {
#pragma unroll
        for (int e = 8; e < 16; ++e) S.tq[e] = *(const f32x4*)QROW(e); SBAR(); }
#undef QROW
    pv_tile<0, SK>(o, vb0, pa0, pa1, pa2, pa3, ACT(even ? NT - 2 : NT - 1));
    if (even) { MASKT(pB0, pB1, NT - 1); partialSM(pB0, pB1, m_reg, mnB, alB); __syncthreads(); RESC(alB);
        finishSM(pB0, pB1, alB, l_reg, pa0, pa1, pa2, pa3); SBAR(); pv_tile<1, SK>(o, vb0, pa0, pa1, pa2, pa3, ACT(NT - 1)); }
    SBAR(); SEAM_K0();
    if (hi == 0) li_l[r32] = l_reg; asm volatile("s_waitcnt lgkmcnt(0)" ::: "memory");
    float rli[16];
#pragma unroll
    for (int r = 0; r < 16; ++r) rli[r] = __builtin_amdgcn_rcpf(li_l[crow(r, hi)]);
    TOut* Ow = cur.O + (size_t)(wid * QBLK) * OP;
#pragma unroll
    for (int r = 0; r < 16; ++r) { const int orow = crow(r, hi);
#pragma unroll
        for (int d0 = 0; d0 < 4; ++d0) { const float v = o[d0][r] * rli[r];
            if constexpr (same_t<TOut, float>::v) { Ow[(size_t)orow * OP + d0 * 32 + r32] = v; }
            else { const float vn = __shfl_xor(v, 1);
                   if ((r32 & 1) == 0) *(unsigned*)(Ow + (size_t)orow * OP + d0 * 32 + r32) = cvtpk(v, vn); } } }
    if constexpr (F32) {
#pragma unroll
        for (int d0 = 0; d0 < 8; ++d0) S.qr[d0] = pack8(S.tq[2 * d0], S.tq[2 * d0 + 1]); }
    __syncthreads();
#undef RESC
#undef KBASE
#undef ACT
#undef MASKT
#undef SEAM_K0
#undef HALF_STEP
}
#undef ROW
#undef VMW
#undef VMWN
#undef SLOAD_H
#undef SWRITE_HK
#undef SWRITE_HV
#undef SWRITE_H
#undef SLOAD_F
#undef SWRITE_KF
#undef SWRITE_VF
}

constexpr float LAMBDA_INIT = 0.35550906759096924f;
__device__ __forceinline__ attn::BlockRef<attn::bf16, float> attn_ref(unsigned char* ws, int bh, int qb) {
    const int b = bh >> 5, h = (bh >> 2) & 7, map = (bh >> 1) & 1, vh = bh & 1;
    attn::BlockRef<attn::bf16, float> r;
    r.Q = (const attn::bf16*)(ws + WS_QB) + ((size_t)b * SEQ + (size_t)qb * 256) * DM + map * 1024 + h * 128;
    r.K = (const attn::bf16*)(ws + WS_KVB) + (size_t)b * LSEQ * 4096 + map * 1024 + h * 128;
    r.V = (const attn::bf16*)(ws + WS_KVB) + (size_t)b * LSEQ * 4096 + 2048 + h * 256 + vh * 128;
    r.O = (float*)(ws + WS_OB) + (size_t)map * MS * DM + ((size_t)b * SEQ + (size_t)qb * 256) * DM + h * 256 + vh * 128;
    r.P0 = NMETA + qb * 256;
    r.cb = __builtin_amdgcn_exp2f(-(float)(h + 1)) * 11.313708498984761f;
    return r;
}
__device__ __forceinline__ void phase10(KArgs a, const Ctx& C, char* lds) {
    using namespace attn;
    constexpr int total = 4 * 128;
    constexpr int SKV = 2112, W = 0x40000000;
    int L = blockIdx.x; const int stride = C.G;
    if (L < total) {
        int bh = L >> 2, x = L & 3, pass = 0;
        BlockRef<bf16, float> cur = attn_ref(a->ws, bh, x);
        Seam<bf16> S;
        causal_swa_prime<bf16, float>(cur, W, lds, S, C.wave);
        for (;;) {
            const bool more_pass = pass == 0, more_item = L + stride < total, last = !more_pass && !more_item;
            int bhn = bh, xn = x, passn = pass + 1, Ln = L;
            if (!more_pass) { passn = 0; Ln = more_item ? L + stride : L; bhn = Ln >> 2; xn = Ln & 3; }
            const BlockRef<bf16, float> nxt = last ? cur : attn_ref(a->ws, bhn, passn ? 7 - xn : xn);
            causal_swa_block<bf16, float>(cur, nxt, SKV, W, lds, S, C.wave);
            if (last) break;
            cur = nxt; bh = bhn; x = xn; pass = passn; L = Ln;
        }
    }
}
__device__ __forceinline__ void phase11(KArgs a, const Ctx& C) {
    unsigned char* ws = a->ws;
    const float* O1 = (const float*)(ws + WS_OB); const float* O2 = O1 + (size_t)MS * DM; bf16* ON = (bf16*)(ws + WS_ON);
    const int lane = C.lane;
    float lam;
    { const float s1 = wave_sum(a->in[16][lane] * a->in[17][lane] + a->in[16][lane + 64] * a->in[17][lane + 64]);
      const float s2 = wave_sum(a->in[18][lane] * a->in[19][lane] + a->in[18][lane + 64] * a->in[19][lane + 64]);
      lam = __expf(s1) - __expf(s2) + LAMBDA_INIT; }
    const f32x4 gs = *((const GAS f32x4*)a->in[20] + lane) * (1.0f - LAMBDA_INIT);
    for (int row = C.gw; row < MS; row += C.NGW) {
        const GAS f32x4* p1 = (const GAS f32x4*)(O1 + (size_t)row * DM) + lane; const GAS f32x4* p2 = (const GAS f32x4*)(O2 + (size_t)row * DM) + lane;
        GAS u64* o8 = (GAS u64*)(ON + (size_t)row * DM) + lane;
        f32x4 v[8];
#pragma unroll
        for (int j = 0; j < 8; ++j) v[j] = p1[64 * j] - lam * p2[64 * j];
#pragma unroll
        for (int j = 0; j < 8; ++j) { const float s = wave_sum((v[j].x * v[j].x + v[j].y * v[j].y) + (v[j].z * v[j].z + v[j].w * v[j].w));
            const float rstd = 1.f / sqrtf(s * (1.f / VDIM) + RMS_EPS); const f32x4 y = v[j] * rstd * gs;
            o8[64 * j] = (u64)pk2(y.x, y.y) | ((u64)pk2(y.z, y.w) << 32); }
    }
}

constexpr size_t MISC_TOKE = 0, MISC_TOKW = 64 * 1024, MISC_TOKS = 128 * 1024, MISC_PE = 192 * 1024;
__device__ __forceinline__ void phase13(KArgs a, const Ctx& C) {
    unsigned char* ws = a->ws; const int lane = C.lane;
    const float* H3 = (const float*)(ws + WS_H3); bf16* UM = (bf16*)(ws + WS_UM);
    int* TOKE = (int*)(ws + WS_MISC + MISC_TOKE); float* TOKW = (float*)(ws + WS_MISC + MISC_TOKW);
    LAS float* RL = (LAS float*)C.lds;
    LAS unsigned* hist = (LAS unsigned*)(C.lds + MISC_OFF) + 16;
    for (int i = C.tid; i < DM * NEXP / 4; i += NWAVES * 64) *((LAS f32x4*)RL + i) = *((const GAS f32x4*)a->in[26] + i);
    __syncthreads();
    const float* gain = a->in[22] + DM;
    for (int row = C.gw; row < MS; row += C.NGW) {
        const GAS f32x4* xr = (const GAS f32x4*)(H3 + (size_t)row * DM) + lane; const GAS f32x4* gr = (const GAS f32x4*)gain + lane;
        f32x4 v[8]; float s = 0.f;
#pragma unroll
        for (int j = 0; j < 8; ++j) { v[j] = xr[64 * j]; s += (v[j].x * v[j].x + v[j].y * v[j].y) + (v[j].z * v[j].z + v[j].w * v[j].w); }
        const float rstd = 1.f / sqrtf(wave_sum(s) * (1.f / DM) + RMS_EPS);
        GAS u64* o8 = (GAS u64*)(UM + (size_t)row * DM) + lane;
        float p[8];
#pragma unroll
        for (int e = 0; e < 8; ++e) p[e] = 0.f;
#pragma unroll
        for (int j = 0; j < 8; ++j) { const f32x4 y = v[j] * rstd * gr[64 * j];
            o8[64 * j] = (u64)pk2(y.x, y.y) | ((u64)pk2(y.z, y.w) << 32);
#pragma unroll
            for (int i = 0; i < 4; ++i) { const LAS f32x4* rr = (const LAS f32x4*)(RL + (256 * j + 4 * lane + i) * 8); const f32x4 r0 = rr[0], r1 = rr[1];
                p[0] += y[i] * r0.x; p[1] += y[i] * r0.y; p[2] += y[i] * r0.z; p[3] += y[i] * r0.w; p[4] += y[i] * r1.x; p[5] += y[i] * r1.y; p[6] += y[i] * r1.z; p[7] += y[i] * r1.w; }
            asm volatile("" ::: "memory"); }
#pragma unroll
        for (int e = 0; e < 8; ++e) p[e] = wave_sum(p[e]);
        int i1 = 0; float v1 = p[0];
#pragma unroll
        for (int e = 1; e < 8; ++e) if (p[e] > v1) { v1 = p[e]; i1 = e; }
        int i2 = -1; float v2 = -__builtin_inff();
#pragma unroll
        for (int e = 0; e < 8; ++e) if (e != i1 && p[e] > v2) { v2 = p[e]; i2 = e; }
        const float e2 = __expf(v2 - v1), w1 = 1.f / (1.f + e2), w2 = e2 * w1;
        if (lane == 0) { TOKE[2 * row] = i1; TOKE[2 * row + 1] = i2; TOKW[2 * row] = w1; TOKW[2 * row + 1] = w2;
            __hip_atomic_fetch_add(hist + i1, 1u, __ATOMIC_RELAXED, __HIP_MEMORY_SCOPE_WORKGROUP); __hip_atomic_fetch_add(hist + i2, 1u, __ATOMIC_RELAXED, __HIP_MEMORY_SCOPE_WORKGROUP); }
    }
    __syncthreads();
    if (C.tid < 8) { const unsigned hcount = hist[C.tid]; if (hcount) __hip_atomic_fetch_add((unsigned*)((gu32*)(ws + WS_CTL) + CW_CNT + 64 * C.tid), hcount, RLX_AGENT); }
}
struct ExpTab { int cnt[8], np[8], pb[8]; int npanels; };
__device__ __forceinline__ void load_exptab(unsigned char* ws, ExpTab& T) {
    int acc = 0;
#pragma unroll
    for (int e = 0; e < 8; ++e) { const int c = __builtin_amdgcn_readfirstlane((int)__hip_atomic_load((unsigned*)((gu32*)(ws + WS_CTL) + CW_CNT + 64 * e), RLX_AGENT));
        T.cnt[e] = c; T.np[e] = (c + 255) >> 8; T.pb[e] = acc; acc += T.np[e]; }
    T.npanels = acc;
}
__device__ __forceinline__ void phase14(KArgs a, const Ctx& C) {
    unsigned char* ws = a->ws; const int lane = C.lane;
    const bf16* UM = (const bf16*)(ws + WS_UM); unsigned char* XP = ws + WS_XPERM;
    const int* TOKE = (const int*)(ws + WS_MISC + MISC_TOKE); int* TOKS = (int*)(ws + WS_MISC + MISC_TOKS);
    ExpTab T; load_exptab(ws, T);
    for (int row = C.gw; row < MS; row += C.NGW) {
        int s1 = 0, s2 = 0;
        if (lane == 0) { const int e1 = TOKE[2 * row], e2 = TOKE[2 * row + 1]; int b1 = 0, b2 = 0;
#pragma unroll
            for (int e = 0; e < 8; ++e) { if (e == e1) b1 = T.pb[e]; if (e == e2) b2 = T.pb[e]; }
            s1 = b1 * 256 + (int)__hip_atomic_fetch_add((unsigned*)((gu32*)(ws + WS_CTL) + CW_CUR + 64 * e1), 1u, RLX_AGENT);
            s2 = b2 * 256 + (int)__hip_atomic_fetch_add((unsigned*)((gu32*)(ws + WS_CTL) + CW_CUR + 64 * e2), 1u, RLX_AGENT);
            TOKS[2 * row] = s1; TOKS[2 * row + 1] = s2; }
        s1 = __builtin_amdgcn_readfirstlane(s1); s2 = __builtin_amdgcn_readfirstlane(s2);
        const GAS v4u* src = (const GAS v4u*)(UM + (size_t)row * DM + 32 * lane); v4u o[2];
#pragma unroll
        for (int hh = 0; hh < 2; ++hh) { const v4u x0 = src[2 * hh], x1 = src[2 * hh + 1];
            o[hh].x = pk4_fp8(__uint_as_float(x0.x << 16), __uint_as_float(x0.x & 0xffff0000u), __uint_as_float(x0.y << 16), __uint_as_float(x0.y & 0xffff0000u));
            o[hh].y = pk4_fp8(__uint_as_float(x0.z << 16), __uint_as_float(x0.z & 0xffff0000u), __uint_as_float(x0.w << 16), __uint_as_float(x0.w & 0xffff0000u));
            o[hh].z = pk4_fp8(__uint_as_float(x1.x << 16), __uint_as_float(x1.x & 0xffff0000u), __uint_as_float(x1.y << 16), __uint_as_float(x1.y & 0xffff0000u));
            o[hh].w = pk4_fp8(__uint_as_float(x1.z << 16), __uint_as_float(x1.z & 0xffff0000u), __uint_as_float(x1.w << 16), __uint_as_float(x1.w & 0xffff0000u)); }
        GAS v4u* d1 = (GAS v4u*)(XP + (size_t)s1 * DM + 32 * lane); GAS v4u* d2 = (GAS v4u*)(XP + (size_t)s2 * DM + 32 * lane);
        d1[0] = o[0]; d1[1] = o[1]; d2[0] = o[0]; d2[1] = o[1];
    }
    if (blockIdx.x == 0 && C.tid < 128 && C.tid < T.npanels) { int e = 0;
#pragma unroll
        for (int q = 1; q < 8; ++q) e += (C.tid >= T.pb[q]) ? 1 : 0;
        ((int*)(ws + WS_MISC + MISC_PE))[C.tid] = e; }
    for (int pr = C.gw; pr < 8 * 256; pr += C.NGW) { const int e = pr >> 8, r = pr & 255; int cnt = 0, pb = 0, np = 0;
#pragma unroll
        for (int q = 0; q < 8; ++q) if (q == e) { cnt = T.cnt[q]; pb = T.pb[q]; np = T.np[q]; }
        const int row = pb * 256 + cnt + r;
        if (row < (pb + np) * 256) { GAS v4u* d = (GAS v4u*)(XP + (size_t)row * DM + 32 * lane); const v4u z = {0u, 0u, 0u, 0u}; d[0] = z; d[1] = z; } }
    { const v4u z = {0u, 0u, 0u, 0u}; unsigned char* AP = ws + WS_ACTP;
      for (int i = C.gw * 64 + lane; i < MPERM * 8; i += C.NGW * 64) { const int rowi = i >> 3, c16 = i & 7; *(GAS v4u*)(AP + (size_t)rowi * DFFP + DFF + 16 * c16) = z; } }
}
__device__ __forceinline__ void make_grouped(unsigned char* ws, pg8::GroupedOrder& S, int nN, int G, int c) {
    int npanels = 0;
#pragma unroll
    for (int e = 0; e < 8; ++e) { const int cn = __builtin_amdgcn_readfirstlane((int)__hip_atomic_load((unsigned*)((gu32*)(ws + WS_CTL) + CW_CNT + 64 * e), RLX_AGENT)); npanels += (cn + 255) >> 8; }
    S.nM = npanels; S.nN = nN; S.nwg = npanels * nN; S.G = G; S.c = c; S.pe = (const int*)(ws + WS_MISC + MISC_PE);
}
__device__ __forceinline__ void phase17(KArgs a, const Ctx& C) {
    unsigned char* ws = a->ws; const int lane = C.lane;
    const float* H3 = (const float*)(ws + WS_H3); const bf16* YP = (const bf16*)(ws + WS_YP);
    const int* TOKS = (const int*)(ws + WS_MISC + MISC_TOKS); const float* TOKW = (const float*)(ws + WS_MISC + MISC_TOKW);
    typedef unsigned u32x2 __attribute__((ext_vector_type(2)));
    for (int row = C.gw; row < MS; row += C.NGW) {
        const int s1 = TOKS[2 * row], s2 = TOKS[2 * row + 1]; const float w1 = TOKW[2 * row], w2 = TOKW[2 * row + 1];
        const GAS f32x4* xr = (const GAS f32x4*)(H3 + (size_t)row * DM) + lane; const GAS f32x4* gr = (const GAS f32x4*)a->in[30] + lane;
        const GAS u32x2* y1 = (const GAS u32x2*)(YP + (size_t)s1 * DM) + lane; const GAS u32x2* y2 = (const GAS u32x2*)(YP + (size_t)s2 * DM) + lane;
        f32x4 v[8]; float s = 0.f;
#pragma unroll
        for (int j = 0; j < 8; ++j) { const u32x2 q1 = y1[64 * j], q2 = y2[64 * j];
            const f32x4 f1 = {__uint_as_float(q1.x << 16), __uint_as_float(q1.x & 0xffff0000u), __uint_as_float(q1.y << 16), __uint_as_float(q1.y & 0xffff0000u)};
            const f32x4 f2 = {__uint_as_float(q2.x << 16), __uint_as_float(q2.x & 0xffff0000u), __uint_as_float(q2.y << 16), __uint_as_float(q2.y & 0xffff0000u)};
            v[j] = xr[64 * j] + w1 * f1 + w2 * f2; s += (v[j].x * v[j].x + v[j].y * v[j].y) + (v[j].z * v[j].z + v[j].w * v[j].w); }
        const float rstd = 1.f / sqrtf(wave_sum(s) * (1.f / DM) + RMS_EPS);
        GAS f32x4* op = (GAS f32x4*)(a->out + (size_t)row * DM) + lane;
#pragma unroll
        for (int j = 0; j < 8; ++j) op[64 * j] = v[j] * rstd * gr[64 * j];
    }
}


__device__ __forceinline__ void phase0(KArgs a, const Ctx& C) {
    unsigned char* ws = a->ws;
    LAS float* scr = (LAS float*)(C.lds + C.wave * 16640);
    constexpr int I_SQ = 32 * 32, I_IN = 32 * 64, I_GU = 32 * 86, I_DN = 86 * 32, I_E = 2 * I_GU + I_DN;
    constexpr int NITEMS = 8 * I_E + I_IN + 2 * I_SQ + (2 * I_GU + I_DN) + I_SQ + I_IN;
    for (int it = C.gw; it < NITEMS; it += C.NGW) {
        int r = it;
        if (r < 8 * I_E) { const int e = r / I_E; int q = r - e * I_E;
            if (q < I_GU) { transpose_item_fp8<1>(a->in[27] + (size_t)e * DM * DFF, DFF, ws + WS_MGU + e * SZ_GU8, DM, 256.f, scr, q, C.lane); continue; } q -= I_GU;
            if (q < I_GU) { transpose_item_fp8<2>(a->in[28] + (size_t)e * DM * DFF, DFF, ws + WS_MGU + e * SZ_GU8, DM, 256.f, scr, q, C.lane); continue; } q -= I_GU;
            transpose_item_fp8<0>(a->in[29] + (size_t)e * DFF * DM, DM, ws + WS_MD + e * SZ_D8, DFFP, 512.f, scr, q, C.lane); continue; }
        r -= 8 * I_E;
        if (r < I_IN) { transpose_item<0>(a->in[13], DM, 4096, (bf16*)(ws + WS_WKV), scr, r, C.lane); continue; } r -= I_IN;
        if (r < I_SQ) { transpose_item<0>(a->in[15], DM, DM, (bf16*)(ws + WS_WQ), scr, r, C.lane); continue; } r -= I_SQ;
        if (r < I_SQ) { transpose_item<0>(a->in[21], DM, DM, (bf16*)(ws + WS_WO2), scr, r, C.lane); continue; } r -= I_SQ;
        if (r < I_GU) { transpose_item<1>(a->in[23], DM, DFF, (bf16*)(ws + WS_WGU), scr, r, C.lane); continue; } r -= I_GU;
        if (r < I_GU) { transpose_item<2>(a->in[24], DM, DFF, (bf16*)(ws + WS_WGU), scr, r, C.lane); continue; } r -= I_GU;
        if (r < I_DN) { transpose_item<0>(a->in[25], DFF, DM, (bf16*)(ws + WS_WD), scr, r, C.lane); continue; } r -= I_DN;
        if (r < I_SQ) { transpose_item<0>(a->in[11], DM, DM, (bf16*)(ws + WS_WOUT), scr, r, C.lane); continue; } r -= I_SQ;
        transpose_item<0>(a->in[3], DM, 4096, (bf16*)(ws + WS_WIN), scr, r, C.lane);
    }
    { bf16* wg = (bf16*)(ws + WS_WG); const float* rg = a->in[6]; const float* ig = a->in[8];
      for (int idx = C.gw * 64 + C.lane; idx < 16 * 256 * 128; idx += C.NGW * 64) { const int g = idx >> 15, jj = (idx >> 7) & 255, i = idx & 127;
          const float v = (jj < 128 ? rg : ig)[(size_t)g * 16384 + i * 128 + (jj & 127)]; wg[idx] = (bf16)f2bf(v); } }
    { const v4u zero = {0u, 0u, 0u, 0u}; for (int i = C.gw * 64 + C.lane; i < 8 * DM * 8; i += C.NGW * 64) { const int rowi = i >> 3, c16 = i & 7; *(GAS v4u*)(ws + WS_MD + (size_t)rowi * DFFP + DFF + 16 * c16) = zero; } }
    { v4u* z = (v4u*)(ws + WS_KVB + (size_t)ML * 4096 * 2); const v4u zero = {0u, 0u, 0u, 0u}; for (int i = C.gw * 64 + C.lane; i < 64 * 4096 * 2 / 16; i += C.NGW * 64) z[i] = zero; }
    { float* hb = (float*)(ws + WS_HBUF); bf16* U = (bf16*)(ws + WS_U);
      for (int row = C.gw; row < ML; row += C.NGW) { const int b = row / LSEQ, t = row - b * LSEQ;
          const float* src = t < NMETA ? a->in[1] + (size_t)t * DM : a->in[0] + ((size_t)b * SEQ + (t - NMETA)) * DM;
          rms_row(src, a->in[2], U + (size_t)row * DM, hb + (size_t)row * DM, C.lane); } }
}

__global__ void __launch_bounds__(NWAVES * 64, 2) mk_fwd(Args args) {
    extern __shared__ __attribute__((aligned(16))) unsigned char lds_raw[];
    const int wave0 = __builtin_amdgcn_readfirstlane((int)threadIdx.x >> 6); __builtin_assume(wave0 >= 0 && wave0 < NWAVES);
#define MKCTX() Ctx C; C.lds = (LAS unsigned char*)lds_raw; C.wave = wave0; C.lane = mk_lane(); C.tid = wave0 * 64 + C.lane; C.G = gridDim.x; C.gw = blockIdx.x * NWAVES + wave0; C.NGW = C.G * NWAVES
    LAS unsigned char* const lds0 = (LAS unsigned char*)lds_raw;
    volatile LAS unsigned* MISC = (volatile LAS unsigned*)(lds0 + MISC_OFF);
    gu32* ctl = (gu32*)(kargs()->ws + WS_CTL);
    for (int u = threadIdx.x; u < (LDS_BYTES - LDSCTL_OFF) / 4; u += NWAVES * 64) ((LAS unsigned*)(lds0 + LDSCTL_OFF))[u] = 0u;
    __syncthreads();
    const int lo = kargs()->ph_lo, hi = kargs()->ph_hi;
    XcdBarrier bar; bar.bar = (unsigned*)(ctl + CW_BAR); bar.x = 0; bar.st = nullptr;
    if (hi - lo > 1) bar = xcd_barrier_post((unsigned*)(ctl + CW_BAR), MISC + 8, threadIdx.x == 0);
#define IN(k) (lo <= (k) && (k) < hi)
#define SEAM(k) do { if (IN(k) && IN((k) + 1)) xcd_barrier(bar, wave0 == 0 && mk_lane() == 0); } while (0)

    if (IN(0)) { MKCTX(); phase0(kargs(), C); }
    SEAM(0);
    if (IN(1)) { MKCTX(); unsigned char* ws = kargs()->ws;
        pg8::Gemm g{ws + WS_U, ws + WS_WIN, 2 * DM, 0}; pg8::StaticOrder S; S.init(MS, 4096, C.G, (int)blockIdx.x);
        pg8::EpiBf16 E{(pg8::bf16_t*)(ws + WS_XG), 4096};
        thin_gemm<1>(C, (const bf16*)(ws + WS_U), (const bf16*)(ws + WS_WIN), DM, 4096 / 16, MS, ThinBf16{(bf16*)(ws + WS_XG), 4096});
        pg8::gemm_phase<pg8::EpiBf16, pg8::StaticOrder, true, true>(C.lds, g, S, E, C.wave);
    }
    SEAM(1);
    if (IN(2)) { MKCTX(); phase2(kargs(), C); }
    SEAM(2);
    if (IN(3)) { MKCTX(); phase3(kargs(), C); }
    SEAM(3);
    if (IN(4)) { MKCTX(); unsigned char* ws = kargs()->ws;
        thin_gemm<1>(C, (const bf16*)(ws + WS_Y), (const bf16*)(ws + WS_WOUT), DM, DM / 16, MS, ThinRes{(float*)(ws + WS_HBUF), DM});
        pg8::Gemm g{ws + WS_Y, ws + WS_WOUT, 2 * DM, 0}; pg8::StaticOrder S; S.init(MS, DM, C.G, (int)blockIdx.x);
        pg8::EpiResF32<0> E{(const float*)(ws + WS_HBUF), (float*)(ws + WS_HBUF), DM};
        pg8::gemm_phase<pg8::EpiResF32<0>, pg8::StaticOrder, true, true>(C.lds, g, S, E, C.wave);
    }
    SEAM(4);
    if (IN(5)) { MKCTX(); unsigned char* ws = kargs()->ws;
        const float* hb = (const float*)(ws + WS_HBUF); bf16* U = (bf16*)(ws + WS_U);
        for (int row = C.gw; row < ML; row += C.NGW) rms_row(hb + (size_t)row * DM, kargs()->in[22], U + (size_t)row * DM, nullptr, C.lane);
    }
    SEAM(5);
    if (IN(6)) { MKCTX(); unsigned char* ws = kargs()->ws;
        thin_gemm<2>(C, (const bf16*)(ws + WS_U), (const bf16*)(ws + WS_WGU), DM, DFF / 16, MS, ThinSwiglu{(bf16*)(ws + WS_ACT), DFF});
        pg8::Gemm g{ws + WS_U, ws + WS_WGU, 2 * DM, 0}; pg8::StaticOrder S; S.init(MS, NGU, C.G, (int)blockIdx.x);
        pg8::EpiSwiglu E{(pg8::bf16_t*)(ws + WS_ACT), DFF};
        pg8::gemm_phase<pg8::EpiSwiglu, pg8::StaticOrder, true, true>(C.lds, g, S, E, C.wave);
    }
    SEAM(6);
    if (IN(7)) { MKCTX(); unsigned char* ws = kargs()->ws;
        thin_gemm<1>(C, (const bf16*)(ws + WS_ACT), (const bf16*)(ws + WS_WD), DFF, DM / 16, MS, ThinRes{(float*)(ws + WS_HBUF), DM});
        pg8::Gemm g{ws + WS_ACT, ws + WS_WD, 2 * DFF, 0}; pg8::StaticOrder S; S.init(MS, DM, C.G, (int)blockIdx.x);
        pg8::EpiResF32<0> E{(const float*)(ws + WS_HBUF), (float*)(ws + WS_HBUF), DM};
        pg8::gemm_phase<pg8::EpiResF32<0>, pg8::StaticOrder, true, true>(C.lds, g, S, E, C.wave);
    }
    SEAM(7);
    if (IN(8)) { MKCTX(); unsigned char* ws = kargs()->ws;
        const float* hb = (const float*)(ws + WS_HBUF); bf16* U = (bf16*)(ws + WS_U); bf16* UQ = (bf16*)(ws + WS_UQ);
        for (int row = C.gw; row < ML; row += C.NGW) { const int b = row / LSEQ, t = row - b * LSEQ;
            rms_row2(hb + (size_t)row * DM, kargs()->in[12], U + (size_t)row * DM, kargs()->in[14], t >= NMETA ? UQ + ((size_t)b * SEQ + (t - NMETA)) * DM : nullptr, C.lane); }
    }
    SEAM(8);
    if (IN(9)) { MKCTX(); unsigned char* ws = kargs()->ws;
        thin_gemm<1>(C, (const bf16*)(ws + WS_U), (const bf16*)(ws + WS_WKV), DM, 4096 / 16, MS, ThinBf16{(bf16*)(ws + WS_KVB), 4096});
        { pg8::Gemm g{ws + WS_U, ws + WS_WKV, 2 * DM, 0}; pg8::StaticOrder S; S.init(MS, 4096, C.G, (int)blockIdx.x);
          pg8::EpiBf16 E{(pg8::bf16_t*)(ws + WS_KVB), 4096};
          pg8::gemm_phase<pg8::EpiBf16, pg8::StaticOrder, true, true>(C.lds, g, S, E, C.wave); }
        { pg8::Gemm g{ws + WS_UQ, ws + WS_WQ, 2 * DM, 0}; pg8::StaticOrder S; S.init(MS, DM, C.G, (int)blockIdx.x);
          pg8::EpiBf16 E{(pg8::bf16_t*)(ws + WS_QB), DM};
          pg8::gemm_phase<pg8::EpiBf16, pg8::StaticOrder, true, true>(C.lds, g, S, E, C.wave); }
    }
    SEAM(9);
    if (IN(10)) { MKCTX(); phase10(kargs(), C, (char*)lds_raw); }
    SEAM(10);
    if (IN(11)) { MKCTX(); phase11(kargs(), C); }
    SEAM(11);
    if (IN(12)) { MKCTX(); unsigned char* ws = kargs()->ws;
        pg8::Gemm g{ws + WS_ON, ws + WS_WO2, 2 * DM, 0}; pg8::StaticOrder S; S.init(MS, DM, C.G, (int)blockIdx.x);
        pg8::EpiResF32<1> E{(const float*)(ws + WS_HBUF), (float*)(ws + WS_H3), DM};
        pg8::gemm_phase<pg8::EpiResF32<1>, pg8::StaticOrder, true, true>(C.lds, g, S, E, C.wave);
    }
    SEAM(12);
    if (IN(13)) { MKCTX(); phase13(kargs(), C); }
    SEAM(13);
    if (IN(14)) { MKCTX(); phase14(kargs(), C); }
    SEAM(14);
    if (IN(15)) { MKCTX(); unsigned char* ws = kargs()->ws;
        pg8::Gemm g{ws + WS_XPERM, ws + WS_MGU, DM, SZ_GU8}; pg8::GroupedOrder S; make_grouped(ws, S, NGU / 256, C.G, (int)blockIdx.x);
        pg8::EpiSwiglu8 E{ws + WS_ACTP, DFFP};
        pg8::gemm_phase<pg8::EpiSwiglu8, pg8::GroupedOrder, true, true, true, 127, 127 - 8>(C.lds, g, S, E, C.wave);
    }
    SEAM(15);
    if (IN(16)) { MKCTX(); unsigned char* ws = kargs()->ws;
        pg8::Gemm g{ws + WS_ACTP, ws + WS_MD, DFFP, SZ_D8}; pg8::GroupedOrder S; make_grouped(ws, S, DM / 256, C.G, (int)blockIdx.x);
        pg8::EpiBf16 E{(pg8::bf16_t*)(ws + WS_YP), DM};
        pg8::gemm_phase<pg8::EpiBf16, pg8::GroupedOrder, true, true, true, 127 - 4, 127 - 9>(C.lds, g, S, E, C.wave);
    }
    SEAM(16);
    if (IN(17)) { MKCTX(); phase17(kargs(), C); }
#undef IN
#undef MKCTX
#undef SEAM
}

#ifndef MK_PER_PHASE
#define MK_PER_PHASE 0
#endif
extern "C" void kernel_launch(void* const* d_in, const int* in_sizes, int n_in, void* d_out, int out_size, void* d_ws, size_t ws_size, hipStream_t stream) {
    static int grid = 0;
    if (grid == 0) {
        if (n_in != 31 || ws_size < WS_END || out_size != MS * DM) { fprintf(stderr, "kernel_launch: unexpected n_in %d / out %d / ws %zu (need %zu)\n", n_in, out_size, ws_size, (size_t)WS_END); grid = -1; return; }
        int dev = 0, cus = 0, per_cu = 0;
        if (hipGetDevice(&dev) != hipSuccess || hipDeviceGetAttribute(&cus, hipDeviceAttributeMultiprocessorCount, dev) != hipSuccess) { grid = -1; return; }
        if (hipFuncSetAttribute((const void*)mk_fwd, hipFuncAttributeMaxDynamicSharedMemorySize, LDS_BYTES) != hipSuccess) { fprintf(stderr, "kernel_launch: hipFuncSetAttribute failed\n"); grid = -1; return; }
        if (hipOccupancyMaxActiveBlocksPerMultiprocessor(&per_cu, (const void*)mk_fwd, NWAVES * 64, LDS_BYTES) != hipSuccess || per_cu < 1) fprintf(stderr, "kernel_launch: occupancy query says %d\n", per_cu);
        (void)hipGetLastError();
        grid = cus;
    }
    if (grid < 0) return;
    (void)hipMemsetAsync((char*)d_ws + WS_CTL, 0, CTL_ZERO_BYTES, stream);
    Args a{};
    for (int i = 0; i < 31; ++i) a.in[i] = (const float*)d_in[i];
    a.out = (float*)d_out; a.ws = (unsigned char*)d_ws;
    if (MK_PER_PHASE) { for (int p = 0; p < NPHASE; ++p) { a.ph_lo = p; a.ph_hi = p + 1; hipLaunchKernelGGL(mk_fwd, dim3(grid), dim3(NWAVES * 64), LDS_BYTES, stream, a); } }
    else { a.ph_lo = 0; a.ph_hi = NPHASE; hipLaunchKernelGGL(mk_fwd, dim3(grid), dim3(NWAVES * 64), LDS_BYTES, stream, a); }
#ifdef PROBE_PHASES
    { const int pl[] = {PROBE_PHASES}; for (int p : pl) { a.ph_lo = p; a.ph_hi = p + 1; hipLaunchKernelGGL(mk_fwd, dim3(grid), dim3(NWAVES * 64), LDS_BYTES, stream, a); } }
#endif
}
```

```cpp
#include <hip/hip_runtime.h>
#include <cstdio>
#include <cstdint>
__device__ __forceinline__ int mk_lane() { int l; asm volatile("v_mbcnt_lo_u32_b32 %0, -1, 0\n\tv_mbcnt_hi_u32_b32 %0, -1, %0" : "=v"(l)); return l & 63; }

namespace pg8 {
#define PG8_LAS __attribute__((address_space(3)))
typedef unsigned short bf16_t;
typedef short bf16x8 __attribute__((ext_vector_type(8)));
typedef float f32x4 __attribute__((ext_vector_type(4)));
typedef unsigned u32x4 __attribute__((ext_vector_type(4)));
constexpr int BM = 256, BK = 64, HALF = 128, HTB = HALF * BK * 2  , STAGE_BYTES = 8 * HTB, NXCD = 8, WGM = 8;

__host__ __device__ __forceinline__ int lds_byte(int r, int c) { const int st = (r >> 4) * 2 + (c >> 5), rr = r & 15, cc = c & 31, ob = rr * 64 + cc * 2; return st * 1024 + (ob ^ (((ob >> 9) & 1) << 5)); }
__host__ __device__ __forceinline__ void stage_rc(int b, int& R, int& C) { const int st = b / 1024, sb = b % 1024, swz = sb ^ (((sb >> 9) & 1) << 5); R = (st >> 1) * 16 + swz / 64; C = (st & 1) * 32 + (swz % 64) / 2; }
__host__ __device__ __forceinline__ int perm32(int rho) { const int n = rho >> 4, i = rho & 15; return 8 * (i >> 2) + 4 * n + (i & 3); }

struct Unit { int pm, pn, e; };
struct Gemm { const void* A; const void* Bt; int KB; size_t estride; };
typedef int i32x4 __attribute__((ext_vector_type(4)));
typedef int i32x8 __attribute__((ext_vector_type(8)));

struct StaticOrder {
    int nM, nN, nwg, G, c;
    __host__ __device__ void init(int M, int N, int G_, int c_) { nM = M / BM; nN = N / BM; nwg = nM * nN; G = G_; c = c_; }
    __host__ __device__ bool next(int i, Unit& u) const {
        const long L = (long)i * G + c; if (L >= nwg) return false;
        int wgid = (int)L; { const int q = nwg / NXCD, r = nwg % NXCD, xcd = wgid % NXCD, off = wgid / NXCD; wgid = (xcd < r ? xcd * (q + 1) : r * (q + 1) + (xcd - r) * q) + off; }
        const int nig = WGM * nN, gid = wgid / nig, fm = gid * WGM, gsz = (nM - fm) < WGM ? (nM - fm) : WGM;
        u.pm = fm + ((wgid % nig) % gsz); u.pn = (wgid % nig) / gsz; u.e = 0; return true;
    }
    __device__ __forceinline__ void a_ready(const Unit&) const {}
    __device__ __forceinline__ void done(const Unit&) const {}
};
struct GroupedOrder {
    int nM, nN, nwg, G, c; const int* pe;
    __device__ __forceinline__ bool next(int i, Unit& u) const {
        const long L = (long)i * G + c; if (L >= nwg) return false;
        int wgid = (int)L; { const int q = nwg / NXCD, r = nwg % NXCD, xcd = wgid % NXCD, off = wgid / NXCD; wgid = (xcd < r ? xcd * (q + 1) : r * (q + 1) + (xcd - r) * q) + off; }
        const int nig = WGM * nN, gid = wgid / nig, fm = gid * WGM, gsz = (nM - fm) < WGM ? (nM - fm) : WGM;
        u.pm = fm + ((wgid % nig) % gsz); u.pn = (wgid % nig) / gsz; u.e = __builtin_amdgcn_readfirstlane(pe[u.pm]); return true;
    }
    __device__ __forceinline__ void a_ready(const Unit&) const {}
    __device__ __forceinline__ void done(const Unit&) const {}
};

__device__ __forceinline__ unsigned cvt_pk_bf16(float lo, float hi) { unsigned r; asm volatile("v_cvt_pk_bf16_f32 %0, %1, %2" : "=v"(r) : "v"(lo), "v"(hi)); return r; }
typedef float f32x2 __attribute__((ext_vector_type(2)));

struct EpiBf16 {
    static constexpr bool PERM = true, AFTER_DRAIN = false;
    bf16_t* O; int ldc;
    __device__ __forceinline__ void operator()(const f32x4 (&acc)[2][2][4][2], const Unit& u, int wr, int wc, int fr, int fq) const {
        const int row0 = u.pm * BM + wr * 64 + fr; const int col0 = u.pn * BM + wc * 32 + 8 * fq;
#pragma unroll
        for (int ai = 0; ai < 2; ++ai)
#pragma unroll
            for (int m = 0; m < 4; ++m) { bf16_t* rowp = O + (size_t)(row0 + ai * HALF + m * 16) * ldc + col0;
#pragma unroll
                for (int bj = 0; bj < 2; ++bj) { const f32x4 v0 = acc[ai][bj][m][0], v1 = acc[ai][bj][m][1];
                    u32x4 w; w.x = cvt_pk_bf16(v0[0], v0[1]); w.y = cvt_pk_bf16(v0[2], v0[3]); w.z = cvt_pk_bf16(v1[0], v1[1]); w.w = cvt_pk_bf16(v1[2], v1[3]);
                    *(u32x4*)(rowp + bj * HALF) = w; } }
    }
};
struct EpiSwiglu {
    static constexpr bool PERM = true, AFTER_DRAIN = false;
    bf16_t* O; int ldc;
    __device__ __forceinline__ void operator()(const f32x4 (&acc)[2][2][4][2], const Unit& u, int wr, int wc, int fr, int fq) const {
        const int row0 = u.pm * BM + wr * 64 + fr; const int col0 = u.pn * HALF + wc * 32 + 8 * fq;
#pragma unroll
        for (int ai = 0; ai < 2; ++ai)
#pragma unroll
            for (int m = 0; m < 4; ++m) { bf16_t* rowp = O + (size_t)(row0 + ai * HALF + m * 16) * ldc + col0;
                float r[8];
#pragma unroll
                for (int n = 0; n < 2; ++n)
#pragma unroll
                    for (int j = 0; j < 4; ++j) { const float g = acc[ai][0][m][n][j], up = acc[ai][1][m][n][j];
                        r[n * 4 + j] = g * __builtin_amdgcn_rcpf(1.0f + __builtin_amdgcn_exp2f(-1.4426950408889634f * g)) * up; }
                u32x4 w; w.x = cvt_pk_bf16(r[0], r[1]); w.y = cvt_pk_bf16(r[2], r[3]); w.z = cvt_pk_bf16(r[4], r[5]); w.w = cvt_pk_bf16(r[6], r[7]);
                *(u32x4*)rowp = w; }
    }
};
struct EpiSwiglu8 {
    static constexpr bool PERM = true, AFTER_DRAIN = false;
    unsigned char* O; int ldc;
    __device__ __forceinline__ void operator()(const f32x4 (&acc)[2][2][4][2], const Unit& u, int wr, int wc, int fr, int fq) const {
        const int row0 = u.pm * BM + wr * 64 + fr; const int col0 = u.pn * HALF + wc * 32 + 8 * fq;
        typedef unsigned u32x2 __attribute__((ext_vector_type(2)));
#pragma unroll
        for (int ai = 0; ai < 2; ++ai)
#pragma unroll
            for (int m = 0; m < 4; ++m) { unsigned char* rowp = O + (size_t)(row0 + ai * HALF + m * 16) * ldc + col0;
                float r[8];
#pragma unroll
                for (int n = 0; n < 2; ++n)
#pragma unroll
                    for (int j = 0; j < 4; ++j) { const float g = acc[ai][0][m][n][j], up = acc[ai][1][m][n][j];
                        r[n * 4 + j] = __builtin_amdgcn_fmed3f(16.0f * g * __builtin_amdgcn_rcpf(1.0f + __builtin_amdgcn_exp2f(-1.4426950408889634f * g)) * up, -448.f, 448.f); }
                u32x2 w; int t = __builtin_amdgcn_cvt_pk_fp8_f32(r[0], r[1], 0, false); t = __builtin_amdgcn_cvt_pk_fp8_f32(r[2], r[3], t, true); w.x = (unsigned)t;
                t = __builtin_amdgcn_cvt_pk_fp8_f32(r[4], r[5], 0, false); t = __builtin_amdgcn_cvt_pk_fp8_f32(r[6], r[7], t, true); w.y = (unsigned)t;
                *(u32x2*)rowp = w; }
    }
};
template <int MAP> struct EpiResF32 {
    static constexpr bool PERM = false, AFTER_DRAIN = false;
    const float* base; float* out; int ldc;
    __device__ __forceinline__ void operator()(const f32x4 (&acc)[2][2][4][2], const Unit& u, int wr, int wc, int fr, int fq) const {
        const int row0 = u.pm * BM + wr * 64 + fr, col0 = u.pn * BM + wc * 32 + 4 * fq;
#pragma unroll
        for (int ai = 0; ai < 2; ++ai)
#pragma unroll
            for (int m = 0; m < 4; ++m) { const int r = row0 + ai * HALF + m * 16; const int br = MAP == 1 ? r + 16 * ((r >> 11) + 1) : r;
                const float* bp = base + (size_t)br * ldc + col0; float* op = out + (size_t)r * ldc + col0;
#pragma unroll
                for (int bj = 0; bj < 2; ++bj)
#pragma unroll
                    for (int n = 0; n < 2; ++n) { const f32x4 b = *(const f32x4*)(bp + bj * HALF + n * 16); *(f32x4*)(op + bj * HALF + n * 16) = b + acc[ai][bj][m][n]; } }
    }
};

template <class Epi, class Sched, bool ALIGN_EPI = false, bool SP2 = false, bool FP8 = false, int SCA = 127, int SCB = 127>
__device__ __forceinline__ void gemm_phase(PG8_LAS unsigned char* lds, const Gemm g, const Sched& S, const Epi& E, const int wid) {
    __builtin_assume(wid >= 0 && wid < 8); const int lane = mk_lane(), tid = wid * 64 + lane, wr = wid >> 2, wc = wid & 3, fr = lane & 15, fq = lane >> 4;
    const int KB = g.KB, nt = KB / (BK * 2);
    unsigned voffA[2], voffB[2];
#pragma unroll
    for (int i = 0; i < 2; ++i) { int R, C; stage_rc(tid * 16 + i * 8192, R, C); const int Rb = Epi::PERM ? ((R & ~31) + perm32(R & 31)) : R;
        voffA[i] = (unsigned)(R * KB + C * 2); voffB[i] = (unsigned)(Rb * KB + C * 2); }
    const unsigned rstep64 = 64u * (unsigned)KB;
    const unsigned kstep = BK * 2;
    const unsigned hstep = (unsigned)HALF * (unsigned)KB;
    const unsigned tstep = 2 * hstep;
    const unsigned ldsw = (unsigned)wid * 1024u;
    const int aoff = lds_byte(wr * 64 + fr, fq * 8), boff = lds_byte(wc * 32 + fr, fq * 8);
#define PG8_SA(b, h) (((b) * 2 + (h)) * HTB)
#define PG8_SB(b, h) ((4 + (b) * 2 + (h)) * HTB)
    const __amdgpu_buffer_rsrc_t rs_voffA = __builtin_amdgcn_make_buffer_rsrc((void*)g.A, (short)0, 0x7fffffff, 0x00020000), rs_voffB = __builtin_amdgcn_make_buffer_rsrc((void*)g.Bt, (short)0, 0x7fffffff, 0x00020000);
#define PG8_STAGE(bufoff, soff, voff) do { _Pragma("unroll") for (int _i = 0; _i < 2; ++_i) \
        __builtin_amdgcn_raw_ptr_buffer_load_lds(rs_##voff, (PG8_LAS unsigned*)(lds + (bufoff) + ldsw + _i * 8192), 16, (voff)[0], (int)((soff) + (unsigned)_i * rstep64), 0, 0); } while (0)
#define PG8_LDA(dst, b, h) do { _Pragma("unroll") for (int m = 0; m < 4; ++m) _Pragma("unroll") for (int k = 0; k < 2; ++k) dst[m][k] = *(const PG8_LAS bf16x8*)(lds + PG8_SA(b, h) + aoff + m * 2048 + k * 1024); } while (0)
#define PG8_LDB(dst, b, h) do { _Pragma("unroll") for (int n = 0; n < 2; ++n) _Pragma("unroll") for (int k = 0; k < 2; ++k) dst[n][k] = *(const PG8_LAS bf16x8*)(lds + PG8_SB(b, h) + boff + n * 2048 + k * 1024); } while (0)
#define PG8_CAT(x, y) __builtin_shufflevector(__builtin_bit_cast(i32x4, x), __builtin_bit_cast(i32x4, y), 0, 1, 2, 3, 4, 5, 6, 7)
#define PG8_MMA(ai, bj, At, Bt) do { __builtin_amdgcn_s_setprio(1); if constexpr (FP8) { _Pragma("unroll") for (int m = 0; m < 4; ++m) _Pragma("unroll") for (int n = 0; n < 2; ++n) \
        acc[ai][bj][m][n] = __builtin_amdgcn_mfma_scale_f32_16x16x128_f8f6f4(PG8_CAT(Bt[n][0], Bt[n][1]), PG8_CAT(At[m][0], At[m][1]), acc[ai][bj][m][n], 0, 0, 0, SCB, 0, SCA); } \
        else { _Pragma("unroll") for (int m = 0; m < 4; ++m) _Pragma("unroll") for (int n = 0; n < 2; ++n) _Pragma("unroll") for (int k = 0; k < 2; ++k) \
        acc[ai][bj][m][n] = __builtin_amdgcn_mfma_f32_16x16x32_bf16(Bt[n][k], At[m][k], acc[ai][bj][m][n], 0, 0, 0); } __builtin_amdgcn_s_setprio(0); } while (0)
#define PG8_WAIT_V(n) asm volatile("s_waitcnt vmcnt(" #n ")" ::: "memory")
#define PG8_WAIT_L(n) asm volatile("s_waitcnt lgkmcnt(" #n ")" ::: "memory")
#define PG8_BAR __builtin_amdgcn_s_barrier()
#define PG8_SCHED __builtin_amdgcn_sched_barrier(0)
    Unit cur, nxt; int ui = 0;
    if (!S.next(0, cur)) return;
    f32x4 acc[2][2][4][2];
#pragma unroll
    for (int a = 0; a < 2; ++a)
#pragma unroll
        for (int b = 0; b < 2; ++b)
#pragma unroll
            for (int m = 0; m < 4; ++m)
#pragma unroll
                for (int n = 0; n < 2; ++n) acc[a][b][m][n] = (f32x4){0.f, 0.f, 0.f, 0.f};
    bf16x8 At[4][2], B0[2][2], B1[2][2];
    unsigned cA = (unsigned)cur.pm * tstep, cB = (unsigned)cur.e * (unsigned)g.estride + (unsigned)cur.pn * tstep;
    S.a_ready(cur);
    if constexpr (SP2) {
        PG8_STAGE(PG8_SB(0, 0), cB, voffB); PG8_STAGE(PG8_SB(0, 1), cB + hstep, voffB); PG8_STAGE(PG8_SA(0, 0), cA, voffA); PG8_STAGE(PG8_SA(0, 1), cA + hstep, voffA);
        if (wr == 1) PG8_BAR;
        PG8_WAIT_V(2); PG8_BAR;
        PG8_STAGE(PG8_SB(1, 0), cB + kstep, voffB); PG8_STAGE(PG8_SA(1, 0), cA + kstep, voffA); PG8_STAGE(PG8_SB(1, 1), cB + hstep + kstep, voffB);
        PG8_WAIT_V(6); PG8_BAR;
    } else {
        PG8_STAGE(PG8_SB(0, 0), cB, voffB); PG8_STAGE(PG8_SA(0, 0), cA, voffA); PG8_STAGE(PG8_SB(0, 1), cB + hstep, voffB); PG8_STAGE(PG8_SA(0, 1), cA + hstep, voffA);
        if (wr == 1) PG8_BAR;
        PG8_WAIT_V(4); PG8_BAR;
        PG8_STAGE(PG8_SB(1, 0), cB + kstep, voffB); PG8_STAGE(PG8_SA(1, 0), cA + kstep, voffA); PG8_STAGE(PG8_SB(1, 1), cB + hstep + kstep, voffB);
        PG8_WAIT_V(6); PG8_BAR;
    }
    for (;;) {
        const bool has_next = S.next(ui + 1, nxt);
        const unsigned nA = has_next ? (unsigned)nxt.pm * tstep : cA, nB = has_next ? (unsigned)nxt.e * (unsigned)g.estride + (unsigned)nxt.pn * tstep : cB;
        for (int t = 0; t < nt; t += 2) {
            const bool last = (t == nt - 2);
            const unsigned a1 = cA + (unsigned)(t + 1) * kstep;
            const unsigned a2 = last ? nA : cA + (unsigned)(t + 2) * kstep, b2 = last ? nB : cB + (unsigned)(t + 2) * kstep;
            const unsigned a3 = a2 + kstep, b3 = b2 + kstep;
            if (last && has_next) S.a_ready(nxt);
            if constexpr (SP2) {
            PG8_LDB(B0, 0, 0); PG8_LDB(B1, 0, 1); PG8_SCHED; PG8_LDA(At, 0, 0); PG8_STAGE(PG8_SA(1, 1), a1 + hstep, voffA);
            PG8_WAIT_V(8); PG8_WAIT_L(0); PG8_BAR; PG8_MMA(0, 0, At, B0); PG8_MMA(0, 1, At, B1); PG8_BAR; PG8_SCHED;
            PG8_LDA(At, 0, 1); PG8_STAGE(PG8_SB(0, 0), b2, voffB); PG8_STAGE(PG8_SB(0, 1), b2 + hstep, voffB); PG8_STAGE(PG8_SA(0, 0), a2, voffA);
            PG8_WAIT_V(8); PG8_WAIT_L(0); PG8_BAR; PG8_MMA(1, 0, At, B0); PG8_MMA(1, 1, At, B1); PG8_BAR; PG8_SCHED;
            PG8_LDB(B0, 1, 0); PG8_LDB(B1, 1, 1); PG8_SCHED; PG8_LDA(At, 1, 0); PG8_STAGE(PG8_SA(0, 1), a2 + hstep, voffA);
            PG8_WAIT_V(8); PG8_WAIT_L(0); PG8_BAR; PG8_MMA(0, 0, At, B0); PG8_MMA(0, 1, At, B1); PG8_BAR; PG8_SCHED;
            PG8_LDA(At, 1, 1); PG8_STAGE(PG8_SB(1, 0), b3, voffB); PG8_STAGE(PG8_SB(1, 1), b3 + hstep, voffB); PG8_STAGE(PG8_SA(1, 0), a3, voffA);
            PG8_WAIT_V(8); PG8_WAIT_L(0); PG8_BAR; PG8_MMA(1, 0, At, B0); PG8_MMA(1, 1, At, B1); PG8_BAR; PG8_SCHED;
            } else {
            PG8_LDB(B0, 0, 0); PG8_SCHED; PG8_LDA(At, 0, 0); PG8_STAGE(PG8_SA(1, 1), a1 + hstep, voffA);
            PG8_WAIT_L(8); PG8_BAR; PG8_WAIT_L(0); PG8_MMA(0, 0, At, B0); PG8_BAR; PG8_SCHED;
            PG8_LDB(B1, 0, 1); PG8_STAGE(PG8_SB(0, 0), b2, voffB);
            PG8_BAR; PG8_WAIT_L(0); PG8_MMA(0, 1, At, B1); PG8_BAR;
            PG8_LDA(At, 0, 1); PG8_STAGE(PG8_SA(0, 0), a2, voffA);
            PG8_BAR; PG8_WAIT_L(0); PG8_MMA(1, 0, At, B0); PG8_BAR; PG8_SCHED;
            PG8_STAGE(PG8_SB(0, 1), b2 + hstep, voffB);
            PG8_WAIT_V(6); PG8_BAR; PG8_MMA(1, 1, At, B1); PG8_BAR;
            PG8_LDB(B0, 1, 0); PG8_SCHED; PG8_LDA(At, 1, 0); PG8_STAGE(PG8_SA(0, 1), a2 + hstep, voffA);
            PG8_WAIT_L(8); PG8_BAR; PG8_WAIT_L(0); PG8_MMA(0, 0, At, B0); PG8_BAR; PG8_SCHED;
            PG8_LDB(B1, 1, 1); PG8_STAGE(PG8_SB(1, 0), b3, voffB);
            PG8_BAR; PG8_WAIT_L(0); PG8_MMA(0, 1, At, B1); PG8_BAR;
            PG8_LDA(At, 1, 1); PG8_STAGE(PG8_SA(1, 0), a3, voffA);
            PG8_BAR; PG8_WAIT_L(0); PG8_MMA(1, 0, At, B0); PG8_BAR; PG8_SCHED;
            PG8_STAGE(PG8_SB(1, 1), b3 + hstep, voffB);
            PG8_WAIT_V(6); PG8_BAR; PG8_MMA(1, 1, At, B1); PG8_BAR;
            }
        }
        if constexpr (ALIGN_EPI) { if (wr == 0) PG8_BAR; }
        if constexpr (!Epi::AFTER_DRAIN) { E(acc, cur, wr, wc, fr, fq); S.done(cur); }
        if (!has_next) break;
#pragma unroll
        for (int a = 0; a < 2; ++a)
#pragma unroll
            for (int b = 0; b < 2; ++b)
#pragma unroll
                for (int m = 0; m < 4; ++m)
#pragma unroll
                    for (int n = 0; n < 2; ++n) acc[a][b][m][n] = (f32x4){0.f, 0.f, 0.f, 0.f};
        cur = nxt; cA = nA; cB = nB; ++ui;
        if constexpr (ALIGN_EPI) { if (wr == 1) PG8_BAR; }
    }
    PG8_WAIT_V(0);
    if constexpr (!ALIGN_EPI) { if (wr == 0) PG8_BAR; }
    PG8_BAR;
    if constexpr (Epi::AFTER_DRAIN) { E.fused(acc, cur, wr, wc, fr, fq, lds, wid, lane); S.done(cur); }
#undef PG8_SA
#undef PG8_SB
#undef PG8_STAGE
#undef PG8_LDA
#undef PG8_LDB
#undef PG8_MMA
#undef PG8_CAT
#undef PG8_WAIT_V
#undef PG8_WAIT_L
#undef PG8_BAR
#undef PG8_SCHED
}
}
#define GAS __attribute__((address_space(1)))
#define LAS __attribute__((address_space(3)))
typedef unsigned short bf16;
typedef unsigned v4u __attribute__((ext_vector_type(4)));
typedef float f32x4 __attribute__((ext_vector_type(4)));
typedef short bf16x8 __attribute__((ext_vector_type(8)));
typedef GAS unsigned gu32;
typedef GAS unsigned long long gu64;
#define RLX_AGENT __ATOMIC_RELAXED, __HIP_MEMORY_SCOPE_AGENT
#define LDS_WAIT() asm volatile("s_waitcnt lgkmcnt(0)" ::: "memory")
#define VM_WAIT() asm volatile("s_waitcnt vmcnt(0)" ::: "memory")
__device__ __forceinline__ unsigned long long rt() { return __builtin_amdgcn_s_memrealtime(); }
__device__ __forceinline__ unsigned f2bf(float f) { unsigned u = __builtin_bit_cast(unsigned, f); return (u + 0x7fffu + ((u >> 16) & 1u)) >> 16; }
__device__ __forceinline__ unsigned pk2(float lo, float hi) { return f2bf(lo) | (f2bf(hi) << 16); }

#define XB_TMO      128
#define XB_XCNT(j)  (256  + 64 * (j))
#define XB_XSUB(j)  (1280 + 64 * (j))
#define XB_XGEN(j)  (2304 + 64 * (j))
#define XB_TOP      3328
#define XB_TOPGEN   3392
#define XCD_BAR_WORDS 3456
#define XB_SPIN_CAP (1u << 22)

__device__ __forceinline__ unsigned xb_ld(unsigned* p)              { return __hip_atomic_load(p, __ATOMIC_RELAXED, __HIP_MEMORY_SCOPE_AGENT); }
__device__ __forceinline__ unsigned xb_add(unsigned* p, unsigned v) { return __hip_atomic_fetch_add(p, v, __ATOMIC_RELAXED, __HIP_MEMORY_SCOPE_AGENT); }
__device__ __forceinline__ unsigned xb_xcc_id() { return (unsigned)__builtin_amdgcn_s_getreg((3 << 11) | 20) & 0xFu; }
#define XB_SPIN(cond, bar) do { unsigned _sp = 0; while (cond) { __builtin_amdgcn_s_sleep(1); \
    if ((++_sp & 255u) == 0u) { if (xb_ld(&(bar)[XB_TMO])) break; if (_sp > XB_SPIN_CAP) { atomicAdd(&(bar)[XB_TMO], 1u); break; } } } } while (0)

struct XcdBarrier {
    unsigned* bar; unsigned x;
    volatile LAS unsigned* st;
};

__device__ __forceinline__ XcdBarrier xcd_barrier_post(unsigned* bar, volatile LAS unsigned* st, const bool thread0) {
    XcdBarrier b; b.bar = bar; b.x = xb_xcc_id(); b.st = st;
    if (thread0) (void)xb_add(&bar[XB_XCNT(b.x)], 1u);
    return b;
}
__device__ __forceinline__ void xcd_barrier_complete(unsigned* bar, unsigned x, unsigned& nloc, unsigned& nx) {
    const unsigned G = gridDim.x * gridDim.y * gridDim.z;
    unsigned sum, cnt, mine, sp = 0u;
    for (;;) {
        sum = 0u; cnt = 0u; mine = 0u;
#pragma unroll
        for (unsigned j = 0; j < 16; ++j) { const unsigned c = xb_ld(&bar[XB_XCNT(j)]); sum += c; cnt += (c > 0u) ? 1u : 0u; mine = (j == x) ? c : mine; }
        if (sum == G) break;
        __builtin_amdgcn_s_sleep(1);
        if ((++sp & 255u) == 0u) { if (xb_ld(&bar[XB_TMO])) break; if (sp > XB_SPIN_CAP) { atomicAdd(&bar[XB_TMO], 1u); break; } }
    }
    nloc = mine > 0u ? mine : 1u; nx = cnt > 0u ? cnt : 1u;
}

__device__ __forceinline__ void xcd_barrier(const XcdBarrier& b, const bool thread0) {
    asm volatile("s_waitcnt vmcnt(0)" ::: "memory");
    __syncthreads();
    if (thread0) {
        unsigned* bar = b.bar;
        __builtin_amdgcn_s_waitcnt(0);
        unsigned nloc = b.st[0], nx = b.st[1];
        if (nloc == 0u) { xcd_barrier_complete(bar, b.x, nloc, nx); b.st[0] = nloc; b.st[1] = nx; }
        const unsigned old = xb_add(&bar[XB_XSUB(b.x)], 1u);
        const unsigned gen = old / nloc;
        if (old + 1u == (gen + 1u) * nloc) {
            __builtin_amdgcn_fence(__ATOMIC_RELEASE, "agent");
            asm volatile("s_waitcnt vmcnt(0)" ::: "memory");
            const unsigned og = xb_add(&bar[XB_TOP], 1u);
            const unsigned tg = og / nx;
            if (og + 1u == (tg + 1u) * nx) xb_add(&bar[XB_TOPGEN], 1u);
            else XB_SPIN(xb_ld(&bar[XB_TOPGEN]) == tg, bar);
            __builtin_amdgcn_fence(__ATOMIC_ACQUIRE, "agent");
            xb_add(&bar[XB_XGEN(b.x)], 1u);
            asm volatile("s_waitcnt vmcnt(0)" ::: "memory");
        } else {
            XB_SPIN(xb_ld(&bar[XB_XGEN(b.x)]) == gen, bar);
            __builtin_amdgcn_fence(__ATOMIC_ACQUIRE, "agent");
            asm volatile("s_waitcnt vmcnt(0)" ::: "memory");
        }
    }
    __syncthreads();
}


constexpr int NB = 4, SEQ = 2048, DM = 2048, NMETA = 16, LSEQ = SEQ + NMETA, DFF = 5504, NH = 8, HDIM = 128, VDIM = 256, NEXP = 8;
constexpr int ML = NB * LSEQ;
constexpr int MLP = 8448;
constexpr int MS = NB * SEQ;
constexpr int NGU = 2 * DFF;
constexpr int MPERM = 18432;
constexpr float RMS_EPS = 1e-6f;
constexpr int NWAVES = 8;

constexpr size_t MiB = 1u << 20;
constexpr size_t WS_CTL = 0, CTL_ZERO_BYTES = 1 * MiB;
constexpr size_t WS_WKV = 1 * MiB;
constexpr size_t WS_WQ = WS_WKV + 16 * MiB;
constexpr size_t WS_WO2 = WS_WQ + 8 * MiB;
constexpr int DFFP = 5632;
constexpr size_t WS_MGU = WS_WO2 + 8 * MiB;
constexpr size_t SZ_GU = (size_t)NGU * DM * 2;
constexpr size_t SZ_GU8 = (size_t)NGU * DM;
constexpr size_t WS_MD = WS_MGU + 8 * SZ_GU8;
constexpr size_t SZ_D = (size_t)DM * DFF * 2;
constexpr size_t SZ_D8 = (size_t)DM * DFFP;
constexpr size_t WS_HBUF = WS_MD + 8 * SZ_D8;
constexpr size_t WS_KVB = WS_HBUF + (size_t)MLP * DM * 4;
constexpr size_t WS_UQ = WS_KVB + (size_t)MLP * 4096 * 2;
constexpr size_t WS_QB = WS_UQ + (size_t)MS * DM * 2;
constexpr size_t WS_OB = WS_QB + (size_t)MS * DM * 2;
constexpr size_t WS_ON = WS_UQ;
constexpr size_t WS_H3 = WS_OB + (size_t)2 * MS * DM * 4;
constexpr size_t WS_UM = WS_QB;
constexpr size_t WS_MISC = WS_H3 + (size_t)MS * DM * 4;
constexpr size_t WS_R0 = WS_MISC + 4 * MiB;
constexpr size_t WS_WIN = WS_R0;
constexpr size_t WS_WG = WS_WIN + 16 * MiB;
constexpr size_t WS_WOUT = WS_WG + 1 * MiB;
constexpr size_t WS_WGU = WS_WOUT + 8 * MiB;
constexpr size_t WS_WD = WS_WGU + SZ_GU;
constexpr size_t WS_U = WS_WD + SZ_D;
constexpr size_t WS_XG = WS_U + (size_t)MLP * DM * 2;
constexpr size_t WS_HSL = WS_XG + (size_t)MLP * 4096 * 2;
constexpr size_t WS_PC = WS_HSL + (size_t)MLP * DM * 2;
constexpr size_t WS_CSUM = WS_PC + (size_t)MLP * DM * 2;
constexpr size_t WS_Y = WS_CSUM + 3 * MiB;
constexpr size_t WS_ACT = WS_Y + (size_t)MLP * DM * 2;
constexpr size_t WS_U8 = WS_ACT + (size_t)MLP * DFFP;
constexpr size_t WS_R0_L0END = WS_ACT + (size_t)MLP * DFF * 2;
static_assert(WS_U8 + (size_t)MLP * DM <= WS_R0_L0END, "U8 inside the old ACT region");
constexpr size_t WS_XPERM = WS_R0;
constexpr size_t WS_ACTP = WS_XPERM + (size_t)MPERM * DM;
constexpr size_t WS_YP = WS_ACTP + (size_t)MPERM * DFFP;
constexpr size_t WS_R0_MOEEND = WS_YP + (size_t)MPERM * DM * 2;
constexpr size_t WS_END = WS_R0_L0END > WS_R0_MOEEND ? WS_R0_L0END : WS_R0_MOEEND;
static_assert(WS_END <= (size_t)1442840576, "d_ws map exceeds the guaranteed workspace");
constexpr int CW_BAR = 4096;
constexpr int CW_CNT = 16384;
constexpr int CW_CUR = 16384 + 1024;

constexpr int SCR_BYTES = 133120;
constexpr int LDSCTL_OFF = SCR_BYTES, MISC_OFF = LDSCTL_OFF + 320;
constexpr int LDS_BYTES = 147456;
static_assert(MISC_OFF + 128 <= LDS_BYTES, "LDS map");

constexpr int NPHASE = 18;
struct Args { const float* in[31]; float* out; unsigned char* ws; int ph_lo, ph_hi; };
static_assert(sizeof(Args) == 33 * 8 + 8, "Args has no padding");
typedef const __attribute__((address_space(4))) Args* KArgs;
__device__ __forceinline__ KArgs kargs() { KArgs p = (KArgs)__builtin_amdgcn_kernarg_segment_ptr(); asm volatile("" : "+s"(p)); return p; }
#define LDS_BARRIER() do { asm volatile("s_waitcnt lgkmcnt(0)" ::: "memory"); __builtin_amdgcn_s_barrier(); asm volatile("" ::: "memory"); } while (0)
struct Ctx { LAS unsigned char* lds; int tid, lane, wave, G, gw, NGW; };

__device__ __forceinline__ float wave_sum(float v) {
#pragma unroll
    for (int o = 1; o < 64; o <<= 1) v += __shfl_xor(v, o);
    return v;
}
typedef unsigned long long u64;

template <int MODE>
__device__ __forceinline__ void transpose_item(const float* __restrict__ W, int K, int N, bf16* __restrict__ WT, LAS float* scr, int item, int lane) {
    const int nblk = N / 64, kb = item / nblk, nb = item % nblk, k0 = 64 * kb, n0 = 64 * nb;
    const float* src = W + (size_t)k0 * N + n0 + lane;
    { float t[64];
#pragma unroll
      for (int i = 0; i < 64; ++i) t[i] = __builtin_nontemporal_load(src + (size_t)i * N);
#pragma unroll
      for (int i = 0; i < 64; ++i) scr[i * 65 + lane] = t[i]; }
    LDS_WAIT(); asm volatile("" ::: "memory");
    const int c = lane & 7, nl = lane >> 3;
    const int drow0 = MODE == 0 ? n0 : ((n0 >> 7) * 256 + (n0 & 127) + (MODE == 2 ? 128 : 0));
#pragma unroll
    for (int j = 0; j < 8; ++j) { const int n = nl + 8 * j; const LAS float* s = scr + (8 * c) * 65 + n;
        v4u o; o.x = pk2(s[0 * 65], s[1 * 65]); o.y = pk2(s[2 * 65], s[3 * 65]); o.z = pk2(s[4 * 65], s[5 * 65]); o.w = pk2(s[6 * 65], s[7 * 65]);
        *(GAS v4u*)(WT + (size_t)(drow0 + n) * K + k0 + 8 * c) = o; }
    LDS_WAIT(); asm volatile("" ::: "memory");
}
__device__ __forceinline__ void rms_row(const float* xrow, const float* __restrict__ g, bf16* orow, float* hcopy, int lane) {
    const GAS f32x4* xr = (const GAS f32x4*)xrow + lane; const GAS f32x4* gr = (const GAS f32x4*)g + lane;
    f32x4 v[8]; float s = 0.f;
#pragma unroll
    for (int j = 0; j < 8; ++j) { v[j] = xr[64 * j]; s += (v[j].x * v[j].x + v[j].y * v[j].y) + (v[j].z * v[j].z + v[j].w * v[j].w); }
    if (hcopy) { GAS f32x4* hc = (GAS f32x4*)hcopy + lane;
#pragma unroll
        for (int j = 0; j < 8; ++j) hc[64 * j] = v[j]; }
    const float rstd = 1.f / sqrtf(wave_sum(s) * (1.f / DM) + RMS_EPS);
    GAS u64* o8 = (GAS u64*)orow + lane;
#pragma unroll
    for (int j = 0; j < 8; ++j) { const f32x4 gg = gr[64 * j]; const f32x4 y = v[j] * rstd * gg;
        o8[64 * j] = (u64)pk2(y.x, y.y) | ((u64)pk2(y.z, y.w) << 32); }
}

__device__ __forceinline__ void rms_row2(const float* xrow, const float* __restrict__ g1, bf16* o1, const float* __restrict__ g2, bf16* o2, int lane) {
    const GAS f32x4* xr = (const GAS f32x4*)xrow + lane;
    f32x4 v[8]; float s = 0.f;
#pragma unroll
    for (int j = 0; j < 8; ++j) { v[j] = xr[64 * j]; s += (v[j].x * v[j].x + v[j].y * v[j].y) + (v[j].z * v[j].z + v[j].w * v[j].w); }
    const float rstd = 1.f / sqrtf(wave_sum(s) * (1.f / DM) + RMS_EPS);
    { const GAS f32x4* gr = (const GAS f32x4*)g1 + lane; GAS u64* o8 = (GAS u64*)o1 + lane;
#pragma unroll
      for (int j = 0; j < 8; ++j) { const f32x4 y = v[j] * rstd * gr[64 * j]; o8[64 * j] = (u64)pk2(y.x, y.y) | ((u64)pk2(y.z, y.w) << 32); } }
    if (o2) { const GAS f32x4* gr = (const GAS f32x4*)g2 + lane; GAS u64* o8 = (GAS u64*)o2 + lane;
#pragma unroll
      for (int j = 0; j < 8; ++j) { const f32x4 y = v[j] * rstd * gr[64 * j]; o8[64 * j] = (u64)pk2(y.x, y.y) | ((u64)pk2(y.z, y.w) << 32); } }
}

__device__ __forceinline__ unsigned pk4_fp8(float a, float b, float c, float d) {
    a = __builtin_amdgcn_fmed3f(a, -448.f, 448.f); b = __builtin_amdgcn_fmed3f(b, -448.f, 448.f); c = __builtin_amdgcn_fmed3f(c, -448.f, 448.f); d = __builtin_amdgcn_fmed3f(d, -448.f, 448.f);
    int r = __builtin_amdgcn_cvt_pk_fp8_f32(a, b, 0, false); r = __builtin_amdgcn_cvt_pk_fp8_f32(c, d, r, true); return (unsigned)r;
}
template <int MODE>
__device__ __forceinline__ void transpose_item_fp8(const float* __restrict__ W, int N, unsigned char* __restrict__ WT, int KP, float scale, LAS float* scr, int item, int lane) {
    const int nblk = N / 64, kb = item / nblk, nb = item % nblk, k0 = 64 * kb, n0 = 64 * nb;
    const float* src = W + (size_t)k0 * N + n0 + lane;
    { float t[64];
#pragma unroll
      for (int i = 0; i < 64; ++i) t[i] = __builtin_nontemporal_load(src + (size_t)i * N);
#pragma unroll
      for (int i = 0; i < 64; ++i) scr[i * 65 + lane] = t[i]; }
    LDS_WAIT(); asm volatile("" ::: "memory");
    const int c = lane & 3, nl = lane >> 2;
    const int drow0 = MODE == 0 ? n0 : ((n0 >> 7) * 256 + (n0 & 127) + (MODE == 2 ? 128 : 0));
#pragma unroll
    for (int j = 0; j < 4; ++j) { const int n = nl + 16 * j; const LAS float* s = scr + (16 * c) * 65 + n;
        v4u o; o.x = pk4_fp8(s[0 * 65] * scale, s[1 * 65] * scale, s[2 * 65] * scale, s[3 * 65] * scale); o.y = pk4_fp8(s[4 * 65] * scale, s[5 * 65] * scale, s[6 * 65] * scale, s[7 * 65] * scale);
        o.z = pk4_fp8(s[8 * 65] * scale, s[9 * 65] * scale, s[10 * 65] * scale, s[11 * 65] * scale); o.w = pk4_fp8(s[12 * 65] * scale, s[13 * 65] * scale, s[14 * 65] * scale, s[15 * 65] * scale);
        *(GAS v4u*)(WT + (size_t)(drow0 + n) * KP + k0 + 16 * c) = o; }
    LDS_WAIT(); asm volatile("" ::: "memory");
}

__device__ __forceinline__ void rms_row_fp8(const float* xrow, const float* __restrict__ g, unsigned char* orow, int lane) {
    const GAS f32x4* xr = (const GAS f32x4*)xrow + lane; const GAS f32x4* gr = (const GAS f32x4*)g + lane;
    f32x4 v[8]; float s = 0.f;
#pragma unroll
    for (int j = 0; j < 8; ++j) { v[j] = xr[64 * j]; s += (v[j].x * v[j].x + v[j].y * v[j].y) + (v[j].z * v[j].z + v[j].w * v[j].w); }
    const float rstd = 1.f / sqrtf(wave_sum(s) * (1.f / DM) + RMS_EPS);
    GAS unsigned* o4 = (GAS unsigned*)orow + lane;
#pragma unroll
    for (int j = 0; j < 8; ++j) { const f32x4 y = v[j] * rstd * gr[64 * j]; o4[64 * j] = pk4_fp8(y.x, y.y, y.z, y.w); }
}

struct ThinBf16 { bf16* O; int ldc; __device__ __forceinline__ void operator()(int row, int col, f32x4 v0, f32x4) const {
    typedef unsigned u32x2 __attribute__((ext_vector_type(2))); u32x2 pk; pk.x = pk2(v0.x, v0.y); pk.y = pk2(v0.z, v0.w); *(GAS u32x2*)(O + (size_t)row * ldc + col) = pk; } };
struct ThinRes { float* H; int ldc; __device__ __forceinline__ void operator()(int row, int col, f32x4 v0, f32x4) const {
    GAS f32x4* p = (GAS f32x4*)(H + (size_t)row * ldc + col); *p = *p + v0; } };
struct ThinSwiglu { bf16* O; int ldc; __device__ __forceinline__ void operator()(int row, int col, f32x4 g, f32x4 up) const {
    typedef unsigned u32x2 __attribute__((ext_vector_type(2))); f32x4 r;
#pragma unroll
    for (int j = 0; j < 4; ++j) r[j] = g[j] * __builtin_amdgcn_rcpf(1.0f + __builtin_amdgcn_exp2f(-1.4426950408889634f * g[j])) * up[j];
    u32x2 pk; pk.x = pk2(r.x, r.y); pk.y = pk2(r.z, r.w); *(GAS u32x2*)(O + (size_t)row * ldc + col) = pk; } };
template <int SETS, class Epi>
__device__ __forceinline__ void thin_gemm(const Ctx& C, const bf16* __restrict__ A, const bf16* __restrict__ Bt, int K, int nunits, int r0, const Epi& E) {
    const int lane = C.lane, w = C.wave, fr = lane & 15, fq = lane >> 4;
    const int nsteps = K / 32, s_lo = (w * nsteps) / 8, s_hi = ((w + 1) * nsteps) / 8;
    LAS float* red = (LAS float*)C.lds;
    for (int u = blockIdx.x; u < nunits; u += C.G) {
        const int hc = 16 * u;
        const size_t brow0 = SETS == 1 ? (size_t)(hc + fr) : (size_t)((hc >> 7) * 256 + (hc & 127) + fr);
        const bf16* bp0 = Bt + brow0 * K + 32 * s_lo + 8 * fq;
        const bf16* ap = A + (size_t)(r0 + fr) * K + 32 * s_lo + 8 * fq;
        f32x4 acc0[4], acc1[4];
#pragma unroll
        for (int mt = 0; mt < 4; ++mt) { acc0[mt] = (f32x4){0.f, 0.f, 0.f, 0.f}; acc1[mt] = (f32x4){0.f, 0.f, 0.f, 0.f}; }
        const int nk = s_hi - s_lo;
        for (int kc = 0; kc < nk; kc += 4) {
            bf16x8 b0[4], b1[4], af[4][4];
#pragma unroll
            for (int q = 0; q < 4; ++q) { const int k = 32 * (kc + q < nk ? kc + q : nk - 1);
                b0[q] = *(const GAS bf16x8*)(bp0 + k); b1[q] = b0[q]; if (SETS == 2) b1[q] = *(const GAS bf16x8*)(bp0 + (size_t)128 * K + k);
#pragma unroll
                for (int mt = 0; mt < 4; ++mt) af[q][mt] = *(const GAS bf16x8*)(ap + (size_t)(16 * mt) * K + k); }
#pragma unroll
            for (int q = 0; q < 4; ++q) if (kc + q < nk) {
#pragma unroll
                for (int mt = 0; mt < 4; ++mt) { acc0[mt] = __builtin_amdgcn_mfma_f32_16x16x32_bf16(b0[q], af[q][mt], acc0[mt], 0, 0, 0);
                    if (SETS == 2) acc1[mt] = __builtin_amdgcn_mfma_f32_16x16x32_bf16(b1[q], af[q][mt], acc1[mt], 0, 0, 0); } }
        }
#pragma unroll
        for (int mt = 0; mt < 4; ++mt) { *(LAS f32x4*)(red + ((w * SETS + 0) * 4 + mt) * 256 + lane * 4) = acc0[mt];
            if (SETS == 2) *(LAS f32x4*)(red + ((w * SETS + 1) * 4 + mt) * 256 + lane * 4) = acc1[mt]; }
        LDS_BARRIER();
        if (C.tid < 256) { const int mt = C.tid >> 6, l = C.tid & 63;
            f32x4 s0 = {0.f, 0.f, 0.f, 0.f}, s1 = {0.f, 0.f, 0.f, 0.f};
#pragma unroll
            for (int ww = 0; ww < 8; ++ww) { s0 += *(const LAS f32x4*)(red + ((ww * SETS + 0) * 4 + mt) * 256 + l * 4);
                if (SETS == 2) s1 += *(const LAS f32x4*)(red + ((ww * SETS + 1) * 4 + mt) * 256 + l * 4); }
            E(r0 + 16 * mt + (l & 15), hc + 4 * (l >> 4), s0, s1); }
        LDS_BARRIER();
    }
}

template <int SETS, int SCA, int SCB, class Epi>
__device__ __forceinline__ void thin_gemm_fp8(const Ctx& C, const unsigned char* __restrict__ A, const unsigned char* __restrict__ Bt, int KB, int nunits, int r0, const Epi& E) {
    typedef int i32x4 __attribute__((ext_vector_type(4))); typedef int i32x8 __attribute__((ext_vector_type(8)));
    const int lane = C.lane, w = C.wave, fr = lane & 15, fq = lane >> 4;
    const int nsteps = KB / 128, s_lo = (w * nsteps) / 8, s_hi = ((w + 1) * nsteps) / 8;
    LAS float* red = (LAS float*)C.lds;
    for (int u = blockIdx.x; u < nunits; u += C.G) {
        const int hc = 16 * u;
        const size_t brow0 = SETS == 1 ? (size_t)(hc + fr) : (size_t)((hc >> 7) * 256 + (hc & 127) + fr);
        const unsigned char* bp0 = Bt + brow0 * KB + 128 * s_lo + 32 * fq;
        const unsigned char* ap = A + (size_t)(r0 + fr) * KB + 128 * s_lo + 32 * fq;
        f32x4 acc0[4], acc1[4];
#pragma unroll
        for (int mt = 0; mt < 4; ++mt) { acc0[mt] = (f32x4){0.f, 0.f, 0.f, 0.f}; acc1[mt] = (f32x4){0.f, 0.f, 0.f, 0.f}; }
        const int nk = s_hi - s_lo;
        for (int kc = 0; kc < nk; kc += 2) {
            i32x8 b0[2], b1[2], af[2][4];
#pragma unroll
            for (int q = 0; q < 2; ++q) { const int k = 128 * (kc + q < nk ? kc + q : nk - 1);
                b0[q] = __builtin_shufflevector(*(const GAS i32x4*)(bp0 + k), *(const GAS i32x4*)(bp0 + k + 16), 0, 1, 2, 3, 4, 5, 6, 7); b1[q] = b0[q];
                if (SETS == 2) b1[q] = __builtin_shufflevector(*(const GAS i32x4*)(bp0 + (size_t)128 * KB + k), *(const GAS i32x4*)(bp0 + (size_t)128 * KB + k + 16), 0, 1, 2, 3, 4, 5, 6, 7);
#pragma unroll
                for (int mt = 0; mt < 4; ++mt) af[q][mt] = __builtin_shufflevector(*(const GAS i32x4*)(ap + (size_t)(16 * mt) * KB + k), *(const GAS i32x4*)(ap + (size_t)(16 * mt) * KB + k + 16), 0, 1, 2, 3, 4, 5, 6, 7); }
#pragma unroll
            for (int q = 0; q < 2; ++q) if (kc + q < nk) {
#pragma unroll
                for (int mt = 0; mt < 4; ++mt) { acc0[mt] = __builtin_amdgcn_mfma_scale_f32_16x16x128_f8f6f4(b0[q], af[q][mt], acc0[mt], 0, 0, 0, SCB, 0, SCA);
                    if (SETS == 2) acc1[mt] = __builtin_amdgcn_mfma_scale_f32_16x16x128_f8f6f4(b1[q], af[q][mt], acc1[mt], 0, 0, 0, SCB, 0, SCA); } }
        }
#pragma unroll
        for (int mt = 0; mt < 4; ++mt) { *(LAS f32x4*)(red + ((w * SETS + 0) * 4 + mt) * 256 + lane * 4) = acc0[mt];
            if (SETS == 2) *(LAS f32x4*)(red + ((w * SETS + 1) * 4 + mt) * 256 + lane * 4) = acc1[mt]; }
        LDS_BARRIER();
        if (C.tid < 256) { const int mt = C.tid >> 6, l = C.tid & 63;
            f32x4 s0 = {0.f, 0.f, 0.f, 0.f}, s1 = {0.f, 0.f, 0.f, 0.f};
#pragma unroll
            for (int ww = 0; ww < 8; ++ww) { s0 += *(const LAS f32x4*)(red + ((ww * SETS + 0) * 4 + mt) * 256 + l * 4);
                if (SETS == 2) s1 += *(const LAS f32x4*)(red + ((ww * SETS + 1) * 4 + mt) * 256 + l * 4); }
            E(r0 + 16 * mt + (l & 15), hc + 4 * (l >> 4), s0, s1); }
        LDS_BARRIER();
    }
}
struct ThinSwiglu8 { unsigned char* O; int ldc; __device__ __forceinline__ void operator()(int row, int col, f32x4 g, f32x4 up) const {
    f32x4 r;
#pragma unroll
    for (int j = 0; j < 4; ++j) r[j] = 16.0f * g[j] * __builtin_amdgcn_rcpf(1.0f + __builtin_amdgcn_exp2f(-1.4426950408889634f * g[j])) * up[j];
    *(GAS unsigned*)(O + (size_t)row * ldc + col) = pk4_fp8(r.x, r.y, r.z, r.w); } };

constexpr int P2_T = 48, P2_NCH = LSEQ / P2_T  , P2_UNITS = 16 * NB * P2_NCH  ;
constexpr int P2_XS = 0, P2_XCF = P2_XS + 51 * 128 * 4, P2_XCB = P2_XCF + 48 * 128 * 4, P2_AS = P2_XCB + 48 * 272, P2_BS = P2_AS + 48 * 128 * 4, P2_END = P2_BS + 48 * 128 * 4;
static_assert(P2_END <= SCR_BYTES, "P2 LDS");
__device__ __forceinline__ float sigmoid_fast(float x) { return __builtin_amdgcn_rcpf(1.0f + __builtin_amdgcn_exp2f(-1.4426950408889634f * x)); }
__device__ __forceinline__ void phase2(KArgs a, const Ctx& C) {
    unsigned char* ws = a->ws;
    const bf16* XG = (const bf16*)(ws + WS_XG); const bf16* WG = (const bf16*)(ws + WS_WG);
    bf16* HSL = (bf16*)(ws + WS_HSL); bf16* PCb = (bf16*)(ws + WS_PC); float* CS = (float*)(ws + WS_CSUM);
    LAS float* XS = (LAS float*)(C.lds + P2_XS); LAS float* XCF = (LAS float*)(C.lds + P2_XCF); LAS unsigned char* XCB = C.lds + P2_XCB;
    LAS float* AS = (LAS float*)(C.lds + P2_AS); LAS float* BS = (LAS float*)(C.lds + P2_BS);
    const int tid = C.tid, lane = C.lane, w = C.wave, fr = lane & 15, fq = lane >> 4;
    const int per = (P2_UNITS + C.G - 1) / C.G;
    const int u0 = (int)blockIdx.x * per, u1 = (u0 + per < P2_UNITS) ? u0 + per : P2_UNITS;
    bf16x8 wr_[4], wi_[4]; f32x4 cb = {0.f, 0.f, 0.f, 0.f}, cw[4], brg = cb, big = cb, sp8 = cb; int gcur = -1;
#pragma unroll
    for (int ks = 0; ks < 4; ++ks) { wr_[ks] = (bf16x8){0, 0, 0, 0, 0, 0, 0, 0}; wi_[ks] = wr_[ks]; cw[ks] = cb; }
    v4u xr0 = {0u, 0u, 0u, 0u}, xr1 = xr0;
    auto xload = [&](int u, v4u& r0, v4u& r1) {
        const int g = u / (NB * P2_NCH), rem = u - g * (NB * P2_NCH), b = rem / P2_NCH, c = rem - b * P2_NCH; const int t0 = c * P2_T; const size_t Rb = (size_t)b * LSEQ;
        { const int q = tid, j = q >> 4, c8 = q & 15, t = t0 - 3 + j; r0 = (v4u){0u, 0u, 0u, 0u}; if (t >= 0) r0 = *(const GAS v4u*)(XG + (Rb + t) * 4096 + 128 * g + 8 * c8); }
        { const int q = tid + 512, j = q >> 4, c8 = q & 15, t = t0 - 3 + j; r1 = (v4u){0u, 0u, 0u, 0u}; if (q < 51 * 16 && t >= 0) r1 = *(const GAS v4u*)(XG + (Rb + t) * 4096 + 128 * g + 8 * c8); } };
    if (u0 < u1) xload(u0, xr0, xr1);
    for (int u = u0; u < u1; ++u) {
        const int g = u / (NB * P2_NCH), rem = u - g * (NB * P2_NCH), b = rem / P2_NCH, c = rem - b * P2_NCH;
        const int t0 = c * P2_T; const size_t Rb = (size_t)b * LSEQ;
        if (g != gcur) { gcur = g;
            const bf16* wrow = WG + ((size_t)g * 256 + 16 * w + fr) * 128 + 8 * fq;
#pragma unroll
            for (int ks = 0; ks < 4; ++ks) { wr_[ks] = *(const GAS bf16x8*)(wrow + 32 * ks); wi_[ks] = *(const GAS bf16x8*)(wrow + 128 * 128 + 32 * ks); }
            { const int gc = 128 * g + 4 * (tid & 31); cb = *(const GAS f32x4*)(a->in[5] + gc);
#pragma unroll
              for (int kk = 0; kk < 4; ++kk) cw[kk] = *(const GAS f32x4*)(a->in[4] + kk * DM + gc); }
            { const int gc = 128 * g + 16 * w + 4 * fq; brg = *(const GAS f32x4*)(a->in[7] + gc); big = *(const GAS f32x4*)(a->in[9] + gc); const f32x4 lam = *(const GAS f32x4*)(a->in[10] + gc);
#pragma unroll
              for (int j = 0; j < 4; ++j) sp8[j] = -8.0f * log1pf(__expf(-lam[j])); } }
        { const int q = tid, j = q >> 4, c8 = q & 15;
          *(LAS f32x4*)(XS + j * 128 + 8 * c8) = (f32x4){__uint_as_float(xr0.x << 16), __uint_as_float(xr0.x & 0xffff0000u), __uint_as_float(xr0.y << 16), __uint_as_float(xr0.y & 0xffff0000u)};
          *(LAS f32x4*)(XS + j * 128 + 8 * c8 + 4) = (f32x4){__uint_as_float(xr0.z << 16), __uint_as_float(xr0.z & 0xffff0000u), __uint_as_float(xr0.w << 16), __uint_as_float(xr0.w & 0xffff0000u)}; }
        if (tid + 512 < 51 * 16) { const int q = tid + 512, j = q >> 4, c8 = q & 15;
          *(LAS f32x4*)(XS + j * 128 + 8 * c8) = (f32x4){__uint_as_float(xr1.x << 16), __uint_as_float(xr1.x & 0xffff0000u), __uint_as_float(xr1.y << 16), __uint_as_float(xr1.y & 0xffff0000u)};
          *(LAS f32x4*)(XS + j * 128 + 8 * c8 + 4) = (f32x4){__uint_as_float(xr1.z << 16), __uint_as_float(xr1.z & 0xffff0000u), __uint_as_float(xr1.w << 16), __uint_as_float(xr1.w & 0xffff0000u)}; }
        if (u + 1 < u1) xload(u + 1, xr0, xr1);
        LDS_BARRIER();
        { const int ch4 = tid & 31, rsub = tid >> 5;
#pragma unroll
          for (int rr = 0; rr < 3; ++rr) { const int row = rsub + 16 * rr; f32x4 y = cb;
#pragma unroll
              for (int kk = 0; kk < 4; ++kk) y += cw[kk] * *(const LAS f32x4*)(XS + (row + kk) * 128 + 4 * ch4);
              *(LAS f32x4*)(XCF + row * 128 + 4 * ch4) = y;
              typedef unsigned u32x2 __attribute__((ext_vector_type(2)));
              u32x2 pk; pk.x = pk2(y.x, y.y); pk.y = pk2(y.z, y.w);
              *(LAS u32x2*)(XCB + row * 272 + 8 * ch4) = pk; } }
        LDS_BARRIER();
        f32x4 accR[3], accI[3];
#pragma unroll
        for (int mt = 0; mt < 3; ++mt) { accR[mt] = (f32x4){0.f, 0.f, 0.f, 0.f}; accI[mt] = (f32x4){0.f, 0.f, 0.f, 0.f}; }
#pragma unroll
        for (int ks = 0; ks < 4; ++ks)
#pragma unroll
            for (int mt = 0; mt < 3; ++mt) { const bf16x8 af = *(const LAS bf16x8*)(XCB + (16 * mt + fr) * 272 + 64 * ks + 16 * fq);
                accR[mt] = __builtin_amdgcn_mfma_f32_16x16x32_bf16(wr_[ks], af, accR[mt], 0, 0, 0);
                accI[mt] = __builtin_amdgcn_mfma_f32_16x16x32_bf16(wi_[ks], af, accI[mt], 0, 0, 0); }
        { const int ch0 = 16 * w + 4 * fq;
#pragma unroll
          for (int mt = 0; mt < 3; ++mt) { const int row = 16 * mt + fr; const f32x4 xc = *(const LAS f32x4*)(XCF + row * 128 + ch0);
              f32x4 av, bv;
#pragma unroll
              for (int j = 0; j < 4; ++j) { const float r = sigmoid_fast(accR[mt][j] + brg[j]), ig = sigmoid_fast(accI[mt][j] + big[j]);
                  const float la = r * sp8[j]; const float aa = __builtin_amdgcn_exp2f(1.4426950408889634f * la); av[j] = aa;
                  bv[j] = __builtin_amdgcn_sqrtf(fmaxf(1.0f - aa * aa, 0.f)) * (ig * xc[j]); }
              *(LAS f32x4*)(AS + row * 128 + ch0) = av; *(LAS f32x4*)(BS + row * 128 + ch0) = bv; } }
        LDS_BARRIER();
        { const int ch = tid & 127, qt = tid >> 7; float h = 0.f, P = 1.f;
#pragma unroll
          for (int rr = 0; rr < 12; ++rr) { const int row = 12 * qt + rr; const float av = AS[row * 128 + ch], bv = BS[row * 128 + ch]; h = av * h + bv; P *= av; }
          XS[qt * 128 + ch] = P; XS[512 + qt * 128 + ch] = h;
          LDS_BARRIER();
          float hin = 0.f, Pin = 1.f;
#pragma unroll
          for (int qq = 0; qq < 3; ++qq) if (qq < qt) { const float Aq = XS[qq * 128 + ch], Hq = XS[512 + qq * 128 + ch]; hin = Aq * hin + Hq; Pin *= Aq; }
          const size_t o0 = (Rb + t0 + 12 * qt) * DM + 128 * g + ch; h = hin; P = Pin;
#pragma unroll
          for (int rr = 0; rr < 12; ++rr) { const int row = 12 * qt + rr; const float av = AS[row * 128 + ch], bv = BS[row * 128 + ch]; h = av * h + bv; P *= av;
              HSL[o0 + (size_t)rr * DM] = (bf16)f2bf(h); PCb[o0 + (size_t)rr * DM] = (bf16)f2bf(P); }
          if (qt == 3) { const size_t cs = ((size_t)b * P2_NCH + c) * DM + 128 * g + ch; CS[cs] = P; CS[(size_t)NB * P2_NCH * DM + cs] = h; } }
        LDS_BARRIER();
    }
}
__device__ __forceinline__ void phase3(KArgs a, const Ctx& C) {
    unsigned char* ws = a->ws;
    const bf16* XG = (const bf16*)(ws + WS_XG); const bf16* HSL = (const bf16*)(ws + WS_HSL); const bf16* PCb = (const bf16*)(ws + WS_PC); const float* CS = (const float*)(ws + WS_CSUM);
    bf16* Y = (bf16*)(ws + WS_Y);
    for (int wu = C.gw; wu < NB * P2_NCH * 8; wu += C.NGW) {
        const int hb = wu & 1, cb = (wu >> 1) & 3, bc = wu >> 3, b = bc / P2_NCH, c = bc - b * P2_NCH; const int ch = 512 * cb + 8 * C.lane;
        f32x4 c0 = {0.f, 0.f, 0.f, 0.f}, c1 = c0;
        for (int cc = 0; cc < c; ++cc) { const size_t cs = ((size_t)b * P2_NCH + cc) * DM + ch; const float* CA = CS + cs; const float* CH = CS + (size_t)NB * P2_NCH * DM + cs;
            c0 = *(const GAS f32x4*)CA * c0 + *(const GAS f32x4*)CH; c1 = *(const GAS f32x4*)(CA + 4) * c1 + *(const GAS f32x4*)(CH + 4); }
        const size_t r0 = (size_t)b * LSEQ + (size_t)c * P2_T + 24 * hb;
#pragma unroll 6
        for (int row = 0; row < 24; ++row) { const size_t o = (r0 + row) * DM + ch;
            const v4u hs = *(const GAS v4u*)(HSL + o), pc = *(const GAS v4u*)(PCb + o), gg = *(const GAS v4u*)(XG + (r0 + row) * 4096 + DM + ch);
            const unsigned hw[4] = {hs.x, hs.y, hs.z, hs.w}, pw[4] = {pc.x, pc.y, pc.z, pc.w}, gw[4] = {gg.x, gg.y, gg.z, gg.w}; unsigned ow[4];
#pragma unroll
            for (int j = 0; j < 4; ++j) { float y2[2];
#pragma unroll
                for (int e = 0; e < 2; ++e) { const float hv = e ? __uint_as_float(hw[j] & 0xffff0000u) : __uint_as_float(hw[j] << 16), pv = e ? __uint_as_float(pw[j] & 0xffff0000u) : __uint_as_float(pw[j] << 16);
                    const float gx = e ? __uint_as_float(gw[j] & 0xffff0000u) : __uint_as_float(gw[j] << 16); const int ci = 2 * j + e; const float cr = ci < 4 ? c0[ci & 3] : c1[ci & 3];
                    const float z2 = 1.5957691216057308f * (gx + 0.044715f * gx * gx * gx);
                    y2[e] = (hv + pv * cr) * (gx * __builtin_amdgcn_rcpf(1.0f + __builtin_amdgcn_exp2f(-1.4426950408889634f * z2))); }
                ow[j] = pk2(y2[0], y2[1]); }
            *(GAS v4u*)(Y + o) = (v4u){ow[0], ow[1], ow[2], ow[3]}; }
    }
}

namespace attn {
constexpr int D = 128;
constexpr float THR = 8.f;
constexpr bool WSKIP = false;
constexpr int QP = 2048, KVP = 4096, OP = 2048;
constexpr float SCALE = 0.08838834764831845f;
constexpr int NW = 8, QBLK = 32, KVBLK = 64, QB = NW * QBLK;
constexpr int SHM_V = KVBLK * D * 2, SHM_K = KVBLK * D * 2;
constexpr int LDS_BYTES = 2 * SHM_V + 2 * SHM_K + NW * 64 * 4;
typedef unsigned short bf16;
typedef short bf16x8 __attribute__((ext_vector_type(8)));
typedef short s16x4 __attribute__((ext_vector_type(4)));
typedef float f32x16 __attribute__((ext_vector_type(16)));
typedef float f32x4 __attribute__((ext_vector_type(4)));
typedef unsigned u32x4 __attribute__((ext_vector_type(4)));
template <class A, class Bt> struct same_t { static constexpr bool v = false; };
template <class A> struct same_t<A, A> { static constexpr bool v = true; };
#define KSWZ(row, colB) ((row) * 256 + ((colB) ^ (((row) & 7) << 4)))
#define SBAR() __builtin_amdgcn_sched_barrier(0)
__device__ __forceinline__ int v_st(int k, int c) { const int kk = (k & ~0xC) | ((k & 4) << 1) | ((k & 8) >> 1); return ((kk >> 3) * 4 + (c >> 5)) * 512 + ((kk & 7) * 32 + (c & 31)) * 2; }
__device__ __forceinline__ int v_rd_base(int lane) { return ((lane & 3) << 3) | (((lane >> 2) & 3) << 6) | (((lane >> 4) & 1) << 5) | (((lane >> 5) & 1) << 8); }
constexpr int v_rd_off(int d0, int ks, int half) { return d0 * 512 + ks * 4096 + half * 2048; }
__device__ __forceinline__ int crow(int r, int hi) { return (r & 3) + 8 * (r >> 2) + 4 * hi; }
__device__ __forceinline__ unsigned cvtpk(float lo, float hi) {
    unsigned r; asm volatile("v_cvt_pk_bf16_f32 %0, %1, %2" : "=v"(r) : "v"(lo), "v"(hi)); return r;
}
__device__ __forceinline__ bf16x8 pack8(f32x4 a, f32x4 b) {
    u32x4 w = {cvtpk(a[0], a[1]), cvtpk(a[2], a[3]), cvtpk(b[0], b[1]), cvtpk(b[2], b[3])};
    return *reinterpret_cast<bf16x8*>(&w);
}
template <class T> __device__ __forceinline__ bf16x8 load8(const T* p) {
    if constexpr (same_t<T, float>::v) { return pack8(*(const f32x4*)p, *(const f32x4*)(p + 4)); }
    else { return *reinterpret_cast<const bf16x8*>(p); }
}
__device__ __forceinline__ void bias_tile(f32x16& p0, f32x16& p1, float cb, float b0) {
    const float b1 = fmaf(cb, 32.f, b0);
#pragma unroll
    for (int r = 0; r < 16; ++r) { const float c = (float)((r & 3) + 8 * (r >> 2)); p0[r] += fmaf(cb, c, b0); p1[r] += fmaf(cb, c, b1); }
}
__device__ __forceinline__ void mask_tile(f32x16& p0, f32x16& p1, int dq, unsigned W) {
    const float NEG = -__builtin_inff();
#pragma unroll
    for (int r = 0; r < 16; ++r) {
        const int c = (r & 3) + 8 * (r >> 2);
        if ((unsigned)(dq - c) >= W) p0[r] = NEG;
        if ((unsigned)(dq - c - 32) >= W) p1[r] = NEG;
    }
}
__device__ __forceinline__ void partialSM(f32x16& p0, f32x16& p1, float& m_reg, float& mn, float& alpha) {
    float pmax = p0[0]; for (int r = 1; r < 16; ++r) pmax = fmaxf(pmax, p0[r]); for (int r = 0; r < 16; ++r) pmax = fmaxf(pmax, p1[r]);
    { auto rr = __builtin_amdgcn_permlane32_swap(__float_as_uint(pmax), __float_as_uint(pmax), false, false);
      pmax = fmaxf(__uint_as_float(rr[0]), __uint_as_float(rr[1])); }
    constexpr float C2 = 1.4426950408889634f * SCALE;
    if (__builtin_expect(__all((pmax - m_reg) * SCALE <= THR), 1)) { mn = m_reg; alpha = 1.f; }
    else { mn = fmaxf(m_reg, pmax); alpha = __builtin_amdgcn_exp2f((m_reg - mn) * C2); m_reg = mn; }
    const float mnL = -mn * C2;
    for (int r = 0; r < 16; ++r) p0[r] = fmaf(p0[r], C2, mnL); for (int r = 0; r < 16; ++r) p1[r] = fmaf(p1[r], C2, mnL);
    for (int r = 0; r < 16; ++r) p0[r] = __builtin_amdgcn_exp2f(p0[r]);
}
__device__ __forceinline__ void finishSM(f32x16& p0, f32x16& p1, float alpha, float& l_reg, bf16x8& pa0, bf16x8& pa1, bf16x8& pa2, bf16x8& pa3) {
    for (int r = 0; r < 16; ++r) p1[r] = __builtin_amdgcn_exp2f(p1[r]);
    float ps = 0; for (int r = 0; r < 16; ++r) ps += p0[r]; for (int r = 0; r < 16; ++r) ps += p1[r];
    { auto rr = __builtin_amdgcn_permlane32_swap(__float_as_uint(ps), __float_as_uint(ps), false, false);
      ps = __uint_as_float(rr[0]) + __uint_as_float(rr[1]); }
    l_reg = l_reg * alpha + ps;
#define PK4(P, B_, OUT) do { unsigned a0 = cvtpk(P[B_+0], P[B_+1]), a1 = cvtpk(P[B_+2], P[B_+3]);                          \
        unsigned b0 = cvtpk(P[B_+4], P[B_+5]), b1 = cvtpk(P[B_+6], P[B_+7]);                                             \
        auto r0 = __builtin_amdgcn_permlane32_swap(a0, b0, false, false); auto r1 = __builtin_amdgcn_permlane32_swap(a1, b1, false, false); \
        u32x4 w = {r0[0], r1[0], r0[1], r1[1]}; OUT = *reinterpret_cast<bf16x8*>(&w); } while (0)
    PK4(p0, 0, pa0); PK4(p0, 8, pa1); PK4(p1, 0, pa2); PK4(p1, 8, pa3);
#undef PK4
}
template <int KB, bool SK>
__device__ __forceinline__ void qkt(f32x16& p0, f32x16& p1, const char* K_lds, int r32, int hi, const bf16x8* qr, bool act) {
    if (SK && !act) { const float NEG = -__builtin_inff();
#pragma unroll
        for (int r = 0; r < 16; ++r) { p0[r] = NEG; p1[r] = NEG; } return; }
    p0 = f32x16{}; p1 = f32x16{};
    const char* kb[4];
#pragma unroll
    for (int dd = 0; dd < 4; ++dd) kb[dd] = K_lds + KB * SHM_K + KSWZ(r32, (dd * 16 + hi * 8) * 2);
#pragma unroll
    for (int d0 = 0; d0 < 8; ++d0) { const char* a = kb[d0 & 3] + (d0 >> 2) * 128;
        bf16x8 b0 = *reinterpret_cast<const bf16x8*>(a);
        bf16x8 b1 = *reinterpret_cast<const bf16x8*>(a + 32 * 256);
        p0 = __builtin_amdgcn_mfma_f32_32x32x16_bf16(b0, qr[d0], p0, 0, 0, 0);
        p1 = __builtin_amdgcn_mfma_f32_32x32x16_bf16(b1, qr[d0], p1, 0, 0, 0); }
}
template <int VB, bool SK>
__device__ __forceinline__ void pv_tile(f32x16* o, int vb0, bf16x8 pa0, bf16x8 pa1, bf16x8 pa2, bf16x8 pa3, bool act) {
    if (SK && !act) return;
#define TRRD(dst, off) asm volatile("ds_read_b64_tr_b16 %0, %1 offset:%2" : "=&v"(dst) : "v"(vb0), "i"(off) : "memory")
#define PV_D0(d0) do { s16x4 l0, l1, l2, l3, h0, h1, h2, h3; constexpr int b_ = VB * SHM_V + v_rd_off(d0, 0, 0);     \
        TRRD(l0, b_); TRRD(h0, b_ + 2048); TRRD(l1, b_ + 4096); TRRD(h1, b_ + 6144); TRRD(l2, b_ + 8192); TRRD(h2, b_ + 10240); TRRD(l3, b_ + 12288); TRRD(h3, b_ + 14336); \
        asm volatile("s_waitcnt lgkmcnt(0)" ::: "memory"); SBAR();                 \
        o[d0] = __builtin_amdgcn_mfma_f32_32x32x16_bf16(pa0, (bf16x8){l0[0], l0[1], l0[2], l0[3], h0[0], h0[1], h0[2], h0[3]}, o[d0], 0, 0, 0);   \
        o[d0] = __builtin_amdgcn_mfma_f32_32x32x16_bf16(pa1, (bf16x8){l1[0], l1[1], l1[2], l1[3], h1[0], h1[1], h1[2], h1[3]}, o[d0], 0, 0, 0);   \
        o[d0] = __builtin_amdgcn_mfma_f32_32x32x16_bf16(pa2, (bf16x8){l2[0], l2[1], l2[2], l2[3], h2[0], h2[1], h2[2], h2[3]}, o[d0], 0, 0, 0);   \
        o[d0] = __builtin_amdgcn_mfma_f32_32x32x16_bf16(pa3, (bf16x8){l3[0], l3[1], l3[2], l3[3], h3[0], h3[1], h3[2], h3[3]}, o[d0], 0, 0, 0); } while (0)
    PV_D0(0); PV_D0(1); PV_D0(2); PV_D0(3);
#undef PV_D0
#undef TRRD
}

template <class TIn, class TOut> struct BlockRef { const TIn* Q; const TIn* K; const TIn* V; TOut* O; int P0; float cb; };
template <class TIn> struct Seam {
    bf16x8 qr[8];
    bf16x8 st_v0, st_v1, st_k0, st_k1; f32x4 sf0, sf1, sf2, sf3;
    f32x4 tq[16];
};
__device__ __forceinline__ int swa_jlo(int P0, int W) { const int lowk = P0 - W + 1; return lowk > 0 ? lowk / KVBLK : 0; }
#define ROW(p, k0, rr) ((p) + (size_t)((k0) + (rr) - sr) * KVP + (unsigned)(sr * KVP + sc))
#define VMW() asm volatile("s_waitcnt vmcnt(0)" ::: "memory")
#define VMWN(n) asm volatile("s_waitcnt vmcnt(%0)" :: "i"(n) : "memory")
#define SLOAD_H(Kp, Vp, k0) do { S.st_v0 = load8<TIn>(ROW(Vp, k0, sr)); S.st_v1 = load8<TIn>(ROW(Vp, k0, 32 + sr));              \
                         S.st_k0 = load8<TIn>(ROW(Kp, k0, sr)); S.st_k1 = load8<TIn>(ROW(Kp, k0, 32 + sr)); } while (0)
#define SWRITE_HK(bf) do { *(bf16x8*)(K_lds + (bf) * SHM_K + kws) = S.st_k0; *(bf16x8*)(K_lds + (bf) * SHM_K + kws + 32 * 256) = S.st_k1; } while (0)
#define SWRITE_HV(bf) do { *(bf16x8*)(V_lds + (bf) * SHM_V + vst0) = S.st_v0; *(bf16x8*)(V_lds + (bf) * SHM_V + vst1) = S.st_v1; } while (0)
#define SWRITE_H(bf) do { SWRITE_HV(bf); SWRITE_HK(bf); } while (0)
#define SLOAD_F(p, k0) do { S.sf0 = *(const f32x4*)ROW(p, k0, sr); S.sf1 = *(const f32x4*)(ROW(p, k0, sr) + 4);                \
                            S.sf2 = *(const f32x4*)ROW(p, k0, 32 + sr); S.sf3 = *(const f32x4*)(ROW(p, k0, 32 + sr) + 4); } while (0)
#define SWRITE_KF(bf) do { *(bf16x8*)(K_lds + (bf) * SHM_K + kws) = pack8(S.sf0, S.sf1); *(bf16x8*)(K_lds + (bf) * SHM_K + kws + 32 * 256) = pack8(S.sf2, S.sf3); } while (0)
#define SWRITE_VF(bf) do { *(bf16x8*)(V_lds + (bf) * SHM_V + vst0) = pack8(S.sf0, S.sf1); *(bf16x8*)(V_lds + (bf) * SHM_V + vst1) = pack8(S.sf2, S.sf3); } while (0)
template <class TIn, class TOut>
__device__ __forceinline__ void causal_swa_prime(const BlockRef<TIn, TOut>& cur, int W, char* lds, Seam<TIn>& S, const int wid_in) {
    constexpr bool F32 = same_t<TIn, float>::v;
    __builtin_assume(wid_in >= 0 && wid_in < 8); const int wid = wid_in, lane = mk_lane(), tid = wid * 64 + lane, r32 = lane & 31, hi = lane >> 5;
    const int sr = tid >> 4, sc = (tid & 15) * 8, kws = KSWZ(sr, sc * 2); char* K_lds = lds + 2 * SHM_V;
    const int kb0 = swa_jlo(cur.P0, W) * KVBLK;
    for (int d0 = 0; d0 < 8; ++d0) S.qr[d0] = load8<TIn>(cur.Q + (size_t)(wid * QBLK) * QP + (unsigned)(r32 * QP + hi * 8) + d0 * 16);
    if constexpr (F32) { SLOAD_F((const float*)cur.K, kb0); VMW(); SWRITE_KF(0); SBAR(); SLOAD_F((const float*)cur.V, kb0); }
    else { SLOAD_H(cur.K, cur.V, kb0); VMW(); SWRITE_HK(0); }
    __syncthreads();
}
template <class TIn, class TOut>
__device__ __forceinline__ void causal_swa_block(const BlockRef<TIn, TOut>& cur, const BlockRef<TIn, TOut>& nxt, int skv, int W, char* lds, Seam<TIn>& S, const int wid_in) {
    constexpr bool F32 = same_t<TIn, float>::v;
    __builtin_assume(wid_in >= 0 && wid_in < 8); const int wid = wid_in, lane = mk_lane(), tid = wid * 64 + lane, r32 = lane & 31, hi = lane >> 5;
    const int j_lo = swa_jlo(cur.P0, W);
    int j_hi = (cur.P0 + QB - 1) / KVBLK + 1; if (j_hi > skv / KVBLK) j_hi = skv / KVBLK;
    const int NT = j_hi - j_lo;
    const int kbn = swa_jlo(nxt.P0, W) * KVBLK;
    const int qlo = cur.P0 + wid * QBLK, qm = qlo + r32 - 4 * hi;
    char* V_lds = lds; char* K_lds = lds + 2 * SHM_V;
    float* ws = (float*)(lds + 2 * SHM_V + 2 * SHM_K) + wid * 64; float* li_l = ws, * al_l = ws + 32;
    float m_reg = -1e30f, l_reg = 0; f32x16 o[4] = {};
    const int sr = tid >> 4, sc = (tid & 15) * 8, vst0 = v_st(sr, sc), vst1 = v_st(32 + sr, sc), kws = KSWZ(sr, sc * 2);
    const int vb0 = (int)(uintptr_t)V_lds + v_rd_base(lane);
    const TIn* Kh = cur.K; const TIn* Vh = cur.V;
#define RESC(a) do { if (__any((a) < 1.f)) { if (hi == 0) al_l[r32] = (a); asm volatile("s_waitcnt lgkmcnt(0)" ::: "memory");              \
                     for (int d_ = 0; d_ < 4; ++d_) for (int r = 0; r < 16; ++r) o[d_][r] *= al_l[crow(r, hi)]; } } while (0)
#define KBASE(t) ((j_lo + (t)) * KVBLK)
#define ACT(t) (KBASE(t) <= qlo + QBLK - 1 && KBASE(t) + KVBLK - 1 >= qlo - W + 1)
#define MASKT(P0_, P1_, t) do { const int kb_ = KBASE(t); bias_tile(P0_, P1_, cur.cb, cur.cb * (float)(kb_ + 4 * hi)); if ((!SK || ACT(t)) && (kb_ + KVBLK - 1 > qlo || kb_ <= qlo + QBLK - 1 - W)) mask_tile(P0_, P1_, qm - kb_, (unsigned)W); } while (0)
    constexpr int NQL = F32 ? 16 : 8;
    constexpr bool SK = WSKIP && !F32;
#define SEAM_K0() do { VMWN(NQL); if constexpr (F32) { SWRITE_KF(0); SBAR(); SLOAD_F((const float*)nxt.V, kbn); } else { SWRITE_HK(0); } SBAR(); } while (0)
    f32x16 pA0, pA1, pB0, pB1; float mnA, mnB, alA, alB; bf16x8 pa0, pa1, pa2, pa3;
    if constexpr (F32) { VMW(); SWRITE_VF(0); SBAR(); } else { SWRITE_HV(0); SBAR(); }
    if (NT > 1) { if constexpr (F32) SLOAD_F((const float*)Kh, KBASE(1)); else SLOAD_H(Kh, Vh, KBASE(1)); }
    SBAR(); qkt<0, SK>(pA0, pA1, K_lds, r32, hi, S.qr, ACT(0));
    if constexpr (F32) { if (NT > 1) { VMW(); SWRITE_KF(1); SBAR(); SLOAD_F((const float*)Vh, KBASE(1)); } }
    MASKT(pA0, pA1, 0); partialSM(pA0, pA1, m_reg, mnA, alA);
    if (NT > 1) { VMW(); if constexpr (F32) { SWRITE_VF(1); SBAR(); if (NT > 2) SLOAD_F((const float*)Kh, KBASE(2)); } else SWRITE_H(1); }
    __syncthreads();
#define HALF_STEP(PX0, PX1, mnX, alX, PY0, PY1, alY, t, KB, VB, SB) do {                                                      \
        SBAR(); qkt<KB, SK>(PX0, PX1, K_lds, r32, hi, S.qr, ACT(t));                                             \
        finishSM(PY0, PY1, alY, l_reg, pa0, pa1, pa2, pa3); SBAR();                                                           \
        if ((t) + 1 < NT) { if constexpr (F32) { VMW(); SWRITE_KF(SB); SBAR(); SLOAD_F((const float*)Vh, KBASE((t) + 1)); }  \
                            else { SLOAD_H(Kh, Vh, KBASE((t) + 1)); } SBAR(); }                                               \
        pv_tile<VB, SK>(o, vb0, pa0, pa1, pa2, pa3, ACT((t) - 1)); MASKT(PX0, PX1, (t)); partialSM(PX0, PX1, m_reg, mnX, alX);                                        \
        __syncthreads();                                                                                                      \
        if ((t) + 1 < NT) { VMW(); if constexpr (F32) { SWRITE_VF(SB); SBAR(); if ((t) + 2 < NT) SLOAD_F((const float*)Kh, KBASE((t) + 2)); } \
                            else { SWRITE_H(SB); } }                                                                          \
        RESC(alX); __syncthreads(); } while (0)
    for (int t = 1; t + 1 < NT; t += 2) {
        HALF_STEP(pB0, pB1, mnB, alB, pA0, pA1, alA, t, 1, 0, 0);
        HALF_STEP(pA0, pA1, mnA, alA, pB0, pB1, alB, t + 1, 0, 1, 1);
    }
    const bool even = (NT & 1) == 0;
    if (even) { SBAR(); qkt<1, SK>(pB0, pB1, K_lds, r32, hi, S.qr, ACT(NT - 1)); SBAR(); }
#define QROW(e) (nxt.Q + (size_t)(wid * QBLK + r32) * QP + ((e) >> 1) * 16 + hi * 8 + ((e) & 1) * 4)
    if constexpr (F32) { SLOAD_F((const float*)nxt.K, kbn); SBAR();
#pragma unroll
        for (int e = 0; e < 8; ++e) S.tq[e] = *(const f32x4*)QROW(e); }
    else { SLOAD_H(nxt.K, nxt.V, kbn); SBAR();
#pragma unroll
        for (int d0 = 0; d0 < 8; ++d0) S.qr[d0] = load8<TIn>(nxt.Q + (size_t)(wid * QBLK) * QP + (unsigned)(r32 * QP + hi * 8) + d0 * 16); }
    SBAR();
    finishSM(pA0, pA1, alA, l_reg, pa0, pa1, pa2, pa3); SBAR();
    if constexpr (F32) {
#pragma unroll
        for (int e = 8; e < 16; ++e) S.tq[e] = *(const f32x4*)QROW(e); SBAR(); }
#undef QROW
    pv_tile<0, SK>(o, vb0, pa0, pa1, pa2, pa3, ACT(even ? NT - 2 : NT - 1));
    if (even) { MASKT(pB0, pB1, NT - 1); partialSM(pB0, pB1, m_reg, mnB, alB); __syncthreads(); RESC(alB);
        finishSM(pB0, pB1, alB, l_reg, pa0, pa1, pa2, pa3); SBAR(); pv_tile<1, SK>(o, vb0, pa0, pa1, pa2, pa3, ACT(NT - 1)); }
    SBAR(); SEAM_K0();
    if (hi == 0) li_l[r32] = l_reg; asm volatile("s_waitcnt lgkmcnt(0)" ::: "memory");
    float rli[16];
#pragma unroll
    for (int r = 0; r < 16; ++r) rli[r] = __builtin_amdgcn_rcpf(li_l[crow(r, hi)]);
    TOut* Ow = cur.O + (size_t)(wid * QBLK) * OP;
#pragma unroll
    for (int r = 0; r < 16; ++r) { const int orow = crow(r, hi);
#pragma unroll
        for (int d0 = 0; d0 < 4; ++d0) { const float v = o[d0][r] * rli[r];
            if constexpr (same_t<TOut, float>::v) { Ow[(size_t)orow * OP + d0 * 32 + r32] = v; }
            else { const float vn = __shfl_xor(v, 1);
                   if ((r32 & 1) == 0) *(unsigned*)(Ow + (size_t)orow * OP + d0 * 32 + r32) = cvtpk(v, vn); } } }
    if constexpr (F32) {
#pragma unroll
        for (int d0 = 0; d0 < 8; ++d0) S.qr[d0] = pack8(S.tq[2 * d0], S.tq[2 * d0 + 1]); }
    __syncthreads();
#undef RESC
#undef KBASE
#undef ACT
#undef MASKT
#undef SEAM_K0
#undef HALF_STEP
}
#undef ROW
#undef VMW
#undef VMWN
#undef SLOAD_H
#undef SWRITE_HK
#undef SWRITE_HV
#undef SWRITE_H
#undef SLOAD_F
#undef SWRITE_KF
#undef SWRITE_VF
}

constexpr float LAMBDA_INIT = 0.35550906759096924f;
__device__ __forceinline__ attn::BlockRef<attn::bf16, float> attn_ref(unsigned char* ws, int bh, int qb) {
    const int b = bh >> 5, h = (bh >> 2) & 7, map = (bh >> 1) & 1, vh = bh & 1;
    attn::BlockRef<attn::bf16, float> r;
    r.Q = (const attn::bf16*)(ws + WS_QB) + ((size_t)b * SEQ + (size_t)qb * 256) * DM + map * 1024 + h * 128;
    r.K = (const attn::bf16*)(ws + WS_KVB) + (size_t)b * LSEQ * 4096 + map * 1024 + h * 128;
    r.V = (const attn::bf16*)(ws + WS_KVB) + (size_t)b * LSEQ * 4096 + 2048 + h * 256 + vh * 128;
    r.O = (float*)(ws + WS_OB) + (size_t)map * MS * DM + ((size_t)b * SEQ + (size_t)qb * 256) * DM + h * 256 + vh * 128;
    r.P0 = NMETA + qb * 256;
    r.cb = __builtin_amdgcn_exp2f(-(float)(h + 1)) * 11.313708498984761f;
    return r;
}
__device__ __forceinline__ void phase10(KArgs a, const Ctx& C, char* lds) {
    using namespace attn;
    constexpr int total = 4 * 128;
    constexpr int SKV = 2112, W = 0x40000000;
    int L = blockIdx.x; const int stride = C.G;
    if (L < total) {
        int bh = L >> 2, x = L & 3, pass = 0;
        BlockRef<bf16, float> cur = attn_ref(a->ws, bh, x);
        Seam<bf16> S;
        causal_swa_prime<bf16, float>(cur, W, lds, S, C.wave);
        for (;;) {
            const bool more_pass = pass == 0, more_item = L + stride < total, last = !more_pass && !more_item;
            int bhn = bh, xn = x, passn = pass + 1, Ln = L;
            if (!more_pass) { passn = 0; Ln = more_item ? L + stride : L; bhn = Ln >> 2; xn = Ln & 3; }
            const BlockRef<bf16, float> nxt = last ? cur : attn_ref(a->ws, bhn, passn ? 7 - xn : xn);
            causal_swa_block<bf16, float>(cur, nxt, SKV, W, lds, S, C.wave);
            if (last) break;
            cur = nxt; bh = bhn; x = xn; pass = passn; L = Ln;
        }
    }
}
__device__ __forceinline__ void phase11(KArgs a, const Ctx& C) {
    unsigned char* ws = a->ws;
    const float* O1 = (const float*)(ws + WS_OB); const float* O2 = O1 + (size_t)MS * DM; bf16* ON = (bf16*)(ws + WS_ON);
    const int lane = C.lane;
    float lam;
    { const float s1 = wave_sum(a->in[16][lane] * a->in[17][lane] + a->in[16][lane + 64] * a->in[17][lane + 64]);
      const float s2 = wave_sum(a->in[18][lane] * a->in[19][lane] + a->in[18][lane + 64] * a->in[19][lane + 64]);
      lam = __expf(s1) - __expf(s2) + LAMBDA_INIT; }
    const f32x4 gs = *((const GAS f32x4*)a->in[20] + lane) * (1.0f - LAMBDA_INIT);
    for (int row = C.gw; row < MS; row += C.NGW) {
        const GAS f32x4* p1 = (const GAS f32x4*)(O1 + (size_t)row * DM) + lane; const GAS f32x4* p2 = (const GAS f32x4*)(O2 + (size_t)row * DM) + lane;
        GAS u64* o8 = (GAS u64*)(ON + (size_t)row * DM) + lane;
        f32x4 v[8];
#pragma unroll
        for (int j = 0; j < 8; ++j) v[j] = p1[64 * j] - lam * p2[64 * j];
#pragma unroll
        for (int j = 0; j < 8; ++j) { const float s = wave_sum((v[j].x * v[j].x + v[j].y * v[j].y) + (v[j].z * v[j].z + v[j].w * v[j].w));
            const float rstd = 1.f / sqrtf(s * (1.f / VDIM) + RMS_EPS); const f32x4 y = v[j] * rstd * gs;
            o8[64 * j] = (u64)pk2(y.x, y.y) | ((u64)pk2(y.z, y.w) << 32); }
    }
}

constexpr size_t MISC_TOKE = 0, MISC_TOKW = 64 * 1024, MISC_TOKS = 128 * 1024, MISC_PE = 192 * 1024;
__device__ __forceinline__ void phase13(KArgs a, const Ctx& C) {
    unsigned char* ws = a->ws; const int lane = C.lane;
    const float* H3 = (const float*)(ws + WS_H3); bf16* UM = (bf16*)(ws + WS_UM);
    int* TOKE = (int*)(ws + WS_MISC + MISC_TOKE); float* TOKW = (float*)(ws + WS_MISC + MISC_TOKW);
    LAS float* RL = (LAS float*)C.lds;
    LAS unsigned* hist = (LAS unsigned*)(C.lds + MISC_OFF) + 16;
    for (int i = C.tid; i < DM * NEXP / 4; i += NWAVES * 64) *((LAS f32x4*)RL + i) = *((const GAS f32x4*)a->in[26] + i);
    LDS_BARRIER();
    const float* gain = a->in[22] + DM;
    for (int row = C.gw; row < MS; row += C.NGW) {
        const GAS f32x4* xr = (const GAS f32x4*)(H3 + (size_t)row * DM) + lane; const GAS f32x4* gr = (const GAS f32x4*)gain + lane;
        f32x4 v[8]; float s = 0.f;
#pragma unroll
        for (int j = 0; j < 8; ++j) { v[j] = xr[64 * j]; s += (v[j].x * v[j].x + v[j].y * v[j].y) + (v[j].z * v[j].z + v[j].w * v[j].w); }
        const float rstd = 1.f / sqrtf(wave_sum(s) * (1.f / DM) + RMS_EPS);
        GAS u64* o8 = (GAS u64*)(UM + (size_t)row * DM) + lane;
        float p[8];
#pragma unroll
        for (int e = 0; e < 8; ++e) p[e] = 0.f;
#pragma unroll
        for (int j = 0; j < 8; ++j) { const f32x4 y = v[j] * rstd * gr[64 * j];
            o8[64 * j] = (u64)pk2(y.x, y.y) | ((u64)pk2(y.z, y.w) << 32);
#pragma unroll
            for (int i = 0; i < 4; ++i) { const LAS f32x4* rr = (const LAS f32x4*)(RL + (256 * j + 4 * lane + i) * 8); const f32x4 r0 = rr[0], r1 = rr[1];
                p[0] += y[i] * r0.x; p[1] += y[i] * r0.y; p[2] += y[i] * r0.z; p[3] += y[i] * r0.w; p[4] += y[i] * r1.x; p[5] += y[i] * r1.y; p[6] += y[i] * r1.z; p[7] += y[i] * r1.w; }
            asm volatile("" ::: "memory"); }
#pragma unroll
        for (int e = 0; e < 8; ++e) p[e] = wave_sum(p[e]);
        int i1 = 0; float v1 = p[0];
#pragma unroll
        for (int e = 1; e < 8; ++e) if (p[e] > v1) { v1 = p[e]; i1 = e; }
        int i2 = -1; float v2 = -__builtin_inff();
#pragma unroll
        for (int e = 0; e < 8; ++e) if (e != i1 && p[e] > v2) { v2 = p[e]; i2 = e; }
        const float e2 = __expf(v2 - v1), w1 = 1.f / (1.f + e2), w2 = e2 * w1;
        if (lane == 0) { TOKE[2 * row] = i1; TOKE[2 * row + 1] = i2; TOKW[2 * row] = w1; TOKW[2 * row + 1] = w2;
            __hip_atomic_fetch_add(hist + i1, 1u, __ATOMIC_RELAXED, __HIP_MEMORY_SCOPE_WORKGROUP); __hip_atomic_fetch_add(hist + i2, 1u, __ATOMIC_RELAXED, __HIP_MEMORY_SCOPE_WORKGROUP); }
    }
    LDS_BARRIER();
    if (C.tid < 8) { const unsigned hcount = hist[C.tid]; if (hcount) __hip_atomic_fetch_add((unsigned*)((gu32*)(ws + WS_CTL) + CW_CNT + 64 * C.tid), hcount, RLX_AGENT); }
}
struct ExpTab { int cnt[8], np[8], pb[8]; int npanels; };
__device__ __forceinline__ void load_exptab(unsigned char* ws, ExpTab& T) {
    int acc = 0;
#pragma unroll
    for (int e = 0; e < 8; ++e) { const int c = __builtin_amdgcn_readfirstlane((int)__hip_atomic_load((unsigned*)((gu32*)(ws + WS_CTL) + CW_CNT + 64 * e), RLX_AGENT));
        T.cnt[e] = c; T.np[e] = (c + 255) >> 8; T.pb[e] = acc; acc += T.np[e]; }
    T.npanels = acc;
}
__device__ __forceinline__ void phase14(KArgs a, const Ctx& C) {
    unsigned char* ws = a->ws; const int lane = C.lane;
    const bf16* UM = (const bf16*)(ws + WS_UM); unsigned char* XP = ws + WS_XPERM;
    const int* TOKE = (const int*)(ws + WS_MISC + MISC_TOKE); int* TOKS = (int*)(ws + WS_MISC + MISC_TOKS);
    ExpTab T; load_exptab(ws, T);
    for (int row = C.gw; row < MS; row += C.NGW) {
        int s1 = 0, s2 = 0;
        if (lane == 0) { const int e1 = TOKE[2 * row], e2 = TOKE[2 * row + 1]; int b1 = 0, b2 = 0;
#pragma unroll
            for (int e = 0; e < 8; ++e) { if (e == e1) b1 = T.pb[e]; if (e == e2) b2 = T.pb[e]; }
            s1 = b1 * 256 + (int)__hip_atomic_fetch_add((unsigned*)((gu32*)(ws + WS_CTL) + CW_CUR + 64 * e1), 1u, RLX_AGENT);
            s2 = b2 * 256 + (int)__hip_atomic_fetch_add((unsigned*)((gu32*)(ws + WS_CTL) + CW_CUR + 64 * e2), 1u, RLX_AGENT);
            TOKS[2 * row] = s1; TOKS[2 * row + 1] = s2; }
        s1 = __builtin_amdgcn_readfirstlane(s1); s2 = __builtin_amdgcn_readfirstlane(s2);
        const GAS v4u* src = (const GAS v4u*)(UM + (size_t)row * DM + 32 * lane); v4u o[2];
#pragma unroll
        for (int hh = 0; hh < 2; ++hh) { const v4u x0 = src[2 * hh], x1 = src[2 * hh + 1];
            o[hh].x = pk4_fp8(__uint_as_float(x0.x << 16), __uint_as_float(x0.x & 0xffff0000u), __uint_as_float(x0.y << 16), __uint_as_float(x0.y & 0xffff0000u));
            o[hh].y = pk4_fp8(__uint_as_float(x0.z << 16), __uint_as_float(x0.z & 0xffff0000u), __uint_as_float(x0.w << 16), __uint_as_float(x0.w & 0xffff0000u));
            o[hh].z = pk4_fp8(__uint_as_float(x1.x << 16), __uint_as_float(x1.x & 0xffff0000u), __uint_as_float(x1.y << 16), __uint_as_float(x1.y & 0xffff0000u));
            o[hh].w = pk4_fp8(__uint_as_float(x1.z << 16), __uint_as_float(x1.z & 0xffff0000u), __uint_as_float(x1.w << 16), __uint_as_float(x1.w & 0xffff0000u)); }
        GAS v4u* d1 = (GAS v4u*)(XP + (size_t)s1 * DM + 32 * lane); GAS v4u* d2 = (GAS v4u*)(XP + (size_t)s2 * DM + 32 * lane);
        d1[0] = o[0]; d1[1] = o[1]; d2[0] = o[0]; d2[1] = o[1];
    }
    if (blockIdx.x == 0 && C.tid < 128 && C.tid < T.npanels) { int e = 0;
#pragma unroll
        for (int q = 1; q < 8; ++q) e += (C.tid >= T.pb[q]) ? 1 : 0;
        ((int*)(ws + WS_MISC + MISC_PE))[C.tid] = e; }
    for (int pr = C.gw; pr < 8 * 256; pr += C.NGW) { const int e = pr >> 8, r = pr & 255; int cnt = 0, pb = 0, np = 0;
#pragma unroll
        for (int q = 0; q < 8; ++q) if (q == e) { cnt = T.cnt[q]; pb = T.pb[q]; np = T.np[q]; }
        const int row = pb * 256 + cnt + r;
        if (row < (pb + np) * 256) { GAS v4u* d = (GAS v4u*)(XP + (size_t)row * DM + 32 * lane); const v4u z = {0u, 0u, 0u, 0u}; d[0] = z; d[1] = z; } }
    { const v4u z = {0u, 0u, 0u, 0u}; unsigned char* AP = ws + WS_ACTP;
      for (int i = C.gw * 64 + lane; i < MPERM * 8; i += C.NGW * 64) { const int rowi = i >> 3, c16 = i & 7; *(GAS v4u*)(AP + (size_t)rowi * DFFP + DFF + 16 * c16) = z; } }
}
__device__ __forceinline__ void make_grouped(unsigned char* ws, pg8::GroupedOrder& S, int nN, int G, int c) {
    int npanels = 0;
#pragma unroll
    for (int e = 0; e < 8; ++e) { const int cn = __builtin_amdgcn_readfirstlane((int)__hip_atomic_load((unsigned*)((gu32*)(ws + WS_CTL) + CW_CNT + 64 * e), RLX_AGENT)); npanels += (cn + 255) >> 8; }
    S.nM = npanels; S.nN = nN; S.nwg = npanels * nN; S.G = G; S.c = c; S.pe = (const int*)(ws + WS_MISC + MISC_PE);
}
__device__ __forceinline__ void phase17(KArgs a, const Ctx& C) {
    unsigned char* ws = a->ws; const int lane = C.lane;
    const float* H3 = (const float*)(ws + WS_H3); const bf16* YP = (const bf16*)(ws + WS_YP);
    const int* TOKS = (const int*)(ws + WS_MISC + MISC_TOKS); const float* TOKW = (const float*)(ws + WS_MISC + MISC_TOKW);
    typedef unsigned u32x2 __attribute__((ext_vector_type(2)));
    for (int row = C.gw; row < MS; row += C.NGW) {
        const int s1 = TOKS[2 * row], s2 = TOKS[2 * row + 1]; const float w1 = TOKW[2 * row], w2 = TOKW[2 * row + 1];
        const GAS f32x4* xr = (const GAS f32x4*)(H3 + (size_t)row * DM) + lane; const GAS f32x4* gr = (const GAS f32x4*)a->in[30] + lane;
        const GAS u32x2* y1 = (const GAS u32x2*)(YP + (size_t)s1 * DM) + lane; const GAS u32x2* y2 = (const GAS u32x2*)(YP + (size_t)s2 * DM) + lane;
        f32x4 v[8]; float s = 0.f;
#pragma unroll
        for (int j = 0; j < 8; ++j) { const u32x2 q1 = y1[64 * j], q2 = y2[64 * j];
            const f32x4 f1 = {__uint_as_float(q1.x << 16), __uint_as_float(q1.x & 0xffff0000u), __uint_as_float(q1.y << 16), __uint_as_float(q1.y & 0xffff0000u)};
            const f32x4 f2 = {__uint_as_float(q2.x << 16), __uint_as_float(q2.x & 0xffff0000u), __uint_as_float(q2.y << 16), __uint_as_float(q2.y & 0xffff0000u)};
            v[j] = xr[64 * j] + w1 * f1 + w2 * f2; s += (v[j].x * v[j].x + v[j].y * v[j].y) + (v[j].z * v[j].z + v[j].w * v[j].w); }
        const float rstd = 1.f / sqrtf(wave_sum(s) * (1.f / DM) + RMS_EPS);
        GAS f32x4* op = (GAS f32x4*)(a->out + (size_t)row * DM) + lane;
#pragma unroll
        for (int j = 0; j < 8; ++j) op[64 * j] = v[j] * rstd * gr[64 * j];
    }
}


template <int VAR> __device__ __forceinline__ void phase0(KArgs a, const Ctx& C) {
    unsigned char* ws = a->ws;
    LAS float* scr = (LAS float*)(C.lds + C.wave * 16640);
    constexpr int I_SQ = 32 * 32, I_IN = 32 * 64, I_GU = 32 * 86, I_DN = 86 * 32, I_E = 2 * I_GU + I_DN;
    constexpr int NITEMS = 8 * I_E + I_IN + 2 * I_SQ + (2 * I_GU + I_DN) + I_SQ + I_IN;
    struct TJob { const float* src; unsigned char* dst; int N, KP, mode, fp8; float scale; };
    auto decode = [&](int it, TJob& J, int& item) {
        int r = it;
        if (r < 8 * I_E) { const int e = r / I_E; int q = r - e * I_E;
            if (q < I_GU) { J = TJob{a->in[27] + (size_t)e * DM * DFF, ws + WS_MGU + e * SZ_GU8, DFF, DM, 1, 1, 256.f}; item = q; return; } q -= I_GU;
            if (q < I_GU) { J = TJob{a->in[28] + (size_t)e * DM * DFF, ws + WS_MGU + e * SZ_GU8, DFF, DM, 2, 1, 256.f}; item = q; return; } q -= I_GU;
            J = TJob{a->in[29] + (size_t)e * DFF * DM, ws + WS_MD + e * SZ_D8, DM, DFFP, 0, 1, 512.f}; item = q; return; }
        r -= 8 * I_E;
        if (r < I_IN) { J = TJob{a->in[13], ws + WS_WKV, 4096, 2 * DM, 0, 0, 1.f}; item = r; return; } r -= I_IN;
        if (r < I_SQ) { J = TJob{a->in[15], ws + WS_WQ, DM, 2 * DM, 0, 0, 1.f}; item = r; return; } r -= I_SQ;
        if (r < I_SQ) { J = TJob{a->in[21], ws + WS_WO2, DM, 2 * DM, 0, 0, 1.f}; item = r; return; } r -= I_SQ;
        if (r < I_GU) { J = TJob{a->in[23], ws + WS_WGU, DFF, 2 * DM, 1, 0, 1.f}; item = r; return; } r -= I_GU;
        if (r < I_GU) { J = TJob{a->in[24], ws + WS_WGU, DFF, 2 * DM, 2, 0, 1.f}; item = r; return; } r -= I_GU;
        if (r < I_DN) { J = TJob{a->in[25], ws + WS_WD, DM, 2 * DFF, 0, 0, 1.f}; item = r; return; } r -= I_DN;
        if (r < I_SQ) { J = TJob{a->in[11], ws + WS_WOUT, DM, 2 * DM, 0, 0, 1.f}; item = r; return; } r -= I_SQ;
        J = TJob{a->in[3], ws + WS_WIN, 4096, 2 * DM, 0, 0, 1.f}; item = r; };
    if (C.gw < NITEMS) {
        const int lane = C.lane;
        TJob J; int item; int it = C.gw; decode(it, J, item);
        float t[64];
        { const int nblk = J.N / 64, k0 = 64 * (item / nblk), n0 = 64 * (item % nblk); const float* src = J.src + (size_t)k0 * J.N + n0 + lane;
#pragma unroll
          for (int i = 0; i < 64; ++i) t[i] = __builtin_nontemporal_load(src + (size_t)i * J.N); }
        for (;;) {
            if (VAR == 2) { float cs = 0.f;
#pragma unroll
                for (int i = 0; i < 64; ++i) cs += t[i];
                if (cs == 1.2345e30f) scr[lane] = cs; }
            else {
#pragma unroll
            for (int i = 0; i < 64; ++i) scr[i * 65 + lane] = t[i]; }
            const TJob cur = J; const int citem = item;
            const int nxt = it + C.NGW; const bool has_next = nxt < NITEMS;
            if (has_next) { decode(nxt, J, item);
                const int nblk = J.N / 64, k0 = 64 * (item / nblk), n0 = 64 * (item % nblk); const float* src = J.src + (size_t)k0 * J.N + n0 + lane;
#pragma unroll
                for (int i = 0; i < 64; ++i) t[i] = __builtin_nontemporal_load(src + (size_t)i * J.N); }
            LDS_WAIT(); asm volatile("" ::: "memory");
            if (VAR != 2) { const int nblk = cur.N / 64, k0 = 64 * (citem / nblk), n0 = 64 * (citem % nblk);
              const int drow0 = cur.mode == 0 ? n0 : ((n0 >> 7) * 256 + (n0 & 127) + (cur.mode == 2 ? 128 : 0));
              if (cur.fp8) { const int c = lane & 3, nl = lane >> 2; const float sc = cur.scale;
#pragma unroll
                  for (int j = 0; j < 4; ++j) { const int n = nl + 16 * j; const LAS float* s = scr + (16 * c) * 65 + n;
                      v4u o; o.x = pk4_fp8(s[0 * 65] * sc, s[1 * 65] * sc, s[2 * 65] * sc, s[3 * 65] * sc); o.y = pk4_fp8(s[4 * 65] * sc, s[5 * 65] * sc, s[6 * 65] * sc, s[7 * 65] * sc);
                      o.z = pk4_fp8(s[8 * 65] * sc, s[9 * 65] * sc, s[10 * 65] * sc, s[11 * 65] * sc); o.w = pk4_fp8(s[12 * 65] * sc, s[13 * 65] * sc, s[14 * 65] * sc, s[15 * 65] * sc);
                      if (VAR == 0 || o.x == 0x7fc1c2c3u) *(GAS v4u*)(cur.dst + (size_t)(drow0 + n) * cur.KP + k0 + 16 * c) = o; } }
              else { const int c = lane & 7, nl = lane >> 3;
#pragma unroll
                  for (int j = 0; j < 8; ++j) { const int n = nl + 8 * j; const LAS float* s = scr + (8 * c) * 65 + n;
                      v4u o; o.x = pk2(s[0 * 65], s[1 * 65]); o.y = pk2(s[2 * 65], s[3 * 65]); o.z = pk2(s[4 * 65], s[5 * 65]); o.w = pk2(s[6 * 65], s[7 * 65]);
                      if (VAR == 0 || o.x == 0x7fc1c2c3u) *(GAS v4u*)(cur.dst + (size_t)(drow0 + n) * cur.KP + (k0 + 8 * c) * 2) = o; } } }
            LDS_WAIT(); asm volatile("" ::: "memory");
            if (!has_next) break;
            it = nxt;
        }
    }
    { bf16* wg = (bf16*)(ws + WS_WG); const float* rg = a->in[6]; const float* ig = a->in[8];
      for (int idx = C.gw * 64 + C.lane; idx < 16 * 256 * 128; idx += C.NGW * 64) { const int g = idx >> 15, jj = (idx >> 7) & 255, i = idx & 127;
          const float v = (jj < 128 ? rg : ig)[(size_t)g * 16384 + i * 128 + (jj & 127)]; wg[idx] = (bf16)f2bf(v); } }
    { const v4u zero = {0u, 0u, 0u, 0u}; for (int i = C.gw * 64 + C.lane; i < 8 * DM * 8; i += C.NGW * 64) { const int rowi = i >> 3, c16 = i & 7; *(GAS v4u*)(ws + WS_MD + (size_t)rowi * DFFP + DFF + 16 * c16) = zero; } }
    { v4u* z = (v4u*)(ws + WS_KVB + (size_t)ML * 4096 * 2); const v4u zero = {0u, 0u, 0u, 0u}; for (int i = C.gw * 64 + C.lane; i < 64 * 4096 * 2 / 16; i += C.NGW * 64) z[i] = zero; }
    { float* hb = (float*)(ws + WS_HBUF); bf16* U = (bf16*)(ws + WS_U);
      for (int row = C.gw; row < ML; row += C.NGW) { const int b = row / LSEQ, t = row - b * LSEQ;
          const float* src = t < NMETA ? a->in[1] + (size_t)t * DM : a->in[0] + ((size_t)b * SEQ + (t - NMETA)) * DM;
          rms_row(src, a->in[2], U + (size_t)row * DM, hb + (size_t)row * DM, C.lane); } }
}

__global__ void __launch_bounds__(NWAVES * 64, 2) mk_fwd(Args args) {
    extern __shared__ __attribute__((aligned(16))) unsigned char lds_raw[];
    const int wave0 = __builtin_amdgcn_readfirstlane((int)threadIdx.x >> 6); __builtin_assume(wave0 >= 0 && wave0 < NWAVES);
#define MKCTX() Ctx C; C.lds = (LAS unsigned char*)lds_raw; C.wave = wave0; C.lane = mk_lane(); C.tid = wave0 * 64 + C.lane; C.G = gridDim.x; C.gw = blockIdx.x * NWAVES + wave0; C.NGW = C.G * NWAVES
    LAS unsigned char* const lds0 = (LAS unsigned char*)lds_raw;
    volatile LAS unsigned* MISC = (volatile LAS unsigned*)(lds0 + MISC_OFF);
    gu32* ctl = (gu32*)(kargs()->ws + WS_CTL);
    for (int u = threadIdx.x; u < (LDS_BYTES - LDSCTL_OFF) / 4; u += NWAVES * 64) ((LAS unsigned*)(lds0 + LDSCTL_OFF))[u] = 0u;
    __syncthreads();
    const int lo = kargs()->ph_lo, hi = kargs()->ph_hi;
    XcdBarrier bar; bar.bar = (unsigned*)(ctl + CW_BAR); bar.x = 0; bar.st = nullptr;
    if (hi - lo > 1) bar = xcd_barrier_post((unsigned*)(ctl + CW_BAR), MISC + 8, threadIdx.x == 0);
#define IN(k) (lo <= (k) && (k) < hi)
#define SEAM(k) do { if (IN(k) && IN((k) + 1)) xcd_barrier(bar, wave0 == 0 && mk_lane() == 0); } while (0)

    if (IN(0)) { MKCTX(); phase0<0>(kargs(), C); }
#ifdef PROBE_PHASES
    if (lo == 100) { MKCTX(); phase0<1>(kargs(), C); }
    if (lo == 101) { MKCTX(); phase0<2>(kargs(), C); }
#endif
    SEAM(0);
    if (IN(1)) { MKCTX(); unsigned char* ws = kargs()->ws;
        pg8::Gemm g{ws + WS_U, ws + WS_WIN, 2 * DM, 0}; pg8::StaticOrder S; S.init(MS, 4096, C.G, (int)blockIdx.x);
        pg8::EpiBf16 E{(pg8::bf16_t*)(ws + WS_XG), 4096};
        thin_gemm<1>(C, (const bf16*)(ws + WS_U), (const bf16*)(ws + WS_WIN), DM, 4096 / 16, MS, ThinBf16{(bf16*)(ws + WS_XG), 4096});
        pg8::gemm_phase<pg8::EpiBf16, pg8::StaticOrder, true, true>(C.lds, g, S, E, C.wave);
    }
    SEAM(1);
    if (IN(2)) { MKCTX(); phase2(kargs(), C); }
    SEAM(2);
    if (IN(3)) { MKCTX(); phase3(kargs(), C); }
    SEAM(3);
    if (IN(4)) { MKCTX(); unsigned char* ws = kargs()->ws;
        thin_gemm<1>(C, (const bf16*)(ws + WS_Y), (const bf16*)(ws + WS_WOUT), DM, DM / 16, MS, ThinRes{(float*)(ws + WS_HBUF), DM});
        pg8::Gemm g{ws + WS_Y, ws + WS_WOUT, 2 * DM, 0}; pg8::StaticOrder S; S.init(MS, DM, C.G, (int)blockIdx.x);
        pg8::EpiResF32<0> E{(const float*)(ws + WS_HBUF), (float*)(ws + WS_HBUF), DM};
        pg8::gemm_phase<pg8::EpiResF32<0>, pg8::StaticOrder, true, true>(C.lds, g, S, E, C.wave);
    }
    SEAM(4);
    if (IN(5)) { MKCTX(); unsigned char* ws = kargs()->ws;
        const float* hb = (const float*)(ws + WS_HBUF); bf16* U = (bf16*)(ws + WS_U);
        for (int row = C.gw; row < ML; row += C.NGW) rms_row(hb + (size_t)row * DM, kargs()->in[22], U + (size_t)row * DM, nullptr, C.lane);
    }
    SEAM(5);
    if (IN(6)) { MKCTX(); unsigned char* ws = kargs()->ws;
        thin_gemm<2>(C, (const bf16*)(ws + WS_U), (const bf16*)(ws + WS_WGU), DM, DFF / 16, MS, ThinSwiglu{(bf16*)(ws + WS_ACT), DFF});
        pg8::Gemm g{ws + WS_U, ws + WS_WGU, 2 * DM, 0}; pg8::StaticOrder S; S.init(MS, NGU, C.G, (int)blockIdx.x);
        pg8::EpiSwiglu E{(pg8::bf16_t*)(ws + WS_ACT), DFF};
        pg8::gemm_phase<pg8::EpiSwiglu, pg8::StaticOrder, true, true>(C.lds, g, S, E, C.wave);
    }
    SEAM(6);
    if (IN(7)) { MKCTX(); unsigned char* ws = kargs()->ws;
        thin_gemm<1>(C, (const bf16*)(ws + WS_ACT), (const bf16*)(ws + WS_WD), DFF, DM / 16, MS, ThinRes{(float*)(ws + WS_HBUF), DM});
        pg8::Gemm g{ws + WS_ACT, ws + WS_WD, 2 * DFF, 0}; pg8::StaticOrder S; S.init(MS, DM, C.G, (int)blockIdx.x);
        pg8::EpiResF32<0> E{(const float*)(ws + WS_HBUF), (float*)(ws + WS_HBUF), DM};
        pg8::gemm_phase<pg8::EpiResF32<0>, pg8::StaticOrder, true, true>(C.lds, g, S, E, C.wave);
    }
    SEAM(7);
    if (IN(8)) { MKCTX(); unsigned char* ws = kargs()->ws;
        const float* hb = (const float*)(ws + WS_HBUF); bf16* U = (bf16*)(ws + WS_U); bf16* UQ = (bf16*)(ws + WS_UQ);
        for (int row = C.gw; row < ML; row += C.NGW) { const int b = row / LSEQ, t = row - b * LSEQ;
            rms_row2(hb + (size_t)row * DM, kargs()->in[12], U + (size_t)row * DM, kargs()->in[14], t >= NMETA ? UQ + ((size_t)b * SEQ + (t - NMETA)) * DM : nullptr, C.lane); }
    }
    SEAM(8);
    if (IN(9)) { MKCTX(); unsigned char* ws = kargs()->ws;
        thin_gemm<1>(C, (const bf16*)(ws + WS_U), (const bf16*)(ws + WS_WKV), DM, 4096 / 16, MS, ThinBf16{(bf16*)(ws + WS_KVB), 4096});
        { pg8::Gemm g{ws + WS_U, ws + WS_WKV, 2 * DM, 0}; pg8::StaticOrder S; S.init(MS, 4096, C.G, (int)blockIdx.x);
          pg8::EpiBf16 E{(pg8::bf16_t*)(ws + WS_KVB), 4096};
          pg8::gemm_phase<pg8::EpiBf16, pg8::StaticOrder, true, true>(C.lds, g, S, E, C.wave); }
        { pg8::Gemm g{ws + WS_UQ, ws + WS_WQ, 2 * DM, 0}; pg8::StaticOrder S; S.init(MS, DM, C.G, (int)blockIdx.x);
          pg8::EpiBf16 E{(pg8::bf16_t*)(ws + WS_QB), DM};
          pg8::gemm_phase<pg8::EpiBf16, pg8::StaticOrder, true, true>(C.lds, g, S, E, C.wave); }
    }
    SEAM(9);
    if (IN(10)) { MKCTX(); phase10(kargs(), C, (char*)lds_raw); }
    SEAM(10);
    if (IN(11)) { MKCTX(); phase11(kargs(), C); }
    SEAM(11);
    if (IN(12)) { MKCTX(); unsigned char* ws = kargs()->ws;
        pg8::Gemm g{ws + WS_ON, ws + WS_WO2, 2 * DM, 0}; pg8::StaticOrder S; S.init(MS, DM, C.G, (int)blockIdx.x);
        pg8::EpiResF32<1> E{(const float*)(ws + WS_HBUF), (float*)(ws + WS_H3), DM};
        pg8::gemm_phase<pg8::EpiResF32<1>, pg8::StaticOrder, true, true>(C.lds, g, S, E, C.wave);
    }
    SEAM(12);
    if (IN(13)) { MKCTX(); phase13(kargs(), C); }
    SEAM(13);
    if (IN(14)) { MKCTX(); phase14(kargs(), C); }
    SEAM(14);
    if (IN(15)) { MKCTX(); unsigned char* ws = kargs()->ws;
        pg8::Gemm g{ws + WS_XPERM, ws + WS_MGU, DM, SZ_GU8}; pg8::GroupedOrder S; make_grouped(ws, S, NGU / 256, C.G, (int)blockIdx.x);
        pg8::EpiSwiglu8 E{ws + WS_ACTP, DFFP};
        pg8::gemm_phase<pg8::EpiSwiglu8, pg8::GroupedOrder, true, true, true, 127, 127 - 8>(C.lds, g, S, E, C.wave);
    }
    SEAM(15);
    if (IN(16)) { MKCTX(); unsigned char* ws = kargs()->ws;
        pg8::Gemm g{ws + WS_ACTP, ws + WS_MD, DFFP, SZ_D8}; pg8::GroupedOrder S; make_grouped(ws, S, DM / 256, C.G, (int)blockIdx.x);
        pg8::EpiBf16 E{(pg8::bf16_t*)(ws + WS_YP), DM};
        pg8::gemm_phase<pg8::EpiBf16, pg8::GroupedOrder, true, true, true, 127 - 4, 127 - 9>(C.lds, g, S, E, C.wave);
    }
    SEAM(16);
    if (IN(17)) { MKCTX(); phase17(kargs(), C); }
#undef IN
#undef MKCTX
#undef SEAM
}

#ifndef MK_PER_PHASE
#define MK_PER_PHASE 0
#endif
extern "C" void kernel_launch(void* const* d_in, const int* in_sizes, int n_in, void* d_out, int out_size, void* d_ws, size_t ws_size, hipStream_t stream) {
    static int grid = 0;
    if (grid == 0) {
        if (n_in != 31 || ws_size < WS_END || out_size != MS * DM) { fprintf(stderr, "kernel_launch: unexpected n_in %d / out %d / ws %zu (need %zu)\n", n_in, out_size, ws_size, (size_t)WS_END); grid = -1; return; }
        int dev = 0, cus = 0, per_cu = 0;
        if (hipGetDevice(&dev) != hipSuccess || hipDeviceGetAttribute(&cus, hipDeviceAttributeMultiprocessorCount, dev) != hipSuccess) { grid = -1; return; }
        if (hipFuncSetAttribute((const void*)mk_fwd, hipFuncAttributeMaxDynamicSharedMemorySize, LDS_BYTES) != hipSuccess) { fprintf(stderr, "kernel_launch: hipFuncSetAttribute failed\n"); grid = -1; return; }
        if (hipOccupancyMaxActiveBlocksPerMultiprocessor(&per_cu, (const void*)mk_fwd, NWAVES * 64, LDS_BYTES) != hipSuccess || per_cu < 1) fprintf(stderr, "kernel_launch: occupancy query says %d\n", per_cu);
        (void)hipGetLastError();
        grid = cus;
    }
    if (grid < 0) return;
    (void)hipMemsetAsync((char*)d_ws + WS_CTL, 0, CTL_ZERO_BYTES, stream);
    Args a{};
    for (int i = 0; i < 31; ++i) a.in[i] = (const float*)d_in[i];
    a.out = (float*)d_out; a.ws = (unsigned char*)d_ws;
    if (MK_PER_PHASE) { for (int p = 0; p < NPHASE; ++p) { a.ph_lo = p; a.ph_hi = p + 1; hipLaunchKernelGGL(mk_fwd, dim3(grid), dim3(NWAVES * 64), LDS_BYTES, stream, a); } }
    else { a.ph_lo = 0; a.ph_hi = NPHASE; hipLaunchKernelGGL(mk_fwd, dim3(grid), dim3(NWAVES * 64), LDS_BYTES, stream, a); }
#ifdef PROBE_PHASES
    { const int pl[] = {PROBE_PHASES}; for (int p : pl) { a.ph_lo = p; a.ph_hi = p + 1; hipLaunchKernelGGL(mk_fwd, dim3(grid), dim3(NWAVES * 64), LDS_BYTES, stream, a); } }
#endif
}
```
